# Optimizing an MI355X kernel written in HIP

```python
import math
import jax, jax.numpy as jnp
from jax import lax
import numpy as np

D_MODEL = 2048
BATCH = 16
SEQ = 256
DEPTH = 4
DEC_BATCH = 8
DEC_SEQ = 2048
PAST_LEN = 256

GRID_W = 64
N_EVEN = (DEPTH + 1) // 2
N_ODD = DEPTH // 2
EPS = 1e-6
CONV_W = 4
CONV_LEFT = CONV_W // 2

D_RNN = D_MODEL // 2
LRU_BLOCKS = 8
LRU_BW = D_RNN // LRU_BLOCKS
LRU_C = 8.0
DA_HEADS = 8
DA_HALF = 64
DA_VDIM = 2 * DA_HALF
D_ATTN = DA_HEADS * DA_VDIM
EVEN_SPLITS = (D_RNN, 2 * D_RNN, 2 * D_RNN + D_ATTN, 2 * D_RNN + 2 * D_ATTN)
EVEN_IN = 2 * D_RNN + 3 * D_ATTN
EVEN_MIX = D_RNN + D_ATTN
Q_BLOCK = 128
ROPE_THETA = 10000.0

D_INNER = 2 * D_MODEL
SSD_HEADDIM = 64
SSD_HEADS = D_INNER // SSD_HEADDIM
SSD_GROUPS = 8
SSD_HPG = SSD_HEADS // SSD_GROUPS
SSD_STATE = 128
SSD_CHUNK = 128
D_XBC = D_INNER + 2 * SSD_GROUPS * SSD_STATE
ODD_IN = D_INNER + D_XBC + 2 * SSD_HEADS

D_FF = -(-8 * D_MODEL // 768) * 256

kernel_name = "hybrid_diffusion_rglru_diffattn_ssd_step"


def rms_norm(x, g):
    xf = x.astype(jnp.float32)
    y = xf * lax.rsqrt(jnp.mean(xf * xf, axis=-1, keepdims=True) + EPS)
    return (y * g.astype(jnp.float32)).astype(x.dtype)


def ada_params(cond, w, b):
    m = jax.nn.silu(cond) @ w + b
    return m.reshape(cond.shape[0], 1, 6, D_MODEL)


def modulate(x, g, shift, scale):
    return rms_norm(x, g) * (1.0 + scale) + shift


def depthwise_conv(x, w, b):
    L = x.shape[1]
    xp = jnp.pad(x, ((0, 0), (CONV_LEFT, CONV_W - 1 - CONV_LEFT), (0, 0)))
    out = b
    for t in range(CONV_W):
        out = out + xp[:, t:t + L] * w[t]
    return out


def axial_rope_tables(L):
    rows = L // GRID_W
    row = jnp.repeat(jnp.arange(rows), GRID_W).astype(jnp.float32)
    col = jnp.tile(jnp.arange(GRID_W), rows).astype(jnp.float32)
    quarter = DA_HALF // 4
    inv = ROPE_THETA ** (-jnp.arange(quarter, dtype=jnp.float32) / quarter)
    ang_r = row[:, None] * inv
    ang_c = col[:, None] * inv
    ang = jnp.concatenate([ang_r, ang_r, ang_c, ang_c], axis=-1)
    return jnp.cos(ang), jnp.sin(ang)


def apply_axial_rope(x, cos, sin):
    q = DA_HALF // 4
    xf = x.astype(jnp.float32)
    x1, x2, x3, x4 = xf[..., :q], xf[..., q:2 * q], xf[..., 2 * q:3 * q], xf[..., 3 * q:]
    rot = jnp.concatenate([-x2, x1, -x4, x3], axis=-1)
    return (xf * cos[:, None, None, :] + rot * sin[:, None, None, :]).astype(x.dtype)


def _lin_combine(l, r):
    al, bl = l
    ar, br = r
    return al * ar, ar * bl + br


def rglru_scan_dir(xc, w_r, b_r, w_i, b_i, lam, h0):
    Bsz, L, _ = xc.shape
    xb = xc.reshape(Bsz, L, LRU_BLOCKS, LRU_BW)
    r = jax.nn.sigmoid(jnp.einsum('blki,kij->blkj', xb, w_r.astype(jnp.float32)).reshape(Bsz, L, D_RNN) + b_r)
    gi = jax.nn.sigmoid(jnp.einsum('blki,kij->blkj', xb, w_i.astype(jnp.float32)).reshape(Bsz, L, D_RNN) + b_i)
    log_a = -LRU_C * r * jax.nn.softplus(-lam.astype(jnp.float32))
    a = jnp.exp(log_a)
    bt = jnp.sqrt(-jnp.expm1(2.0 * log_a)) * (gi * xc)
    bt = bt.at[:, 0].add(a[:, 0] * h0)
    _, hs = lax.associative_scan(_lin_combine, (a, bt), axis=1)
    return hs


def rglru_bidir(xc, w_r, b_r, w_i, b_i, lam, h0):
    hf = rglru_scan_dir(xc, w_r[0], b_r[0], w_i[0], b_i[0], lam[0], h0[:, 0])
    hb = jnp.flip(rglru_scan_dir(jnp.flip(xc, 1), w_r[1], b_r[1], w_i[1], b_i[1], lam[1], h0[:, 1]), 1)
    return hf + hb, jnp.stack([hf[:, -1], hb[:, 0]], axis=1)


def diff_attention(q, k, v, lam):
    s = jnp.einsum('bqhmd,bkhmd->bhmqk', q, k).astype(jnp.float32) * (DA_HALF ** -0.5)
    p = jax.nn.softmax(s, axis=-1)
    w = p[:, :, 0] - lam * p[:, :, 1]
    return jnp.einsum('bhqk,bkhd->bqhd', w.astype(v.dtype), v)


def even_mixer(h, ctx, rope, lam_init, w_in, w_out, conv_w, conv_b, w_r, b_r, w_i, b_i, lru_lam,
               q_norm, k_norm, da_lam, subln):
    Bsz, L, _ = h.shape
    f32 = jnp.float32
    u = h @ w_in
    gate, xr, q, k, v = jnp.split(u, EVEN_SPLITS, axis=-1)
    xc = depthwise_conv(xr, conv_w, conv_b).astype(f32)
    h0 = jnp.zeros((Bsz, 2, D_RNN), f32) if ctx is None else ctx[2].astype(f32)
    rec, s_fin = rglru_bidir(xc, w_r, b_r, w_i, b_i, lru_lam, h0)
    rec = (rec * jax.nn.gelu(gate.astype(f32))).astype(h.dtype)
    q = rms_norm(q.reshape(Bsz, L, DA_HEADS, 2, DA_HALF), q_norm)
    k = rms_norm(k.reshape(Bsz, L, DA_HEADS, 2, DA_HALF), k_norm)
    v = v.reshape(Bsz, L, DA_HEADS, DA_VDIM)
    if ctx is None:
        k_all, v_all = k, v
    else:
        cos, sin = rope
        q = apply_axial_rope(q, cos, sin)
        k_lat = apply_axial_rope(k, cos, sin)
        k_ctx = ctx[0].reshape(Bsz, -1, DA_HEADS, 2, DA_HALF).astype(k.dtype)
        k_all = jnp.concatenate([k_lat, k_ctx], axis=1)
        v_all = jnp.concatenate([v, ctx[1].astype(v.dtype)], axis=1)
    dl = da_lam.astype(f32)
    lam = jnp.exp(jnp.sum(dl[0] * dl[1])) - jnp.exp(jnp.sum(dl[2] * dl[3])) + lam_init
    qb = q.reshape(Bsz, L // Q_BLOCK, Q_BLOCK, DA_HEADS, 2, DA_HALF).swapaxes(0, 1)
    att = lax.map(lambda qq: diff_attention(qq, k_all, v_all, lam), qb)
    att = att.swapaxes(0, 1).reshape(Bsz, L, DA_HEADS, DA_VDIM)
    att = (rms_norm(att, subln) * (1.0 - lam_init)).reshape(Bsz, L, D_ATTN).astype(h.dtype)
    out = jnp.concatenate([rec, att], axis=-1) @ w_out
    return out, (k.reshape(Bsz, L, DA_HEADS, 2 * DA_HALF), v, s_fin)


def segsum(a):
    T = a.shape[-1]
    cs = jnp.cumsum(a, axis=-1)
    diff = cs[..., :, None] - cs[..., None, :]
    return jnp.where(jnp.tril(jnp.ones((T, T), bool)), diff, -jnp.inf)


def ssd_chunked(X, A, Bm, Cm, h0):
    b, l, _, p = X.shape
    c, q = l // SSD_CHUNK, SSD_CHUNK
    g, e, n = SSD_GROUPS, SSD_HPG, SSD_STATE
    X = X.reshape(b, c, q, g, e, p)
    A = A.reshape(b, c, q, g, e).transpose(0, 3, 4, 1, 2)
    Bm = Bm.reshape(b, c, q, g, n)
    Cm = Cm.reshape(b, c, q, g, n)
    A_cs = jnp.cumsum(A, axis=-1)
    Lmat = jnp.exp(segsum(A))
    CB = jnp.einsum('bclgn,bcsgn->bgcls', Cm, Bm)
    Y_diag = jnp.einsum('bgcls,bgecls,bcsgep->bclgep', CB, Lmat, X)
    decay_states = jnp.exp(A_cs[..., -1:] - A_cs)
    states = jnp.einsum('bclgn,bgecl,bclgep->bcgepn', Bm, decay_states, X)
    states = jnp.concatenate([h0.reshape(b, 1, g, e, p, n), states], axis=1)
    chunk_tot = jnp.pad(A_cs[..., -1], ((0, 0), (0, 0), (0, 0), (1, 0)))
    decay_chunk = jnp.exp(segsum(chunk_tot))
    states = jnp.einsum('bgezc,bcgepn->bzgepn', decay_chunk, states)
    prev_states, final = states[:, :-1], states[:, -1]
    Y_off = jnp.einsum('bclgn,bcgepn,bgecl->bclgep', Cm, prev_states, jnp.exp(A_cs))
    Y = (Y_diag + Y_off).reshape(b, l, g * e, p)
    return Y, final.reshape(b, g * e, p, n)


def odd_mixer(h, h0, w_in, conv_w, conv_b, dt_bias, a_log, d_skip, norm_w, w_out):
    Bsz, L, _ = h.shape
    f32 = jnp.float32
    u = h @ w_in
    z, xbc, dt = jnp.split(u, (D_INNER, D_INNER + D_XBC), axis=-1)
    xbc = jax.nn.silu(depthwise_conv(xbc, conv_w, conv_b)).astype(f32)
    xs, bm, cm = jnp.split(xbc, (D_INNER, D_INNER + SSD_GROUPS * SSD_STATE), axis=-1)
    xs = xs.reshape(Bsz, L, SSD_HEADS, SSD_HEADDIM)
    bm = bm.reshape(Bsz, L, SSD_GROUPS, SSD_STATE)
    cm = cm.reshape(Bsz, L, SSD_GROUPS, SSD_STATE)
    dt = jax.nn.softplus(dt.astype(f32).reshape(Bsz, L, 2, SSD_HEADS) + dt_bias.astype(f32))
    a = -jnp.exp(a_log.astype(f32))
    if h0 is None:
        h0 = jnp.zeros((Bsz, 2, SSD_HEADS, SSD_HEADDIM, SSD_STATE), f32)
    h0 = h0.astype(f32)
    yf, sf = ssd_chunked(xs * dt[:, :, 0, :, None], a[0] * dt[:, :, 0], bm, cm, h0[:, 0])
    yb, sb = ssd_chunked(jnp.flip(xs * dt[:, :, 1, :, None], 1), jnp.flip(a[1] * dt[:, :, 1], 1),
                         jnp.flip(bm, 1), jnp.flip(cm, 1), h0[:, 1])
    y = yf + jnp.flip(yb, 1) + d_skip.astype(f32)[:, None] * xs
    y = y.reshape(Bsz, L, D_INNER) * jax.nn.silu(z.astype(f32))
    yg = y.reshape(Bsz, L, SSD_GROUPS, D_INNER // SSD_GROUPS)
    yg = yg * lax.rsqrt(jnp.mean(yg * yg, axis=-1, keepdims=True) + EPS)
    yg = yg.reshape(Bsz, L, D_INNER) * norm_w.astype(f32)
    return yg.astype(h.dtype) @ w_out, jnp.stack([sf, sb], axis=1)


def swiglu(h, w_in, w_out):
    g, u = jnp.split(h @ w_in, 2, axis=-1)
    return (jax.nn.silu(g) * u) @ w_out


def setup_inputs(seed: int = 0) -> dict:
    key = jax.random.key(seed)
    ks = jax.random.split(key, 40)
    f32 = jnp.float32

    def nrm(k, shape, scale):
        return jax.random.normal(k, shape, f32) * scale

    def gain(k, shape):
        return 1.0 + 0.02 * jax.random.normal(k, shape, f32)

    u_lru = jax.random.uniform(ks[13], (N_EVEN, 2, D_RNN), f32, 0.9, 0.999)
    a_base = u_lru ** (1.0 / LRU_C)
    lru_lambda = jnp.log(a_base) - jnp.log1p(-a_base)
    dt0 = jnp.exp(jax.random.uniform(ks[25], (N_ODD, 2, SSD_HEADS), f32, math.log(1e-3), math.log(1e-1)))
    ssd_dt_bias = dt0 + jnp.log(-jnp.expm1(-dt0))
    ssd_a_log = jnp.log(jax.random.uniform(ks[26], (N_ODD, 2, SSD_HEADS), f32, 1.0, 16.0))
    return {
        "x_prompt": nrm(ks[0], (BATCH, SEQ, D_MODEL), 1.0),
        "x_sample": nrm(ks[1], (DEC_BATCH, DEC_SEQ, D_MODEL), 1.0),
        "c": nrm(ks[2], (DEC_BATCH, D_MODEL), 1.0),
        "cache_attn_k": nrm(ks[3], (DEC_BATCH, N_EVEN, PAST_LEN, DA_HEADS, 2 * DA_HALF), 1.0),
        "cache_attn_v": nrm(ks[4], (DEC_BATCH, N_EVEN, PAST_LEN, DA_HEADS, DA_VDIM), 1.0),
        "state_lru": nrm(ks[5], (DEC_BATCH, N_EVEN, 2, D_RNN), 0.5),
        "state_ssd": nrm(ks[6], (DEC_BATCH, N_ODD, 2, SSD_HEADS, SSD_HEADDIM, SSD_STATE), 0.1),
        "c_ctx": nrm(ks[7], (D_MODEL,), 1.0),
        "w_ada": nrm(ks[8], (DEPTH, D_MODEL, 6 * D_MODEL), 0.5 * D_MODEL ** -0.5),
        "b_ada": nrm(ks[9], (DEPTH, 6 * D_MODEL), 0.02),
        "norm_g": gain(ks[10], (DEPTH, 2, D_MODEL)),
        "lru_conv_w": nrm(ks[11], (N_EVEN, CONV_W, D_RNN), CONV_W ** -0.5),
        "lru_conv_b": nrm(ks[12], (N_EVEN, D_RNN), 0.02),
        "lru_w_r": nrm(ks[14], (N_EVEN, 2, LRU_BLOCKS, LRU_BW, LRU_BW), LRU_BW ** -0.5),
        "lru_b_r": nrm(ks[15], (N_EVEN, 2, D_RNN), 0.02),
        "lru_w_i": nrm(ks[16], (N_EVEN, 2, LRU_BLOCKS, LRU_BW, LRU_BW), LRU_BW ** -0.5),
        "lru_b_i": nrm(ks[17], (N_EVEN, 2, D_RNN), 0.02),
        "lru_lambda": lru_lambda,
        "even_w_in": nrm(ks[18], (N_EVEN, D_MODEL, EVEN_IN), D_MODEL ** -0.5),
        "even_w_out": nrm(ks[19], (N_EVEN, EVEN_MIX, D_MODEL), EVEN_MIX ** -0.5),
        "da_q_norm": gain(ks[20], (N_EVEN, 2, DA_HALF)),
        "da_k_norm": gain(ks[21], (N_EVEN, 2, DA_HALF)),
        "da_lambda": nrm(ks[22], (N_EVEN, 4, DA_HALF), 0.1),
        "da_subln": gain(ks[23], (N_EVEN, DA_VDIM)),
        "ssd_w_in": nrm(ks[24], (N_ODD, D_MODEL, ODD_IN), D_MODEL ** -0.5),
        "ssd_conv_w": nrm(ks[27], (N_ODD, CONV_W, D_XBC), CONV_W ** -0.5),
        "ssd_conv_b": nrm(ks[28], (N_ODD, D_XBC), 0.02),
        "ssd_dt_bias": ssd_dt_bias,
        "ssd_a_log": ssd_a_log,
        "ssd_d": gain(ks[29], (N_ODD, SSD_HEADS)),
        "ssd_norm_w": gain(ks[30], (N_ODD, D_INNER)),
        "ssd_w_out": nrm(ks[31], (N_ODD, D_INNER, D_MODEL), D_INNER ** -0.5),
        "ffn_w_in": nrm(ks[32], (DEPTH, D_MODEL, 2 * D_FF), D_MODEL ** -0.5),
        "ffn_w_out": nrm(ks[33], (DEPTH, D_FF, D_MODEL), D_FF ** -0.5),
    }


def reference(x_prompt, x_sample, c, cache_attn_k, cache_attn_v, state_lru, state_ssd, c_ctx,
              w_ada, b_ada, norm_g, lru_conv_w, lru_conv_b, lru_w_r, lru_b_r, lru_w_i, lru_b_i,
              lru_lambda, even_w_in, even_w_out, da_q_norm, da_k_norm, da_lambda, da_subln,
              ssd_w_in, ssd_conv_w, ssd_conv_b, ssd_dt_bias, ssd_a_log, ssd_d, ssd_norm_w,
              ssd_w_out, ffn_w_in, ffn_w_out):
    rope = axial_rope_tables(x_sample.shape[1])
    yp, ys = x_prompt, x_sample
    new_k, new_v, new_lru, new_ssd = [], [], [], []
    for i in range(DEPTH):
        j = i // 2
        mp = ada_params(c_ctx[None, :], w_ada[i], b_ada[i])
        ms = ada_params(c, w_ada[i], b_ada[i])
        hp = modulate(yp, norm_g[i, 0], mp[:, :, 0], mp[:, :, 1])
        hs = modulate(ys, norm_g[i, 0], ms[:, :, 0], ms[:, :, 1])
        if i % 2 == 0:
            lam_init = 0.8 - 0.6 * math.exp(-0.3 * i)
            ew = (even_w_in[j], even_w_out[j], lru_conv_w[j], lru_conv_b[j], lru_w_r[j], lru_b_r[j],
                  lru_w_i[j], lru_b_i[j], lru_lambda[j], da_q_norm[j], da_k_norm[j], da_lambda[j],
                  da_subln[j])
            op, (kc, vc, sc) = even_mixer(hp, None, None, lam_init, *ew)
            ctx = (cache_attn_k[:, j], cache_attn_v[:, j], state_lru[:, j])
            os_, _ = even_mixer(hs, ctx, rope, lam_init, *ew)
            new_k.append(kc)
            new_v.append(vc)
            new_lru.append(sc)
        else:
            ow = (ssd_w_in[j], ssd_conv_w[j], ssd_conv_b[j], ssd_dt_bias[j], ssd_a_log[j], ssd_d[j],
                  ssd_norm_w[j], ssd_w_out[j])
            op, sc = odd_mixer(hp, None, *ow)
            os_, _ = odd_mixer(hs, state_ssd[:, j], *ow)
            new_ssd.append(sc)
        yp = yp + mp[:, :, 2] * op
        ys = ys + ms[:, :, 2] * os_
        hp = modulate(yp, norm_g[i, 1], mp[:, :, 3], mp[:, :, 4])
        hs = modulate(ys, norm_g[i, 1], ms[:, :, 3], ms[:, :, 4])
        yp = yp + mp[:, :, 5] * swiglu(hp, ffn_w_in[i], ffn_w_out[i])
        ys = ys + ms[:, :, 5] * swiglu(hs, ffn_w_in[i], ffn_w_out[i])
    return (yp, ys, jnp.stack(new_k, axis=1), jnp.stack(new_v, axis=1),
            jnp.stack(new_lru, axis=1), jnp.stack(new_ssd, axis=1))
```

```cpp
#include <hip/hip_runtime.h>
#include <cstdio>
#include <cstdint>
namespace pg8 {
#define PG8_LAS __attribute__((address_space(3)))
typedef unsigned short bf16_t;
typedef short bf16x8 __attribute__((ext_vector_type(8)));
typedef float f32x4 __attribute__((ext_vector_type(4)));
typedef unsigned u32x4 __attribute__((ext_vector_type(4)));
constexpr int BM = 256, BK = 64, HALF = 128, HTB = HALF * BK * 2  , STAGE_BYTES = 8 * HTB, NXCD = 8, WGM = 8;

__host__ __device__ __forceinline__ int lds_byte(int r, int c) { const int st = (r >> 4) * 2 + (c >> 5), rr = r & 15, cc = c & 31, ob = rr * 64 + cc * 2; return st * 1024 + (ob ^ (((ob >> 9) & 1) << 5)); }
__host__ __device__ __forceinline__ void stage_rc(int b, int& R, int& C) { const int st = b / 1024, sb = b % 1024, swz = sb ^ (((sb >> 9) & 1) << 5); R = (st >> 1) * 16 + swz / 64; C = (st & 1) * 32 + (swz % 64) / 2; }
__host__ __device__ __forceinline__ int perm32(int rho) { const int n = rho >> 4, i = rho & 15; return 8 * (i >> 2) + 4 * n + (i & 3); }

struct Unit { int pm, pn; };
struct Gemm { const bf16_t* A; const bf16_t* Bt; int M, N, K; };

struct StaticOrder {
    int nM, nN, nwg, G, c;
    __host__ __device__ void init(int M, int N, int G_, int c_) { nM = M / BM; nN = N / BM; nwg = nM * nN; G = G_; c = c_; }
    __host__ __device__ bool next(int i, Unit& u) const {
        const long L = (long)i * G + c; if (L >= nwg) return false;
        int wgid = (int)L; { const int q = nwg / NXCD, r = nwg % NXCD, xcd = wgid % NXCD, off = wgid / NXCD; wgid = (xcd < r ? xcd * (q + 1) : r * (q + 1) + (xcd - r) * q) + off; }
        const int nig = WGM * nN, gid = wgid / nig, fm = gid * WGM, gsz = (nM - fm) < WGM ? (nM - fm) : WGM;
        u.pm = fm + ((wgid % nig) % gsz); u.pn = (wgid % nig) / gsz; return true;
    }
    __device__ __forceinline__ void a_ready(const Unit&) const {}
    __device__ __forceinline__ void done(const Unit&) const {}
};

__device__ __forceinline__ unsigned cvt_pk_bf16(float lo, float hi) { unsigned r; asm volatile("v_cvt_pk_bf16_f32 %0, %1, %2" : "=v"(r) : "v"(lo), "v"(hi)); return r; }
__device__ __forceinline__ float fast_sigmoid(float x) { return __builtin_amdgcn_rcpf(1.0f + __builtin_amdgcn_exp2f(-1.4426950408889634f * x)); }

struct EpiStore {
    static constexpr bool PERM = true, AFTER_DRAIN = false;
    bf16_t* O; int ldc;
    __device__ __forceinline__ void operator()(const f32x4 (&acc)[2][2][4][2], const Unit& u, int wr, int wc, int fr, int fq) const {
        const int row0 = u.pm * BM + wr * 64 + fr, col0 = u.pn * BM + wc * 32 + 8 * fq;
#pragma unroll
        for (int ai = 0; ai < 2; ++ai)
#pragma unroll
            for (int m = 0; m < 4; ++m) { bf16_t* rowp = O + (size_t)(row0 + ai * HALF + m * 16) * ldc + col0;
#pragma unroll
                for (int bj = 0; bj < 2; ++bj) { const f32x4 v0 = acc[ai][bj][m][0], v1 = acc[ai][bj][m][1];
                    u32x4 w; w.x = cvt_pk_bf16(v0[0], v0[1]); w.y = cvt_pk_bf16(v0[2], v0[3]); w.z = cvt_pk_bf16(v1[0], v1[1]); w.w = cvt_pk_bf16(v1[2], v1[3]);
                    *(u32x4*)(rowp + bj * HALF) = w; } }
    }
};
struct EpiOdd1 {
    static constexpr bool PERM = true, AFTER_DRAIN = false;
    bf16_t* Z; bf16_t* XBC; float* DTRAW;
    __device__ __forceinline__ void operator()(const f32x4 (&acc)[2][2][4][2], const Unit& u, int wr, int wc, int fr, int fq) const {
        const int row0 = u.pm * BM + wr * 64 + fr;
        if (u.pn >= 40) {
#pragma unroll
            for (int ai = 0; ai < 2; ++ai)
#pragma unroll
                for (int m = 0; m < 4; ++m) { float* rp = DTRAW + (size_t)(row0 + ai * HALF + m * 16) * 128 + wc * 32 + 8 * fq;
                    *(f32x4*)(rp) = acc[ai][0][m][0]; *(f32x4*)(rp + 4) = acc[ai][0][m][1]; }
            return;
        }
        bf16_t* base; int ldc, colt;
        if (u.pn < 16) { base = Z; ldc = 4096; colt = u.pn * BM; } else { base = XBC; ldc = 6144; colt = (u.pn - 16) * BM; }
        const int col0 = colt + wc * 32 + 8 * fq;
#pragma unroll
        for (int ai = 0; ai < 2; ++ai)
#pragma unroll
            for (int m = 0; m < 4; ++m) { bf16_t* rowp = base + (size_t)(row0 + ai * HALF + m * 16) * ldc + col0;
#pragma unroll
                for (int bj = 0; bj < 2; ++bj) { const f32x4 v0 = acc[ai][bj][m][0], v1 = acc[ai][bj][m][1];
                    u32x4 w; w.x = cvt_pk_bf16(v0[0], v0[1]); w.y = cvt_pk_bf16(v0[2], v0[3]); w.z = cvt_pk_bf16(v1[0], v1[1]); w.w = cvt_pk_bf16(v1[2], v1[3]);
                    *(u32x4*)(rowp + bj * HALF) = w; } }
    }
};
struct EpiSwiGLU {
    static constexpr bool PERM = true, AFTER_DRAIN = false;
    bf16_t* O; int ldc;
    __device__ __forceinline__ void operator()(const f32x4 (&acc)[2][2][4][2], const Unit& u, int wr, int wc, int fr, int fq) const {
        const int row0 = u.pm * BM + wr * 64 + fr, col0 = u.pn * HALF + wc * 32 + 8 * fq;
#pragma unroll
        for (int ai = 0; ai < 2; ++ai)
#pragma unroll
            for (int m = 0; m < 4; ++m) { bf16_t* rowp = O + (size_t)(row0 + ai * HALF + m * 16) * ldc + col0;
                float o[8];
#pragma unroll
                for (int n = 0; n < 2; ++n)
#pragma unroll
                    for (int j = 0; j < 4; ++j) { const float g = acc[ai][0][m][n][j], uu = acc[ai][1][m][n][j]; o[n * 4 + j] = g * fast_sigmoid(g) * uu; }
                u32x4 w; w.x = cvt_pk_bf16(o[0], o[1]); w.y = cvt_pk_bf16(o[2], o[3]); w.z = cvt_pk_bf16(o[4], o[5]); w.w = cvt_pk_bf16(o[6], o[7]);
                *(u32x4*)(rowp) = w; }
    }
};
struct EpiResid {
    static constexpr bool PERM = false, AFTER_DRAIN = false;
    float* Y; const float* gate;
    __device__ __forceinline__ void operator()(const f32x4 (&acc)[2][2][4][2], const Unit& u, int wr, int wc, int fr, int fq) const {
        const int row0 = u.pm * BM + wr * 64 + fr, col0 = u.pn * BM + wc * 32 + 4 * fq;
        const int cond = u.pm < 16 ? 0 : 1 + ((u.pm - 16) >> 3);
        const float* gp = gate + (size_t)cond * 12288 + col0;
        f32x4 gv[2][2];
#pragma unroll
        for (int bj = 0; bj < 2; ++bj)
#pragma unroll
            for (int n = 0; n < 2; ++n) gv[bj][n] = *(const f32x4*)(gp + bj * HALF + n * 16);
#pragma unroll
        for (int ai = 0; ai < 2; ++ai)
#pragma unroll
            for (int m = 0; m < 4; ++m) { float* rowp = Y + (size_t)(row0 + ai * HALF + m * 16) * 2048 + col0;
#pragma unroll
                for (int bj = 0; bj < 2; ++bj)
#pragma unroll
                    for (int n = 0; n < 2; ++n) { f32x4* p = (f32x4*)(rowp + bj * HALF + n * 16); *p = *p + gv[bj][n] * acc[ai][bj][m][n]; } }
    }
};

template <class Epi, class Sched, bool ALIGN_EPI = false, bool SP2 = false>
__device__ __forceinline__ void gemm_phase(PG8_LAS unsigned char* lds, const Gemm g, const Sched& S, const Epi& E) {
    int tid_ = threadIdx.x; asm volatile("" : "+v"(tid_)); const int tid = tid_, wid = __builtin_amdgcn_readfirstlane(tid >> 6), lane = tid & 63, wr = wid >> 2, wc = wid & 3, fr = lane & 15, fq = lane >> 4;
    const int K = g.K, nt = K / BK;
    unsigned voffA[2], voffB[2];
#pragma unroll
    for (int i = 0; i < 2; ++i) { int R, C; stage_rc(tid * 16 + i * 8192, R, C); const int Rb = Epi::PERM ? ((R & ~31) + perm32(R & 31)) : R;
        voffA[i] = (unsigned)(R * K + C) * 2u; voffB[i] = (unsigned)(Rb * K + C) * 2u; }
    const size_t kstep = (size_t)(BK * 2);
    const size_t hstep = (size_t)HALF * K * 2;
    const size_t tstep = 2 * hstep;
    const unsigned ldsw = (unsigned)wid * 1024u;
    const int aoff = lds_byte(wr * 64 + fr, fq * 8), boff = lds_byte(wc * 32 + fr, fq * 8);
#define PG8_SA(b, h) (((b) * 2 + (h)) * HTB)
#define PG8_SB(b, h) ((4 + (b) * 2 + (h)) * HTB)
#define PG8_STAGE(bufoff, gbase, voff) do { _Pragma("unroll") for (int _i = 0; _i < 2; ++_i) \
        __builtin_amdgcn_global_load_lds((const unsigned*)((const char*)(gbase) + (voff)[_i]), (PG8_LAS unsigned*)(lds + (bufoff) + ldsw + _i * 8192), 16, 0, 0); } while (0)
#define PG8_LDA(dst, b, h) do { _Pragma("unroll") for (int m = 0; m < 4; ++m) _Pragma("unroll") for (int k = 0; k < 2; ++k) dst[m][k] = *(const PG8_LAS bf16x8*)(lds + PG8_SA(b, h) + aoff + m * 2048 + k * 1024); } while (0)
#define PG8_LDB(dst, b, h) do { _Pragma("unroll") for (int n = 0; n < 2; ++n) _Pragma("unroll") for (int k = 0; k < 2; ++k) dst[n][k] = *(const PG8_LAS bf16x8*)(lds + PG8_SB(b, h) + boff + n * 2048 + k * 1024); } while (0)
#define PG8_MMA(ai, bj, At, Bt) do { __builtin_amdgcn_s_setprio(1); _Pragma("unroll") for (int m = 0; m < 4; ++m) _Pragma("unroll") for (int n = 0; n < 2; ++n) _Pragma("unroll") for (int k = 0; k < 2; ++k) \
        acc[ai][bj][m][n] = __builtin_amdgcn_mfma_f32_16x16x32_bf16(Bt[n][k], At[m][k], acc[ai][bj][m][n], 0, 0, 0); __builtin_amdgcn_s_setprio(0); } while (0)
#define PG8_WAIT_V(n) asm volatile("s_waitcnt vmcnt(" #n ")" ::: "memory")
#define PG8_WAIT_L(n) asm volatile("s_waitcnt lgkmcnt(" #n ")" ::: "memory")
#define PG8_BAR __builtin_amdgcn_s_barrier()
#define PG8_SCHED __builtin_amdgcn_sched_barrier(0)
    Unit cur, nxt; int ui = 0;
    if (!S.next(0, cur)) return;
    f32x4 acc[2][2][4][2];
#pragma unroll
    for (int a = 0; a < 2; ++a)
#pragma unroll
        for (int b = 0; b < 2; ++b)
#pragma unroll
            for (int m = 0; m < 4; ++m)
#pragma unroll
                for (int n = 0; n < 2; ++n) acc[a][b][m][n] = (f32x4){0.f, 0.f, 0.f, 0.f};
    bf16x8 At[4][2], B0[2][2], B1[2][2];
    const char* cA = (const char*)g.A + (size_t)cur.pm * tstep; const char* cB = (const char*)g.Bt + (size_t)cur.pn * tstep;
    S.a_ready(cur);
    if constexpr (SP2) {
        PG8_STAGE(PG8_SB(0, 0), cB, voffB); PG8_STAGE(PG8_SB(0, 1), cB + hstep, voffB); PG8_STAGE(PG8_SA(0, 0), cA, voffA); PG8_STAGE(PG8_SA(0, 1), cA + hstep, voffA);
        if (wr == 1) PG8_BAR;
        PG8_WAIT_V(2); PG8_BAR;
        PG8_STAGE(PG8_SB(1, 0), cB + kstep, voffB); PG8_STAGE(PG8_SA(1, 0), cA + kstep, voffA); PG8_STAGE(PG8_SB(1, 1), cB + hstep + kstep, voffB);
        PG8_WAIT_V(6); PG8_BAR;
    } else {
        PG8_STAGE(PG8_SB(0, 0), cB, voffB); PG8_STAGE(PG8_SA(0, 0), cA, voffA); PG8_STAGE(PG8_SB(0, 1), cB + hstep, voffB); PG8_STAGE(PG8_SA(0, 1), cA + hstep, voffA);
        if (wr == 1) PG8_BAR;
        PG8_WAIT_V(4); PG8_BAR;
        PG8_STAGE(PG8_SB(1, 0), cB + kstep, voffB); PG8_STAGE(PG8_SA(1, 0), cA + kstep, voffA); PG8_STAGE(PG8_SB(1, 1), cB + hstep + kstep, voffB);
        PG8_WAIT_V(6); PG8_BAR;
    }
    for (;;) {
        const bool has_next = S.next(ui + 1, nxt);
        const char* nA = has_next ? (const char*)g.A + (size_t)nxt.pm * tstep : cA; const char* nB = has_next ? (const char*)g.Bt + (size_t)nxt.pn * tstep : cB;
        for (int t = 0; t < nt; t += 2) {
            const bool last = (t == nt - 2);
            const char* a1 = cA + (size_t)(t + 1) * kstep;
            const char* a2 = last ? nA : cA + (size_t)(t + 2) * kstep; const char* b2 = last ? nB : cB + (size_t)(t + 2) * kstep;
            const char* a3 = a2 + kstep; const char* b3 = b2 + kstep;
            if (last && has_next) S.a_ready(nxt);
            if constexpr (SP2) {
            PG8_LDB(B0, 0, 0); PG8_LDB(B1, 0, 1); PG8_SCHED; PG8_LDA(At, 0, 0); PG8_STAGE(PG8_SA(1, 1), a1 + hstep, voffA);
            PG8_WAIT_V(8); PG8_WAIT_L(0); PG8_BAR; PG8_MMA(0, 0, At, B0); PG8_MMA(0, 1, At, B1); PG8_BAR; PG8_SCHED;
            PG8_LDA(At, 0, 1); PG8_STAGE(PG8_SB(0, 0), b2, voffB); PG8_STAGE(PG8_SB(0, 1), b2 + hstep, voffB); PG8_STAGE(PG8_SA(0, 0), a2, voffA);
            PG8_WAIT_V(8); PG8_WAIT_L(0); PG8_BAR; PG8_MMA(1, 0, At, B0); PG8_MMA(1, 1, At, B1); PG8_BAR; PG8_SCHED;
            PG8_LDB(B0, 1, 0); PG8_LDB(B1, 1, 1); PG8_SCHED; PG8_LDA(At, 1, 0); PG8_STAGE(PG8_SA(0, 1), a2 + hstep, voffA);
            PG8_WAIT_V(8); PG8_WAIT_L(0); PG8_BAR; PG8_MMA(0, 0, At, B0); PG8_MMA(0, 1, At, B1); PG8_BAR; PG8_SCHED;
            PG8_LDA(At, 1, 1); PG8_STAGE(PG8_SB(1, 0), b3, voffB); PG8_STAGE(PG8_SB(1, 1), b3 + hstep, voffB); PG8_STAGE(PG8_SA(1, 0), a3, voffA);
            PG8_WAIT_V(8); PG8_WAIT_L(0); PG8_BAR; PG8_MMA(1, 0, At, B0); PG8_MMA(1, 1, At, B1); PG8_BAR; PG8_SCHED;
            } else {
            PG8_LDB(B0, 0, 0); PG8_SCHED; PG8_LDA(At, 0, 0); PG8_STAGE(PG8_SA(1, 1), a1 + hstep, voffA);
            PG8_WAIT_L(8); PG8_BAR; PG8_WAIT_L(0); PG8_MMA(0, 0, At, B0); PG8_BAR; PG8_SCHED;
            PG8_LDB(B1, 0, 1); PG8_STAGE(PG8_SB(0, 0), b2, voffB);
            PG8_BAR; PG8_WAIT_L(0); PG8_MMA(0, 1, At, B1); PG8_BAR;
            PG8_LDA(At, 0, 1); PG8_STAGE(PG8_SA(0, 0), a2, voffA);
            PG8_BAR; PG8_WAIT_L(0); PG8_MMA(1, 0, At, B0); PG8_BAR; PG8_SCHED;
            PG8_STAGE(PG8_SB(0, 1), b2 + hstep, voffB);
            PG8_WAIT_V(6); PG8_BAR; PG8_MMA(1, 1, At, B1); PG8_BAR;
            PG8_LDB(B0, 1, 0); PG8_SCHED; PG8_LDA(At, 1, 0); PG8_STAGE(PG8_SA(0, 1), a2 + hstep, voffA);
            PG8_WAIT_L(8); PG8_BAR; PG8_WAIT_L(0); PG8_MMA(0, 0, At, B0); PG8_BAR; PG8_SCHED;
            PG8_LDB(B1, 1, 1); PG8_STAGE(PG8_SB(1, 0), b3, voffB);
            PG8_BAR; PG8_WAIT_L(0); PG8_MMA(0, 1, At, B1); PG8_BAR;
            PG8_LDA(At, 1, 1); PG8_STAGE(PG8_SA(1, 0), a3, voffA);
            PG8_BAR; PG8_WAIT_L(0); PG8_MMA(1, 0, At, B0); PG8_BAR; PG8_SCHED;
            PG8_STAGE(PG8_SB(1, 1), b3 + hstep, voffB);
            PG8_WAIT_V(6); PG8_BAR; PG8_MMA(1, 1, At, B1); PG8_BAR;
            }
        }
        if constexpr (ALIGN_EPI) { if (wr == 0) PG8_BAR; }
        if constexpr (!Epi::AFTER_DRAIN) { E(acc, cur, wr, wc, fr, fq); S.done(cur); }
        if (!has_next) break;
#pragma unroll
        for (int a = 0; a < 2; ++a)
#pragma unroll
            for (int b = 0; b < 2; ++b)
#pragma unroll
                for (int m = 0; m < 4; ++m)
#pragma unroll
                    for (int n = 0; n < 2; ++n) acc[a][b][m][n] = (f32x4){0.f, 0.f, 0.f, 0.f};
        cur = nxt; cA = nA; cB = nB; ++ui;
        if constexpr (ALIGN_EPI) { if (wr == 1) PG8_BAR; }
    }
    PG8_WAIT_V(0);
    if constexpr (!ALIGN_EPI) { if (wr == 0) PG8_BAR; }
    PG8_BAR;
    if constexpr (Epi::AFTER_DRAIN) { E.fused(acc, cur, wr, wc, fr, fq, lds, wid, lane); S.done(cur); }
#undef PG8_SA
#undef PG8_SB
#undef PG8_STAGE
#undef PG8_LDA
#undef PG8_LDB
#undef PG8_MMA
#undef PG8_WAIT_V
#undef PG8_WAIT_L
#undef PG8_BAR
#undef PG8_SCHED
}
}

#define GAS __attribute__((address_space(1)))
#define LAS __attribute__((address_space(3)))
typedef unsigned short bf16_t;
typedef short bf16x8 __attribute__((ext_vector_type(8)));
typedef short bf16x4 __attribute__((ext_vector_type(4)));
typedef float f32x4 __attribute__((ext_vector_type(4)));
typedef float f32x2 __attribute__((ext_vector_type(2)));
typedef unsigned u32x4 __attribute__((ext_vector_type(4)));
typedef unsigned u32x2 __attribute__((ext_vector_type(2)));
#define MFMA16(a, b, c) __builtin_amdgcn_mfma_f32_16x16x32_bf16((a), (b), (c), 0, 0, 0)

constexpr int D = 2048, T = 20480, TP = 4096, NT = 80;
constexpr float EPS = 1e-6f;
constexpr size_t MiB = 1u << 20;
constexpr size_t WS_CTL = 0, WS_ADA = 1 * MiB, WS_ZERO_BYTES = 3 * MiB;
constexpr size_t WS_ROPE = 3 * MiB, WS_LRUW = 4 * MiB, WS_CHS = 6 * MiB;
constexpr size_t WS_WEIN = 16 * MiB, WS_WEOUT = 56 * MiB, WS_WSIN = 72 * MiB, WS_WSOUT = 154 * MiB, WS_WFIN = 186 * MiB, WS_WFOUT = 362 * MiB;
constexpr size_t WS_H = 450 * MiB, WS_R1 = 530 * MiB, WS_R2 = 770 * MiB, WS_R3 = 930 * MiB, WS_R4 = 1090 * MiB, WS_R5 = 1210 * MiB, WS_END = 1242 * MiB;
constexpr size_t WS_U5 = WS_R1, WS_Q = WS_R2, WS_K = WS_R2 + 40 * MiB, WS_KC = WS_R2 + 80 * MiB, WS_VTP = WS_R2 + 84 * MiB, WS_VTS = WS_R2 + 92 * MiB, WS_MIXE = WS_R3;
constexpr size_t WS_XBC = WS_R1, WS_Z = WS_R2, WS_XT = WS_R3, WS_BN = WS_R4, WS_BT = WS_R4 + 40 * MiB, WS_CN = WS_R4 + 80 * MiB, WS_DTRAW = WS_R5;
constexpr size_t WS_SIN = WS_H, WS_MIXO = WS_R1 + 80 * MiB;
constexpr size_t WS_HID = WS_R1;
constexpr size_t OUT_K = 41943040, OUT_V = 50331648, OUT_LRU = 58720256, OUT_SSD = 58785792;
constexpr int LDS_MISC = 131072, LDS_BYTES = 131072 + 1024;

struct Args { const float* in[34]; float* out; unsigned char* ws; int ph_lo, ph_hi; };

__device__ __forceinline__ float bf2f(unsigned short b) { return __uint_as_float(((unsigned)b) << 16); }
__device__ __forceinline__ float bflo(unsigned w) { return __uint_as_float(w << 16); }
__device__ __forceinline__ float bfhi(unsigned w) { return __uint_as_float(w & 0xffff0000u); }
__device__ __forceinline__ unsigned pk2(float lo, float hi) { return pg8::cvt_pk_bf16(lo, hi); }
__device__ __forceinline__ float fexp(float x) { return __builtin_amdgcn_exp2f(1.4426950408889634f * x); }
__device__ __forceinline__ float fsigmoid(float x) { return __builtin_amdgcn_rcpf(1.0f + __builtin_amdgcn_exp2f(-1.4426950408889634f * x)); }
__device__ __forceinline__ float fsilu(float x) { return x * fsigmoid(x); }
__device__ __forceinline__ float fsoftplus(float x) { return fmaxf(x, 0.f) + log1pf(fexp(-fabsf(x))); }
__device__ __forceinline__ float fgelu_tanh(float x) { const float u = 0.7978845608028654f * (x + 0.044715f * x * x * x); const float t = 1.f - 2.f * __builtin_amdgcn_rcpf(fexp(2.f * u) + 1.f); return 0.5f * x * (1.f + t); }
__device__ __forceinline__ float wave_sum(float v) {
#pragma unroll
    for (int o = 1; o < 64; o <<= 1) v += __shfl_xor(v, o);
    return v;
}
__device__ __forceinline__ void unpack8(const u32x4 v, float (&f)[8]) { f[0] = bflo(v.x); f[1] = bfhi(v.x); f[2] = bflo(v.y); f[3] = bfhi(v.y); f[4] = bflo(v.z); f[5] = bfhi(v.z); f[6] = bflo(v.w); f[7] = bfhi(v.w); }
__device__ __forceinline__ u32x4 pack8(const float (&f)[8]) { u32x4 w; w.x = pk2(f[0], f[1]); w.y = pk2(f[2], f[3]); w.z = pk2(f[4], f[5]); w.w = pk2(f[6], f[7]); return w; }
__device__ __forceinline__ bf16x8 as_bf16x8(u32x4 v) { return __builtin_bit_cast(bf16x8, v); }
__device__ __forceinline__ int cond_of_tok(int t) { return t < TP ? 0 : 1 + ((t - TP) >> 11); }
__device__ __forceinline__ int otid() { int t = threadIdx.x; asm volatile("" : "+v"(t)); return t; }
#define WG_SYNC() __syncthreads()
#ifndef DBG_SUB
#define DBG_SUB 3
#endif

#define XB_TMO      128
#define XB_XCNT(j)  (256  + 64 * (j))
#define XB_XSUB(j)  (1280 + 64 * (j))
#define XB_XGEN(j)  (2304 + 64 * (j))
#define XB_TOP      3328
#define XB_TOPGEN   3392
#define XCD_BAR_WORDS 3456
#define XB_SPIN_CAP (1u << 18)

__device__ __forceinline__ unsigned xb_ld(unsigned* p)              { return __hip_atomic_load(p, __ATOMIC_RELAXED, __HIP_MEMORY_SCOPE_AGENT); }
__device__ __forceinline__ unsigned xb_add(unsigned* p, unsigned v) { return __hip_atomic_fetch_add(p, v, __ATOMIC_RELAXED, __HIP_MEMORY_SCOPE_AGENT); }
__device__ __forceinline__ unsigned xb_xcc_id() { return (unsigned)__builtin_amdgcn_s_getreg((3 << 11) | 20) & 0xFu; }
#define XB_SPIN(cond, bar) do { unsigned _sp = 0; while (cond) { __builtin_amdgcn_s_sleep(1); \
    if ((++_sp & 255u) == 0u) { if (xb_ld(&(bar)[XB_TMO])) break; if (_sp > XB_SPIN_CAP) { atomicAdd(&(bar)[XB_TMO], 1u); break; } } } } while (0)

struct XcdBarrier {
    unsigned* bar; unsigned x;
    volatile LAS unsigned* st;
};

__device__ __forceinline__ XcdBarrier xcd_barrier_post(unsigned* bar, volatile LAS unsigned* st) {
    XcdBarrier b; b.bar = bar; b.x = xb_xcc_id(); b.st = st;
    if (threadIdx.x == 0) (void)xb_add(&bar[XB_XCNT(b.x)], 1u);
    return b;
}
__device__ __forceinline__ void xcd_barrier_complete(unsigned* bar, unsigned x, unsigned& nloc, unsigned& nx) {
    const unsigned G = gridDim.x * gridDim.y * gridDim.z;
    unsigned sum, cnt, mine, sp = 0u;
    for (;;) {
        sum = 0u; cnt = 0u; mine = 0u;
#pragma unroll
        for (unsigned j = 0; j < 16; ++j) { const unsigned c = xb_ld(&bar[XB_XCNT(j)]); sum += c; cnt += (c > 0u) ? 1u : 0u; mine = (j == x) ? c : mine; }
        if (sum == G) break;
        __builtin_amdgcn_s_sleep(1);
        if ((++sp & 255u) == 0u) { if (xb_ld(&bar[XB_TMO])) break; if (sp > XB_SPIN_CAP) { atomicAdd(&bar[XB_TMO], 1u); break; } }
    }
    nloc = mine > 0u ? mine : 1u; nx = cnt > 0u ? cnt : 1u;
}

__device__ __forceinline__ void xcd_barrier(const XcdBarrier& b) {
    asm volatile("s_waitcnt vmcnt(0)" ::: "memory");
    __syncthreads();
    if (threadIdx.x == 0) {
        unsigned* bar = b.bar;
        __builtin_amdgcn_s_waitcnt(0);
        unsigned nloc = b.st[0], nx = b.st[1];
        if (nloc == 0u) { xcd_barrier_complete(bar, b.x, nloc, nx); b.st[0] = nloc; b.st[1] = nx; }
        const unsigned old = xb_add(&bar[XB_XSUB(b.x)], 1u);
        const unsigned gen = old / nloc;
        if (old + 1u == (gen + 1u) * nloc) {
            __builtin_amdgcn_fence(__ATOMIC_RELEASE, "agent");
            asm volatile("s_waitcnt vmcnt(0)" ::: "memory");
            const unsigned og = xb_add(&bar[XB_TOP], 1u);
            const unsigned tg = og / nx;
            if (og + 1u == (tg + 1u) * nx) xb_add(&bar[XB_TOPGEN], 1u);
            else XB_SPIN(xb_ld(&bar[XB_TOPGEN]) == tg, bar);
            __builtin_amdgcn_fence(__ATOMIC_ACQUIRE, "agent");
            xb_add(&bar[XB_XGEN(b.x)], 1u);
            asm volatile("s_waitcnt vmcnt(0)" ::: "memory");
        } else {
            XB_SPIN(xb_ld(&bar[XB_XGEN(b.x)]) == gen, bar);
            __builtin_amdgcn_fence(__ATOMIC_ACQUIRE, "agent");
            asm volatile("s_waitcnt vmcnt(0)" ::: "memory");
        }
    }
    __syncthreads();
}

__device__ __forceinline__ void transpose_item(const float* W, int N, bf16_t* WT, int ldk, int k0, int n0, int drow0, LAS float* scr, int lane) {
#pragma unroll 8
    for (int i = 0; i < 32; ++i) { const int kk = 2 * i + (lane >> 5); scr[kk * 33 + (lane & 31)] = W[(size_t)(k0 + kk) * N + n0 + (lane & 31)]; }
    asm volatile("s_waitcnt lgkmcnt(0)" ::: "memory");
    const int c = lane & 7;
#pragma unroll
    for (int jj = 0; jj < 4; ++jj) { const int n = (lane >> 3) + 8 * jj; const LAS float* s = scr + (8 * c) * 33 + n;
        u32x4 o; o.x = pk2(s[0 * 33], s[1 * 33]); o.y = pk2(s[2 * 33], s[3 * 33]); o.z = pk2(s[4 * 33], s[5 * 33]); o.w = pk2(s[6 * 33], s[7 * 33]);
        *(u32x4*)(WT + (size_t)(drow0 + n) * ldk + k0 + 8 * c) = o; }
    asm volatile("s_waitcnt lgkmcnt(0)" ::: "memory");
}

__device__ __forceinline__ void phase_prologue(const Args& A, LAS unsigned char* lds) {
    const int tid = otid(), lane = tid & 63, wave = tid >> 6;
    unsigned char* ws = A.ws;
    {
        LAS float* s = (LAS float*)lds;
        for (int idx = tid; idx < 9 * 2048; idx += 512) { const int cnd = idx >> 11, k = idx & 2047; const float v = cnd == 0 ? A.in[7][k] : A.in[2][(cnd - 1) * 2048 + k]; s[k * 12 + cnd] = v * fsigmoid(v); }
        WG_SYNC();
        float* ADA = (float*)(ws + WS_ADA);
        LAS float* red = (LAS float*)(lds + 98304);
        for (int it = blockIdx.x; it < 4 * 192; it += gridDim.x) {
            const int layer = it / 192, cg = it - layer * 192, col = cg * 64 + lane;
            float acc[9];
#pragma unroll
            for (int c = 0; c < 9; ++c) acc[c] = 0.f;
            const float* w = A.in[8] + ((size_t)layer * 2048 + wave * 256) * 12288 + col;
#pragma unroll 8
            for (int k = 0; k < 256; ++k) {
                const float wv = w[(size_t)k * 12288];
                const LAS f32x4* sp = (const LAS f32x4*)(s + (wave * 256 + k) * 12);
                const f32x4 s0 = sp[0], s1 = sp[1], s2 = sp[2];
                acc[0] += s0[0] * wv; acc[1] += s0[1] * wv; acc[2] += s0[2] * wv; acc[3] += s0[3] * wv;
                acc[4] += s1[0] * wv; acc[5] += s1[1] * wv; acc[6] += s1[2] * wv; acc[7] += s1[3] * wv; acc[8] += s2[0] * wv;
            }
            WG_SYNC();
#pragma unroll
            for (int c = 0; c < 9; ++c) red[(wave * 9 + c) * 64 + lane] = acc[c];
            WG_SYNC();
            for (int idx = tid; idx < 9 * 64; idx += 512) { const int c = idx >> 6, l = idx & 63; float v = A.in[9][(size_t)layer * 12288 + cg * 64 + l];
#pragma unroll
                for (int wv_ = 0; wv_ < 8; ++wv_) v += red[(wv_ * 9 + c) * 64 + l];
                ADA[((size_t)layer * 9 + c) * 12288 + cg * 64 + l] = v; }
        }
        WG_SYNC();
    }
    {
        float* rope = (float*)(ws + WS_ROPE);
        for (int idx = blockIdx.x * 512 + tid; idx < 2048 * 64; idx += gridDim.x * 512) {
            const int pos = idx >> 6, d = idx & 63, qtr = d >> 4, i = d & 15;
            const float inv = __builtin_amdgcn_exp2f(-(float)i * (13.287712379549449f / 16.0f));
            const float p = (qtr < 2) ? (float)(pos >> 6) : (float)(pos & 63);
            const float rev = p * inv * 0.15915494309189535f;
            rope[idx] = __builtin_amdgcn_cosf(rev); rope[2048 * 64 + idx] = __builtin_amdgcn_sinf(rev);
        }
    }
    {
        LAS float* scr = (LAS float*)(lds + wave * 16384);
        const int gw = blockIdx.x * 8 + wave, NGW = gridDim.x * 8;
        constexpr int I_EIN = 32 * 160, I_EOUT = 32 * 64, I_SIN = 32 * 324, I_SOUT = 64 * 64, I_FIN = 32 * 352, I_FOUT = 88 * 64, I_LRU = 8;
        constexpr int N0 = 2 * I_EIN, N1 = N0 + 2 * I_EOUT, N2 = N1 + 2 * I_SIN, N3 = N2 + 2 * I_SOUT, N4 = N3 + 4 * I_FIN, N5 = N4 + 4 * I_FOUT, N6 = N5 + 64 * I_LRU;
        for (int it = gw; it < N6; it += NGW) {
            if (it < N0) { const int mtx = it / I_EIN, r = it - mtx * I_EIN, kb = r / 160, nb = r - kb * 160;
                transpose_item(A.in[18] + (size_t)mtx * 2048 * 5120, 5120, (bf16_t*)(ws + WS_WEIN) + (size_t)mtx * 5120 * 2048, 2048, kb * 64, nb * 32, nb * 32, scr, lane); }
            else if (it < N1) { const int q = it - N0, mtx = q / I_EOUT, r = q - mtx * I_EOUT, kb = r / 64, nb = r - kb * 64;
                transpose_item(A.in[19] + (size_t)mtx * 2048 * 2048, 2048, (bf16_t*)(ws + WS_WEOUT) + (size_t)mtx * 2048 * 2048, 2048, kb * 64, nb * 32, nb * 32, scr, lane); }
            else if (it < N2) { const int q = it - N1, mtx = q / I_SIN, r = q - mtx * I_SIN, kb = r / 324, nb = r - kb * 324;
                transpose_item(A.in[24] + (size_t)mtx * 2048 * 10368, 10368, (bf16_t*)(ws + WS_WSIN) + (size_t)mtx * 10496 * 2048, 2048, kb * 64, nb * 32, nb * 32, scr, lane); }
            else if (it < N3) { const int q = it - N2, mtx = q / I_SOUT, r = q - mtx * I_SOUT, kb = r / 64, nb = r - kb * 64;
                transpose_item(A.in[31] + (size_t)mtx * 4096 * 2048, 2048, (bf16_t*)(ws + WS_WSOUT) + (size_t)mtx * 2048 * 4096, 4096, kb * 64, nb * 32, nb * 32, scr, lane); }
            else if (it < N4) { const int q = it - N3, mtx = q / I_FIN, r = q - mtx * I_FIN, kb = r / 352, nb = r - kb * 352;
                const int n0 = nb * 32; const int drow = n0 < 5632 ? (n0 >> 7) * 256 + (n0 & 127) : ((n0 - 5632) >> 7) * 256 + 128 + ((n0 - 5632) & 127);
                transpose_item(A.in[32] + (size_t)mtx * 2048 * 11264, 11264, (bf16_t*)(ws + WS_WFIN) + (size_t)mtx * 11264 * 2048, 2048, kb * 64, n0, drow, scr, lane); }
            else if (it < N5) { const int q = it - N4, mtx = q / I_FOUT, r = q - mtx * I_FOUT, kb = r / 64, nb = r - kb * 64;
                transpose_item(A.in[33] + (size_t)mtx * 5632 * 2048, 2048, (bf16_t*)(ws + WS_WFOUT) + (size_t)mtx * 2048 * 5632, 5632, kb * 64, nb * 32, nb * 32, scr, lane); }
            else { const int q = it - N5, mtx = q >> 3, r = q & 7, kb = r >> 2, nb = r & 3;
                const int blk = mtx & 7, gate = (mtx >> 3) & 1, jd = mtx >> 4;
                const float* src = (gate ? A.in[15] : A.in[13]) + ((size_t)jd * 8 + blk) * 16384;
                transpose_item(src, 128, (bf16_t*)(ws + WS_LRUW) + (size_t)mtx * 16384, 128, kb * 64, nb * 32, nb * 32, scr, lane); }
        }
        for (int idx = blockIdx.x * 512 + tid; idx < 2 * 128 * 2048 / 8; idx += gridDim.x * 512) {
            const int mtx = idx / (128 * 256), r = idx - mtx * (128 * 256);
            *(u32x4*)((bf16_t*)(ws + WS_WSIN) + (size_t)mtx * 10496 * 2048 + (size_t)10368 * 2048 + (size_t)r * 8) = (u32x4){0u, 0u, 0u, 0u};
        }
    }
}

__device__ __forceinline__ void phase_modulate(const Args& A, int layer, int which) {
    const int tid = otid(), lane = tid & 63, wave = tid >> 6;
    const int gw = blockIdx.x * 8 + wave, NGW = gridDim.x * 8;
    const float* g = A.in[10] + ((size_t)layer * 2 + which) * 2048;
    const float* ADA = (const float*)(A.ws + WS_ADA);
    bf16_t* H = (bf16_t*)(A.ws + WS_H);
    for (int row = gw; row < T; row += NGW) {
        const int cond = cond_of_tok(row);
        const float* shift = ADA + ((size_t)layer * 9 + cond) * 12288 + (which * 3 + 0) * 2048;
        const float* scale = shift + 2048;
        const f32x4* xr = (const f32x4*)(A.out + (size_t)row * 2048) + lane;
        f32x4 v[8]; float ss = 0.f;
#pragma unroll
        for (int jj = 0; jj < 8; ++jj) { v[jj] = xr[64 * jj]; ss += (v[jj][0] * v[jj][0] + v[jj][1] * v[jj][1]) + (v[jj][2] * v[jj][2] + v[jj][3] * v[jj][3]); }
        const float rstd = 1.0f / sqrtf(wave_sum(ss) * (1.f / 2048.f) + EPS);
        u32x2* o8 = (u32x2*)(H + (size_t)row * 2048) + lane;
#pragma unroll
        for (int jj = 0; jj < 8; ++jj) { const int c = 4 * lane + 256 * jj;
            const f32x4 gg = *(const f32x4*)(g + c), sc = *(const f32x4*)(scale + c), sh = *(const f32x4*)(shift + c);
            f32x4 o = v[jj] * rstd * gg * (sc + 1.0f) + sh;
            u32x2 w; w.x = pk2(o[0], o[1]); w.y = pk2(o[2], o[3]); o8[64 * jj] = w; }
    }
}

constexpr float QSCALE = 0.125f * 1.4426950408889634f;

template <bool F32SRC>
__device__ __forceinline__ void vt_tile(const void* src, size_t src_ld, bf16_t* dst, int Lk, LAS bf16_t* scr  , int lane) {
#pragma unroll 4
    for (int i = 0; i < 16; ++i) { const int p = lane + 64 * i, row = p >> 4, pc = p & 15;
        u32x4 v;
        if (F32SRC) { const float* s = (const float*)src + (size_t)row * src_ld + pc * 8; const f32x4 a = *(const f32x4*)s, b = *(const f32x4*)(s + 4);
            v.x = pk2(a[0], a[1]); v.y = pk2(a[2], a[3]); v.z = pk2(b[0], b[1]); v.w = pk2(b[2], b[3]); }
        else v = *(const u32x4*)((const bf16_t*)src + (size_t)row * src_ld + pc * 8);
        *(LAS u32x4*)(scr + row * 128 + pc * 8) = v; }
    asm volatile("s_waitcnt lgkmcnt(0)" ::: "memory");
#pragma unroll 4
    for (int i = 0; i < 16; ++i) { const int p = lane + 64 * i, dv = p & 127, tg = p >> 7;
        unsigned short e[8];
#pragma unroll
        for (int k = 0; k < 8; ++k) e[k] = scr[(8 * tg + k) * 128 + dv];
        u32x4 v; v.x = e[0] | ((unsigned)e[1] << 16); v.y = e[2] | ((unsigned)e[3] << 16); v.z = e[4] | ((unsigned)e[5] << 16); v.w = e[6] | ((unsigned)e[7] << 16);
        *(u32x4*)(dst + (size_t)dv * Lk + 8 * tg) = v; }
    asm volatile("s_waitcnt lgkmcnt(0)" ::: "memory");
}

__device__ __forceinline__ void phase_qkv_prep(const Args& A, LAS unsigned char* lds, int j) {
    const int tid = otid(), lane = tid & 63, wave = tid >> 6;
    unsigned char* ws = A.ws;
    const bf16_t* U5 = (const bf16_t*)(ws + WS_U5);
    bf16_t* Qb = (bf16_t*)(ws + WS_Q); bf16_t* Kb = (bf16_t*)(ws + WS_K); bf16_t* KC = (bf16_t*)(ws + WS_KC);
    bf16_t* VTP = (bf16_t*)(ws + WS_VTP); bf16_t* VTS = (bf16_t*)(ws + WS_VTS);
    const float* rope = (const float*)(ws + WS_ROPE);
    LAS bf16_t* scr = (LAS bf16_t*)(lds + wave * 16384);
    const int mq = (lane >> 2) & 1, aq = lane & 3;
    float qn[16], kn[16];
#pragma unroll
    for (int i = 0; i < 16; ++i) { qn[i] = A.in[20][((size_t)j * 2 + mq) * 64 + aq * 16 + i]; kn[i] = A.in[21][((size_t)j * 2 + mq) * 64 + aq * 16 + i]; }
    for (int u = blockIdx.x; u < 320 + 32; u += gridDim.x) {
        if (u < 320) {
            const int t0 = u * 64;
            const int sample = t0 >= TP, b = sample ? (t0 - TP) >> 11 : t0 >> 8, l0 = sample ? (t0 - TP) & 2047 : t0 & 255;
            for (int tt = 0; tt < 8; ++tt) {
                const int tok = wave * 8 + tt, t = t0 + tok, l = l0 + tok;
                float cs[16], sn[16];
                if (sample) {
#pragma unroll
                    for (int i = 0; i < 16; i += 4) { const f32x4 c4 = *(const f32x4*)(rope + (size_t)l * 64 + aq * 16 + i), s4 = *(const f32x4*)(rope + 2048 * 64 + (size_t)l * 64 + aq * 16 + i);
                        cs[i] = c4[0]; cs[i + 1] = c4[1]; cs[i + 2] = c4[2]; cs[i + 3] = c4[3]; sn[i] = s4[0]; sn[i + 1] = s4[1]; sn[i + 2] = s4[2]; sn[i + 3] = s4[3]; }
                }
#pragma unroll
                for (int qk = 0; qk < 2; ++qk) {
                    const bf16_t* src = U5 + (size_t)t * 5120 + (qk == 0 ? 2048 : 3072) + 16 * lane;
                    float x[16]; { float a[8], c[8]; unpack8(*(const u32x4*)src, a); unpack8(*(const u32x4*)(src + 8), c);
#pragma unroll
                        for (int i = 0; i < 8; ++i) { x[i] = a[i]; x[8 + i] = c[i]; } }
                    float ss = 0.f;
#pragma unroll
                    for (int i = 0; i < 16; ++i) ss += x[i] * x[i];
                    ss += __shfl_xor(ss, 1); ss += __shfl_xor(ss, 2);
                    const float rstd = 1.0f / sqrtf(ss * (1.f / 64.f) + EPS);
#pragma unroll
                    for (int i = 0; i < 16; ++i) x[i] = x[i] * rstd * (qk == 0 ? qn[i] : kn[i]);
                    if (qk == 1 && !sample) {
                        float* o = A.out + OUT_K + (((size_t)b * 2 + j) * 256 + l) * 1024 + 16 * lane;
#pragma unroll
                        for (int i = 0; i < 16; i += 4) *(f32x4*)(o + i) = (f32x4){x[i], x[i + 1], x[i + 2], x[i + 3]};
                    }
                    if (sample) {
#pragma unroll
                        for (int i = 0; i < 16; ++i) { const float partner = __shfl_xor(x[i], 1); x[i] = (aq & 1) ? (x[i] * cs[i] + partner * sn[i]) : (x[i] * cs[i] - partner * sn[i]); }
                    }
                    if (qk == 0) {
#pragma unroll
                        for (int i = 0; i < 16; ++i) x[i] *= QSCALE;
                    }
                    bf16_t* dst = (qk == 0 ? Qb : Kb) + (size_t)t * 1024 + 16 * lane;
                    u32x4 w0, w1; w0.x = pk2(x[0], x[1]); w0.y = pk2(x[2], x[3]); w0.z = pk2(x[4], x[5]); w0.w = pk2(x[6], x[7]);
                    w1.x = pk2(x[8], x[9]); w1.y = pk2(x[10], x[11]); w1.z = pk2(x[12], x[13]); w1.w = pk2(x[14], x[15]);
                    *(u32x4*)dst = w0; *(u32x4*)(dst + 8) = w1;
                }
                if (!sample) {
                    const bf16_t* src = U5 + (size_t)t * 5120 + 4096 + 16 * lane;
                    float a[8], c[8]; unpack8(*(const u32x4*)src, a); unpack8(*(const u32x4*)(src + 8), c);
                    float* o = A.out + OUT_V + (((size_t)b * 2 + j) * 256 + l) * 1024 + 16 * lane;
                    *(f32x4*)(o) = (f32x4){a[0], a[1], a[2], a[3]}; *(f32x4*)(o + 4) = (f32x4){a[4], a[5], a[6], a[7]};
                    *(f32x4*)(o + 8) = (f32x4){c[0], c[1], c[2], c[3]}; *(f32x4*)(o + 12) = (f32x4){c[4], c[5], c[6], c[7]};
                }
            }
            {
                const int h = wave;
                bf16_t* dst = sample ? VTS + (((size_t)b * 8 + h) * 128) * 2304 + l0 : VTP + (((size_t)b * 8 + h) * 128) * 256 + l0;
                vt_tile<false>(U5 + (size_t)t0 * 5120 + 4096 + h * 128, 5120, dst, sample ? 2304 : 256, scr, lane);
            }
        } else {
            const int uu = u - 320, b = uu >> 2, k0 = (uu & 3) * 64;
            const float* ck = A.in[3] + (((size_t)b * 2 + j) * 256 + k0) * 1024;
            for (int idx = tid; idx < 64 * 1024 / 8; idx += 512) { const float* s = ck + (size_t)idx * 8; const f32x4 a = *(const f32x4*)s, c = *(const f32x4*)(s + 4);
                u32x4 v; v.x = pk2(a[0], a[1]); v.y = pk2(a[2], a[3]); v.z = pk2(c[0], c[1]); v.w = pk2(c[2], c[3]);
                *(u32x4*)(KC + ((size_t)b * 256 + k0) * 1024 + (size_t)idx * 8) = v; }
            const int h = wave;
            const float* cv = A.in[4] + (((size_t)b * 2 + j) * 256 + k0) * 1024 + h * 128;
            vt_tile<true>(cv, 1024, VTS + (((size_t)b * 8 + h) * 128) * 2304 + 2048 + k0, 2304, scr, lane);
        }
    }
}

template <int PASS>
__device__ __forceinline__ void lru_unit(const Args& A, LAS unsigned char* lds, int j, int ci, int kblk) {
    const int tid = otid(), lane = tid & 63, wave = tid >> 6, r = lane & 15, kq = lane >> 4;
    unsigned char* ws = A.ws;
    const bf16_t* U5 = (const bf16_t*)(ws + WS_U5);
    const bf16_t* LRUW = (const bf16_t*)(ws + WS_LRUW);
    f32x2* CHS = (f32x2*)(ws + WS_CHS);
    const int t0 = ci * 128;
    const int sample = t0 >= TP, b = sample ? (t0 - TP) >> 11 : t0 >> 8, l0 = sample ? (t0 - TP) & 2047 : t0 & 255, L = sample ? 2048 : 256;
    const int cis = l0 >> 7, nch = L >> 7, cbase = ci - cis;
    LAS bf16_t* X = (LAS bf16_t*)lds;
    WG_SYNC();
    {
        const int oct = tid & 15, tb = tid >> 4, ch0 = kblk * 128 + oct * 8;
        float cw[4][8], cb[8];
#pragma unroll
        for (int tp = 0; tp < 4; ++tp) { const f32x4 a = *(const f32x4*)(A.in[11] + ((size_t)j * 4 + tp) * 1024 + ch0), c = *(const f32x4*)(A.in[11] + ((size_t)j * 4 + tp) * 1024 + ch0 + 4);
            cw[tp][0] = a[0]; cw[tp][1] = a[1]; cw[tp][2] = a[2]; cw[tp][3] = a[3]; cw[tp][4] = c[0]; cw[tp][5] = c[1]; cw[tp][6] = c[2]; cw[tp][7] = c[3]; }
        { const f32x4 a = *(const f32x4*)(A.in[12] + (size_t)j * 1024 + ch0), c = *(const f32x4*)(A.in[12] + (size_t)j * 1024 + ch0 + 4);
            cb[0] = a[0]; cb[1] = a[1]; cb[2] = a[2]; cb[3] = a[3]; cb[4] = c[0]; cb[5] = c[1]; cb[6] = c[2]; cb[7] = c[3]; }
#pragma unroll
        for (int it = 0; it < 4; ++it) {
            const int tok = tb + 32 * it, l = l0 + tok;
            float o[8];
#pragma unroll
            for (int i = 0; i < 8; ++i) o[i] = cb[i];
#pragma unroll
            for (int tp = 0; tp < 4; ++tp) { const int ll = l - 2 + tp;
                if (ll >= 0 && ll < L) { float x[8]; unpack8(*(const u32x4*)(U5 + (size_t)(t0 + tok - 2 + tp) * 5120 + 1024 + ch0), x);
#pragma unroll
                    for (int i = 0; i < 8; ++i) o[i] += x[i] * cw[tp][i]; } }
            *(LAS u32x4*)(X + tok * 136 + oct * 8) = pack8(o);
        }
    }
    WG_SYNC();
    const int chl = wave * 16 + 4 * kq, C0 = kblk * 128 + chl;
    float hsum[8][4];
#pragma unroll
    for (int nt = 0; nt < 8; ++nt)
#pragma unroll
        for (int e = 0; e < 4; ++e) hsum[nt][e] = 0.f;
#pragma unroll
    for (int d = 0; d < 2; ++d) {
        f32x4 ar[8], ai[8];
#pragma unroll
        for (int nt = 0; nt < 8; ++nt) { ar[nt] = (f32x4){0.f, 0.f, 0.f, 0.f}; ai[nt] = (f32x4){0.f, 0.f, 0.f, 0.f}; }
        const bf16_t* Wr = LRUW + ((((size_t)j * 2 + d) * 2 + 0) * 8 + kblk) * 16384 + (size_t)(wave * 16 + r) * 128 + 8 * kq;
        const bf16_t* Wi = LRUW + ((((size_t)j * 2 + d) * 2 + 1) * 8 + kblk) * 16384 + (size_t)(wave * 16 + r) * 128 + 8 * kq;
#pragma unroll
        for (int ks = 0; ks < 4; ++ks) {
            const bf16x8 fr_ = as_bf16x8(*(const u32x4*)(Wr + 32 * ks)), fi_ = as_bf16x8(*(const u32x4*)(Wi + 32 * ks));
#pragma unroll
            for (int nt = 0; nt < 8; ++nt) { const bf16x8 fb = *(const LAS bf16x8*)(X + (16 * nt + r) * 136 + 32 * ks + 8 * kq);
                ar[nt] = MFMA16(fr_, fb, ar[nt]); ai[nt] = MFMA16(fi_, fb, ai[nt]); }
        }
        float br[4], bi[4], sp[4];
        { const f32x4 v0 = *(const f32x4*)(A.in[14] + ((size_t)j * 2 + d) * 1024 + C0), v1 = *(const f32x4*)(A.in[16] + ((size_t)j * 2 + d) * 1024 + C0), v2 = *(const f32x4*)(A.in[17] + ((size_t)j * 2 + d) * 1024 + C0);
#pragma unroll
            for (int e = 0; e < 4; ++e) { br[e] = v0[e]; bi[e] = v1[e]; sp[e] = fsoftplus(-v2[e]); } }
#pragma unroll
        for (int nt = 0; nt < 8; ++nt) {
            const u32x2 xv = *(const LAS u32x2*)(X + (16 * nt + r) * 136 + chl);
            const float xc[4] = {bflo(xv.x), bfhi(xv.x), bflo(xv.y), bfhi(xv.y)};
#pragma unroll
            for (int e = 0; e < 4; ++e) {
                const float rr = fsigmoid(ar[nt][e] + br[e]), gi = fsigmoid(ai[nt][e] + bi[e]);
                const float la = -8.0f * rr * sp[e];
                const float av = fexp(la);
                const float t2 = 2.0f * la; const float om = t2 > -0.03f ? -t2 * (1.0f + t2 * (0.5f + t2 * (0.16666667f + t2 * 0.041666668f))) : 1.0f - av * av;
                const float bt = __builtin_amdgcn_sqrtf(om) * gi * xc[e];
                ar[nt][e] = av; ai[nt][e] = bt;
            }
            __builtin_amdgcn_sched_barrier(0);
        }
#pragma unroll
        for (int nt = 0; nt < 8; ++nt)
#pragma unroll
            for (int e = 0; e < 4; ++e) {
                float Av = ar[nt][e], Bv = ai[nt][e];
#pragma unroll
                for (int dl = 1; dl < 16; dl <<= 1) {
                    if (d == 0) { const float Ap = __shfl_up(Av, dl, 16), Bp = __shfl_up(Bv, dl, 16); if (r >= dl) { Bv = Av * Bp + Bv; Av = Av * Ap; } }
                    else        { const float An = __shfl_down(Av, dl, 16), Bn = __shfl_down(Bv, dl, 16); if (r + dl < 16) { Bv = Av * Bn + Bv; Av = Av * An; } }
                }
                ar[nt][e] = Av; ai[nt][e] = Bv;
                if (e & 1) __builtin_amdgcn_sched_barrier(0);
            }
        if (PASS == 1) {
#pragma unroll
            for (int e = 0; e < 4; ++e) {
                float P = 1.f, E = 0.f;
#pragma unroll
                for (int q = 0; q < 8; ++q) { const int nt = d == 0 ? q : 7 - q; const int sl = d == 0 ? 15 : 0;
                    const float At = __shfl(ar[nt][e], sl, 16), Bt = __shfl(ai[nt][e], sl, 16);
                    E = At * E + Bt; P = P * At; }
                if (r == 0) CHS[((size_t)ci * 2 + d) * 1024 + C0 + e] = (f32x2){P, E};
            }
        } else {
#pragma unroll
            for (int e = 0; e < 4; ++e) {
                float h = sample ? A.in[5][(((size_t)b * 2 + j) * 2 + d) * 1024 + C0 + e] : 0.f;
                if (d == 0) { for (int cj = 0; cj < cis; ++cj) { const f32x2 pe = CHS[((size_t)(cbase + cj) * 2 + 0) * 1024 + C0 + e]; h = pe.x * h + pe.y; } }
                else        { for (int cj = nch - 1; cj > cis; --cj) { const f32x2 pe = CHS[((size_t)(cbase + cj) * 2 + 1) * 1024 + C0 + e]; h = pe.x * h + pe.y; } }
#pragma unroll
                for (int q = 0; q < 8; ++q) { const int nt = d == 0 ? q : 7 - q; const int sl = d == 0 ? 15 : 0;
                    const float hv = ar[nt][e] * h + ai[nt][e];
                    hsum[nt][e] += hv;
                    h = __shfl(hv, sl, 16); }
                if (!sample && r == 0) {
                    if (d == 0 && cis == nch - 1) A.out[OUT_LRU + (((size_t)b * 2 + j) * 2 + 0) * 1024 + C0 + e] = h;
                    if (d == 1 && cis == 0)       A.out[OUT_LRU + (((size_t)b * 2 + j) * 2 + 1) * 1024 + C0 + e] = h;
                }
            }
        }
    }
    if (PASS == 2) {
        bf16_t* MIX = (bf16_t*)(ws + WS_MIXE);
#pragma unroll
        for (int nt = 0; nt < 8; ++nt) { const int t = t0 + 16 * nt + r;
            const u32x2 gv = *(const u32x2*)(U5 + (size_t)t * 5120 + C0);
            const float g[4] = {bflo(gv.x), bfhi(gv.x), bflo(gv.y), bfhi(gv.y)};
            u32x2 o; o.x = pk2(hsum[nt][0] * fgelu_tanh(g[0]), hsum[nt][1] * fgelu_tanh(g[1])); o.y = pk2(hsum[nt][2] * fgelu_tanh(g[2]), hsum[nt][3] * fgelu_tanh(g[3]));
            *(u32x2*)(MIX + (size_t)t * 2048 + C0) = o; }
    }
}

__device__ __forceinline__ void attn_unit(const Args& A, LAS unsigned char* lds, int j, int sample, int b, int h, int qb, float lam, float lam_init) {
    const int tid = otid(), lane = tid & 63, wave = tid >> 6, r = lane & 15, kq = lane >> 4;
    unsigned char* ws = A.ws;
    const bf16_t* Qb = (const bf16_t*)(ws + WS_Q); const bf16_t* Kb = (const bf16_t*)(ws + WS_K); const bf16_t* KC = (const bf16_t*)(ws + WS_KC);
    const int L = sample ? 2048 : 256, Lk = sample ? 2304 : 256;
    const int tbase = sample ? TP + b * 2048 : b * 256;
    const bf16_t* VT = sample ? (const bf16_t*)(ws + WS_VTS) + (((size_t)b * 8 + h) * 128) * 2304 : (const bf16_t*)(ws + WS_VTP) + (((size_t)b * 8 + h) * 128) * 256;
    const int m = wave >> 2, qs = (wave & 3) * 32, q0 = tbase + qb * 128 + qs;
    constexpr int KT_BYTES = 64 * 136 * 2, VT_BYTES = 128 * 72 * 2;
    bf16x8 qf[2][2];
#pragma unroll
    for (int qt = 0; qt < 2; ++qt)
#pragma unroll
        for (int ks = 0; ks < 2; ++ks) qf[qt][ks] = as_bf16x8(*(const u32x4*)(Qb + (size_t)(q0 + 16 * qt + r) * 1024 + h * 128 + m * 64 + 32 * ks + 8 * kq));
    f32x4 o[8][2];
#pragma unroll
    for (int dt = 0; dt < 8; ++dt) { o[dt][0] = (f32x4){0.f, 0.f, 0.f, 0.f}; o[dt][1] = (f32x4){0.f, 0.f, 0.f, 0.f}; }
    float mrun[2] = {-1e30f, -1e30f}, lrun[2] = {0.f, 0.f};
    const int nkt = Lk >> 6;
    u32x4 pk_[2], pv_[2];
#define ATT_LOAD(kt_) do { const int key0_ = (kt_) * 64; \
        _Pragma("unroll") for (int i_ = 0; i_ < 2; ++i_) { const int p_ = tid + 512 * i_; \
            { const int row_ = p_ >> 4, pc_ = p_ & 15, key_ = key0_ + row_; \
              const bf16_t* s_ = key_ < L ? Kb + (size_t)(tbase + key_) * 1024 + h * 128 + pc_ * 8 : KC + ((size_t)b * 256 + (key_ - 2048)) * 1024 + h * 128 + pc_ * 8; \
              pk_[i_] = *(const u32x4*)s_; } \
            { const int row_ = p_ >> 3, pc_ = p_ & 7; pv_[i_] = *(const u32x4*)(VT + (size_t)row_ * Lk + key0_ + pc_ * 8); } } } while (0)
#define ATT_STORE(buf_) do { LAS unsigned char* kb_ = lds + (buf_) * KT_BYTES; LAS unsigned char* vb_ = lds + 2 * KT_BYTES + (buf_) * VT_BYTES; \
        _Pragma("unroll") for (int i_ = 0; i_ < 2; ++i_) { const int p_ = tid + 512 * i_; \
            *(LAS u32x4*)(kb_ + ((p_ >> 4) * 136 + (p_ & 15) * 8) * 2) = pk_[i_]; \
            *(LAS u32x4*)(vb_ + ((p_ >> 3) * 72 + (p_ & 7) * 8) * 2) = pv_[i_]; } } while (0)
    WG_SYNC();
    ATT_LOAD(0); ATT_STORE(0);
    WG_SYNC();
    for (int kt = 0; kt < nkt; ++kt) {
        if (kt + 1 < nkt) ATT_LOAD(kt + 1);
        const LAS bf16_t* Kl = (const LAS bf16_t*)(lds + (kt & 1) * KT_BYTES);
        const LAS bf16_t* Vl = (const LAS bf16_t*)(lds + 2 * KT_BYTES + (kt & 1) * VT_BYTES);
        f32x4 s[4][2];
#pragma unroll
        for (int t = 0; t < 4; ++t) { s[t][0] = (f32x4){0.f, 0.f, 0.f, 0.f}; s[t][1] = (f32x4){0.f, 0.f, 0.f, 0.f}; }
#pragma unroll
        for (int ks = 0; ks < 2; ++ks)
#pragma unroll
            for (int t = 0; t < 4; ++t) { const bf16x8 ka = *(const LAS bf16x8*)(Kl + (16 * t + r) * 136 + m * 64 + 32 * ks + 8 * kq);
                s[t][0] = MFMA16(ka, qf[0][ks], s[t][0]); s[t][1] = MFMA16(ka, qf[1][ks], s[t][1]); }
        bf16x8 pf[2][2];
#pragma unroll
        for (int qt = 0; qt < 2; ++qt) {
            float mx = s[0][qt][0];
#pragma unroll
            for (int t = 0; t < 4; ++t)
#pragma unroll
                for (int e = 0; e < 4; ++e) mx = fmaxf(mx, s[t][qt][e]);
            mx = fmaxf(mx, __shfl_xor(mx, 16)); mx = fmaxf(mx, __shfl_xor(mx, 32));
            const float mnew = fmaxf(mrun[qt], mx), alpha = __builtin_amdgcn_exp2f(mrun[qt] - mnew);
            mrun[qt] = mnew;
            float ps = 0.f;
#pragma unroll
            for (int t = 0; t < 4; ++t)
#pragma unroll
                for (int e = 0; e < 4; ++e) { const float p = __builtin_amdgcn_exp2f(s[t][qt][e] - mnew); s[t][qt][e] = p; ps += p; }
            lrun[qt] = lrun[qt] * alpha + ps;
#pragma unroll
            for (int dt = 0; dt < 8; ++dt) o[dt][qt] = o[dt][qt] * alpha;
#pragma unroll
            for (int blk = 0; blk < 2; ++blk) { u32x4 w; w.x = pk2(s[2 * blk][qt][0], s[2 * blk][qt][1]); w.y = pk2(s[2 * blk][qt][2], s[2 * blk][qt][3]);
                w.z = pk2(s[2 * blk + 1][qt][0], s[2 * blk + 1][qt][1]); w.w = pk2(s[2 * blk + 1][qt][2], s[2 * blk + 1][qt][3]); pf[blk][qt] = as_bf16x8(w); }
        }
#pragma unroll
        for (int blk = 0; blk < 2; ++blk)
#pragma unroll
            for (int dt = 0; dt < 8; ++dt) {
                const u32x2 v0 = *(const LAS u32x2*)(Vl + (16 * dt + r) * 72 + 32 * blk + 4 * kq), v1 = *(const LAS u32x2*)(Vl + (16 * dt + r) * 72 + 32 * blk + 16 + 4 * kq);
                const bf16x8 va = as_bf16x8((u32x4){v0.x, v0.y, v1.x, v1.y});
                o[dt][0] = MFMA16(va, pf[blk][0], o[dt][0]); o[dt][1] = MFMA16(va, pf[blk][1], o[dt][1]); }
        if (kt + 1 < nkt) ATT_STORE((kt + 1) & 1);
        WG_SYNC();
    }
#undef ATT_LOAD
#undef ATT_STORE
#pragma unroll
    for (int qt = 0; qt < 2; ++qt) { float l = lrun[qt]; l += __shfl_xor(l, 16); l += __shfl_xor(l, 32); const float inv = 1.0f / l;
#pragma unroll
        for (int dt = 0; dt < 8; ++dt) o[dt][qt] = o[dt][qt] * inv; }
    LAS f32x4* ex = (LAS f32x4*)lds;
    if (m == 1) {
#pragma unroll
        for (int dt = 0; dt < 8; ++dt) { ex[((wave & 3) * 16 + dt * 2 + 0) * 64 + lane] = o[dt][0]; ex[((wave & 3) * 16 + dt * 2 + 1) * 64 + lane] = o[dt][1]; }
    }
    WG_SYNC();
    if (m == 0) {
        bf16_t* MIX = (bf16_t*)(ws + WS_MIXE);
        const float* subln = A.in[23] + (size_t)j * 128;
        float ss[2] = {0.f, 0.f};
#pragma unroll
        for (int dt = 0; dt < 8; ++dt)
#pragma unroll
            for (int qt = 0; qt < 2; ++qt) { const f32x4 o1 = ex[((wave & 3) * 16 + dt * 2 + qt) * 64 + lane]; o[dt][qt] = o[dt][qt] - o1 * lam;
                ss[qt] += (o[dt][qt][0] * o[dt][qt][0] + o[dt][qt][1] * o[dt][qt][1]) + (o[dt][qt][2] * o[dt][qt][2] + o[dt][qt][3] * o[dt][qt][3]); }
#pragma unroll
        for (int qt = 0; qt < 2; ++qt) { float v = ss[qt]; v += __shfl_xor(v, 16); v += __shfl_xor(v, 32); const float rstd = (1.0f - lam_init) / sqrtf(v * (1.f / 128.f) + EPS);
#pragma unroll
            for (int dt = 0; dt < 8; ++dt) { const f32x4 g = *(const f32x4*)(subln + 16 * dt + 4 * kq); const f32x4 v4 = o[dt][qt] * rstd * g;
                u32x2 w; w.x = pk2(v4[0], v4[1]); w.y = pk2(v4[2], v4[3]);
                *(u32x2*)(MIX + (size_t)(q0 + 16 * qt + r) * 2048 + 1024 + h * 128 + 16 * dt + 4 * kq) = w; } }
    }
}

__device__ __forceinline__ void phase_even_mix1(const Args& A, LAS unsigned char* lds, int j) {
    if (DBG_SUB & 1) phase_qkv_prep(A, lds, j);
    if (DBG_SUB & 2) for (int u = blockIdx.x; u < 1280; u += gridDim.x) lru_unit<1>(A, lds, j, u >> 3, u & 7);
}
__device__ __forceinline__ void phase_even_mix2(const Args& A, LAS unsigned char* lds, int j, int layer) {
    float lam;
    { const float* dl = A.in[22] + (size_t)j * 256; float s0 = 0.f, s1 = 0.f;
      for (int i = 0; i < 64; ++i) { s0 += dl[i] * dl[64 + i]; s1 += dl[128 + i] * dl[192 + i]; }
      const float lam_init = 0.8f - 0.6f * expf(-0.3f * (float)layer); lam = expf(s0) - expf(s1) + lam_init;
      if (DBG_SUB & 1) for (int u = blockIdx.x; u < 1024 + 256; u += gridDim.x) {
          if (u < 1024) attn_unit(A, lds, j, 1, u >> 7, (u >> 4) & 7, u & 15, lam, lam_init);
          else { const int v = u - 1024; attn_unit(A, lds, j, 0, v >> 4, (v >> 1) & 7, v & 1, lam, lam_init); }
      }
    }
    if (DBG_SUB & 2) for (int u = blockIdx.x; u < 1280; u += gridDim.x) lru_unit<2>(A, lds, j, u >> 3, u & 7);
}

__device__ __forceinline__ void phase_ssd_prep(const Args& A, LAS unsigned char* lds, int j) {
    const int tid = otid(), wave = tid >> 6;
    unsigned char* ws = A.ws;
    const bf16_t* XBC = (const bf16_t*)(ws + WS_XBC);
    bf16_t* XT = (bf16_t*)(ws + WS_XT); bf16_t* BN = (bf16_t*)(ws + WS_BN); bf16_t* BT = (bf16_t*)(ws + WS_BT); bf16_t* CN = (bf16_t*)(ws + WS_CN);
    LAS bf16_t* Tl = (LAS bf16_t*)lds;
    for (int u = blockIdx.x; u < 320 * 12; u += gridDim.x) {
        const int slab = u / 12, cb = u - slab * 12, t0 = slab * 64;
        const int sample = t0 >= TP, l0 = sample ? (t0 - TP) & 2047 : t0 & 255, L = sample ? 2048 : 256;
        const int co = tid & 63, ch = cb * 512 + co * 8;
        float cw[4][8], cbias[8];
#pragma unroll
        for (int tp = 0; tp < 4; ++tp) { const f32x4 a = *(const f32x4*)(A.in[25] + ((size_t)j * 4 + tp) * 6144 + ch), c = *(const f32x4*)(A.in[25] + ((size_t)j * 4 + tp) * 6144 + ch + 4);
            cw[tp][0] = a[0]; cw[tp][1] = a[1]; cw[tp][2] = a[2]; cw[tp][3] = a[3]; cw[tp][4] = c[0]; cw[tp][5] = c[1]; cw[tp][6] = c[2]; cw[tp][7] = c[3]; }
        { const f32x4 a = *(const f32x4*)(A.in[26] + (size_t)j * 6144 + ch), c = *(const f32x4*)(A.in[26] + (size_t)j * 6144 + ch + 4);
            cbias[0] = a[0]; cbias[1] = a[1]; cbias[2] = a[2]; cbias[3] = a[3]; cbias[4] = c[0]; cbias[5] = c[1]; cbias[6] = c[2]; cbias[7] = c[3]; }
        WG_SYNC();
#pragma unroll
        for (int it = 0; it < 4; ++it) {
            const int tp0 = 2 * (wave + 8 * it);
            float xr[5][8];
#pragma unroll
            for (int rr = 0; rr < 5; ++rr) { const int ll = l0 + tp0 - 2 + rr;
                if (ll >= 0 && ll < L) unpack8(*(const u32x4*)(XBC + (size_t)(t0 + tp0 - 2 + rr) * 6144 + ch), xr[rr]);
                else {
#pragma unroll
                    for (int i = 0; i < 8; ++i) xr[rr][i] = 0.f; } }
#pragma unroll
            for (int tk = 0; tk < 2; ++tk) {
                float o[8];
#pragma unroll
                for (int i = 0; i < 8; ++i) { float v = cbias[i];
#pragma unroll
                    for (int tp = 0; tp < 4; ++tp) v += xr[tk + tp][i] * cw[tp][i];
                    o[i] = fsilu(v); }
                const u32x4 pk = pack8(o);
                const int tok = tp0 + tk;
                if (cb >= 8) { bf16_t* dst = (cb < 10 ? BN + (size_t)(t0 + tok) * 1024 + (cb - 8) * 512 : CN + (size_t)(t0 + tok) * 1024 + (cb - 10) * 512) + co * 8; *(u32x4*)dst = pk; }
                if (cb < 10) *(LAS u32x4*)(Tl + tok * 520 + co * 8) = pk;
            }
        }
        if (cb < 10) {
            WG_SYNC();
            const int tile = t0 >> 8, so = t0 & 255;
#pragma unroll
            for (int i = 0; i < 8; ++i) { const int p = tid + 512 * i, c = p & 511, tg = p >> 9;
                unsigned short e[8];
#pragma unroll
                for (int k = 0; k < 8; ++k) e[k] = Tl[(8 * tg + k) * 520 + c];
                u32x4 v; v.x = e[0] | ((unsigned)e[1] << 16); v.y = e[2] | ((unsigned)e[3] << 16); v.z = e[4] | ((unsigned)e[5] << 16); v.w = e[6] | ((unsigned)e[7] << 16);
                bf16_t* dst;
                if (cb < 8) { const int cg = cb * 512 + c; dst = XT + (((size_t)tile * 64 + (cg >> 6)) * 64 + (cg & 63)) * 256 + so + 8 * tg; }
                else { const int cg = (cb - 8) * 512 + c; dst = BT + (((size_t)tile * 8 + (cg >> 7)) * 128 + (cg & 127)) * 256 + so + 8 * tg; }
                *(u32x4*)dst = v; }
        }
    }
}

template <int NV>
__device__ __forceinline__ void scan256(float (&v)[NV], LAS float* wtot, int lane, int wave_in_grp, float (&tot)[NV]) {
#pragma unroll
    for (int dl = 1; dl < 64; dl <<= 1) {
#pragma unroll
        for (int k = 0; k < NV; ++k) { const float up = __shfl_up(v[k], dl, 64); if (lane >= dl) v[k] += up; }
    }
    if (lane == 63) {
#pragma unroll
        for (int k = 0; k < NV; ++k) wtot[wave_in_grp * NV + k] = v[k];
    }
    WG_SYNC();
#pragma unroll
    for (int k = 0; k < NV; ++k) { float pre = 0.f, all = 0.f;
#pragma unroll
        for (int w = 0; w < 4; ++w) { const float x = wtot[w * NV + k]; all += x; if (w < wave_in_grp) pre += x; }
        v[k] += pre; tot[k] = all; }
}

__device__ __forceinline__ void phase_ssd_state(const Args& A, LAS unsigned char* lds, int j) {
    const int tid = otid(), lane = tid & 63, wave = tid >> 6, r = lane & 15, kq = lane >> 4;
    unsigned char* ws = A.ws;
    const bf16_t* XT = (const bf16_t*)(ws + WS_XT); const bf16_t* BT = (const bf16_t*)(ws + WS_BT);
    const float* DTRAW = (const float*)(ws + WS_DTRAW);
    bf16_t* SIN = (bf16_t*)(ws + WS_SIN);
    LAS bf16_t* Bl = (LAS bf16_t*)lds;
    LAS bf16_t* Xl = (LAS bf16_t*)(lds + 67584);
    LAS float* Wl = (LAS float*)(lds + 67584 + 33792);
    LAS float* TOT = Wl + 1024;
    LAS float* WT_ = TOT + 16;
    const int pt = wave & 3, nh = wave >> 2;
    for (int u = blockIdx.x; u < 256 + 512; u += gridDim.x) {
        const int sample = u < 256, v = sample ? u : u - 256;
        const int b = v >> 5, g = (v >> 2) & 7, dir = (v >> 1) & 1, half = v & 1;
        const int tile0 = sample ? 16 + b * 8 : b, ntile = sample ? 8 : 1;
        const int h0 = g * 8 + half * 4;
        f32x4 acc[4][4];
#pragma unroll
        for (int hh = 0; hh < 4; ++hh)
#pragma unroll
            for (int nt = 0; nt < 4; ++nt) {
                if (sample) {
#pragma unroll
                    for (int e = 0; e < 4; ++e) acc[hh][nt][e] = A.in[6][((((size_t)b * 2 + j) * 2 + dir) * 64 + h0 + hh) * 8192 + (size_t)(16 * pt + 4 * kq + e) * 128 + 16 * (nh * 4 + nt) + r];
                } else acc[hh][nt] = (f32x4){0.f, 0.f, 0.f, 0.f};
            }
        float adec[4], dtb[4];
#pragma unroll
        for (int hh = 0; hh < 4; ++hh) { adec[hh] = -expf(A.in[28][((size_t)j * 2 + dir) * 64 + h0 + hh]); dtb[hh] = A.in[27][((size_t)j * 2 + dir) * 64 + h0 + hh]; }
        for (int st = 0; st < ntile; ++st) {
            const int c = dir == 0 ? st : ntile - 1 - st, tile = tile0 + c;
            if (sample) {
#pragma unroll
                for (int hh = 0; hh < 4; ++hh)
#pragma unroll
                    for (int nt = 0; nt < 4; ++nt)
#pragma unroll
                        for (int e = 0; e < 4; ++e)
                            SIN[((((size_t)(tile - 16) * 2 + dir) * 64 + h0 + hh) * 64 + 16 * pt + 4 * kq + e) * 128 + 16 * (nh * 4 + nt) + r] = (bf16_t)(pk2(acc[hh][nt][e], 0.f) & 0xffffu);
                if (st == ntile - 1) break;
            }
            WG_SYNC();
            {
                float val[4], dtv[4], tot[4];
                if (tid < 256) {
#pragma unroll
                    for (int hh = 0; hh < 4; ++hh) { dtv[hh] = fsoftplus(DTRAW[(size_t)(tile * 256 + tid) * 128 + dir * 64 + h0 + hh] + dtb[hh]); val[hh] = adec[hh] * dtv[hh]; }
                } else {
#pragma unroll
                    for (int hh = 0; hh < 4; ++hh) { dtv[hh] = 0.f; val[hh] = 0.f; }
                }
                float adt[4];
#pragma unroll
                for (int hh = 0; hh < 4; ++hh) adt[hh] = val[hh];
                scan256<4>(val, WT_ + (tid < 256 ? 0 : 16), lane, wave & 3, tot);
                if (tid < 256) {
#pragma unroll
                    for (int hh = 0; hh < 4; ++hh) { const float w = dir == 0 ? fexp(tot[hh] - val[hh]) * dtv[hh] : fexp(val[hh] - adt[hh]) * dtv[hh]; Wl[hh * 256 + tid] = w; }
                    if (tid == 0) {
#pragma unroll
                        for (int hh = 0; hh < 4; ++hh) TOT[hh] = tot[hh];
                    }
                }
            }
#pragma unroll
            for (int i = 0; i < 8; ++i) { const int p = tid + 512 * i, row = p >> 5, pc = p & 31;
                *(LAS u32x4*)(Bl + row * 264 + pc * 8) = *(const u32x4*)(BT + (((size_t)tile * 8 + g) * 128 + row) * 256 + pc * 8); }
#pragma unroll
            for (int hh = 0; hh < 4; ++hh) {
                WG_SYNC();
#pragma unroll
                for (int i = 0; i < 4; ++i) { const int p = tid + 512 * i, row = p >> 5, pc = p & 31;
                    float x[8]; unpack8(*(const u32x4*)(XT + (((size_t)tile * 64 + h0 + hh) * 64 + row) * 256 + pc * 8), x);
                    const f32x4 w0 = *(const LAS f32x4*)(Wl + hh * 256 + pc * 8), w1 = *(const LAS f32x4*)(Wl + hh * 256 + pc * 8 + 4);
                    x[0] *= w0[0]; x[1] *= w0[1]; x[2] *= w0[2]; x[3] *= w0[3]; x[4] *= w1[0]; x[5] *= w1[1]; x[6] *= w1[2]; x[7] *= w1[3];
                    *(LAS u32x4*)(Xl + row * 264 + pc * 8) = pack8(x); }
                WG_SYNC();
                const float dec = fexp(TOT[hh]);
#pragma unroll
                for (int nt = 0; nt < 4; ++nt) acc[hh][nt] = acc[hh][nt] * dec;
#pragma unroll
                for (int ks = 0; ks < 8; ++ks) { const bf16x8 fa = *(const LAS bf16x8*)(Xl + (16 * pt + r) * 264 + 32 * ks + 8 * kq);
#pragma unroll
                    for (int nt = 0; nt < 4; ++nt) { const bf16x8 fb = *(const LAS bf16x8*)(Bl + (16 * (nh * 4 + nt) + r) * 264 + 32 * ks + 8 * kq);
                        acc[hh][nt] = MFMA16(fa, fb, acc[hh][nt]); } }
            }
        }
        if (!sample) {
#pragma unroll
            for (int hh = 0; hh < 4; ++hh)
#pragma unroll
                for (int nt = 0; nt < 4; ++nt)
#pragma unroll
                    for (int e = 0; e < 4; ++e)
                        A.out[OUT_SSD + ((((size_t)b * 2 + j) * 2 + dir) * 64 + h0 + hh) * 8192 + (size_t)(16 * pt + 4 * kq + e) * 128 + 16 * (nh * 4 + nt) + r] = acc[hh][nt][e];
        }
    }
}

__device__ __forceinline__ void phase_ssd_out(const Args& A, LAS unsigned char* lds, int j) {
    const int tid = otid(), lane = tid & 63, wave = tid >> 6, r = lane & 15, kq = lane >> 4;
    unsigned char* ws = A.ws;
    const bf16_t* XT = (const bf16_t*)(ws + WS_XT); const bf16_t* BN = (const bf16_t*)(ws + WS_BN); const bf16_t* CN = (const bf16_t*)(ws + WS_CN);
    const bf16_t* Z = (const bf16_t*)(ws + WS_Z); const float* DTRAW = (const float*)(ws + WS_DTRAW); const bf16_t* SIN = (const bf16_t*)(ws + WS_SIN);
    bf16_t* MIX = (bf16_t*)(ws + WS_MIXO);
    LAS float* PF = (LAS float*)lds;
    LAS float* DTF = PF + 2048;
    LAS float* EB = DTF + 2048;
    LAS float* DTB = EB + 2048;
    LAS float* TOTB = (LAS float*)(lds + LDS_MISC + 256);
    LAS float* WT_ = (LAS float*)(lds + LDS_MISC + 320);
    LAS bf16_t* Bl = (LAS bf16_t*)(lds + 32768);
    LAS bf16_t* Xl = (LAS bf16_t*)(lds + 32768);
    LAS bf16_t* Sl = (LAS bf16_t*)(lds + 32768 + 33792);
    for (int u = blockIdx.x; u < 160 * 8; u += gridDim.x) {
        const int rt = u >> 3, g = u & 7, tile = rt >> 1, half = rt & 1;
        const int sample = tile >= 16;
        const int l_loc = half * 128 + wave * 16 + r;
        const size_t tk = (size_t)tile * 256 + l_loc;
        WG_SYNC();
        {
            const int dir = tid >> 8, s = tid & 255;
            float val[8], dtv[8], tot[8], adt[8];
#pragma unroll
            for (int h8 = 0; h8 < 8; ++h8) { const int h = g * 8 + h8;
                dtv[h8] = fsoftplus(DTRAW[((size_t)tile * 256 + s) * 128 + dir * 64 + h] + A.in[27][((size_t)j * 2 + dir) * 64 + h]);
                val[h8] = -expf(A.in[28][((size_t)j * 2 + dir) * 64 + h]) * dtv[h8]; adt[h8] = val[h8]; }
            scan256<8>(val, WT_ + dir * 32, lane, wave & 3, tot);
            if (dir == 0) {
#pragma unroll
                for (int h8 = 0; h8 < 8; ++h8) { PF[h8 * 256 + s] = val[h8]; DTF[h8 * 256 + s] = dtv[h8]; }
            } else {
#pragma unroll
                for (int h8 = 0; h8 < 8; ++h8) { EB[h8 * 256 + s] = val[h8] - adt[h8]; DTB[h8 * 256 + s] = dtv[h8]; }
                if (s == 0) {
#pragma unroll
                    for (int h8 = 0; h8 < 8; ++h8) TOTB[h8] = tot[h8];
                }
            }
        }
#pragma unroll
        for (int i = 0; i < 8; ++i) { const int p = tid + 512 * i, row = p >> 4, pc = p & 15;
            *(LAS u32x4*)(Bl + row * 136 + pc * 8) = *(const u32x4*)(BN + ((size_t)tile * 256 + row) * 1024 + g * 128 + pc * 8); }
        bf16x8 cf[4];
#pragma unroll
        for (int ks = 0; ks < 4; ++ks) cf[ks] = as_bf16x8(*(const u32x4*)(CN + tk * 1024 + g * 128 + 32 * ks + 8 * kq));
        WG_SYNC();
        f32x4 gt[16];
#pragma unroll
        for (int t = 0; t < 16; ++t) gt[t] = (f32x4){0.f, 0.f, 0.f, 0.f};
#pragma unroll
        for (int ks = 0; ks < 4; ++ks)
#pragma unroll
            for (int t = 0; t < 16; ++t) { const bf16x8 fa = *(const LAS bf16x8*)(Bl + (16 * t + r) * 136 + 32 * ks + 8 * kq); gt[t] = MFMA16(fa, cf[ks], gt[t]); }
        float ssq = 0.f;
        const int tdiag = half * 8 + wave;
#pragma unroll 1
        for (int h8 = 0; h8 < 8; ++h8) {
            const int h = g * 8 + h8;
            const int tid = otid(), lane = tid & 63, wave = __builtin_amdgcn_readfirstlane(tid >> 6), r = lane & 15, kq = lane >> 4;
            const int l_loc = half * 128 + wave * 16 + r; const size_t tk = (size_t)tile * 256 + l_loc; const int tdiag = half * 8 + wave;
            WG_SYNC();
#pragma unroll
            for (int i = 0; i < 4; ++i) { const int p = tid + 512 * i, row = p >> 5, pc = p & 31;
                *(LAS u32x4*)(Xl + row * 264 + pc * 8) = *(const u32x4*)(XT + (((size_t)tile * 64 + h) * 64 + row) * 256 + pc * 8); }
            if (sample) {
#pragma unroll
                for (int i = 0; i < 4; ++i) { const int p = tid + 512 * i, dirn = p >> 10, row = (p >> 4) & 63, pc = p & 15;
                    *(LAS u32x4*)(Sl + (dirn * 64 + row) * 136 + pc * 8) = *(const u32x4*)(SIN + ((((size_t)(tile - 16) * 2 + dirn) * 64 + h) * 64 + row) * 128 + pc * 8); }
            }
            WG_SYNC();
            const float pf_l = PF[h8 * 256 + l_loc], eb_l = EB[h8 * 256 + l_loc];
            f32x4 y[4];
#pragma unroll
            for (int p4 = 0; p4 < 4; ++p4) y[p4] = (f32x4){0.f, 0.f, 0.f, 0.f};
#pragma unroll
            for (int blk = 0; blk < 8; ++blk) {
                float mv[8];
#pragma unroll
                for (int hf = 0; hf < 2; ++hf) {
                    const int t = 2 * blk + hf, sb = 16 * t + 4 * kq;
                    if (t < tdiag) {
                        const f32x4 ps = *(const LAS f32x4*)(PF + h8 * 256 + sb), ds = *(const LAS f32x4*)(DTF + h8 * 256 + sb);
#pragma unroll
                        for (int e = 0; e < 4; ++e) mv[hf * 4 + e] = gt[t][e] * fexp(pf_l - ps[e]) * ds[e];
                    } else if (t > tdiag) {
                        const f32x4 es = *(const LAS f32x4*)(EB + h8 * 256 + sb), ds = *(const LAS f32x4*)(DTB + h8 * 256 + sb);
#pragma unroll
                        for (int e = 0; e < 4; ++e) mv[hf * 4 + e] = gt[t][e] * fexp(es[e] - eb_l) * ds[e];
                    } else {
                        const f32x4 ps = *(const LAS f32x4*)(PF + h8 * 256 + sb), df = *(const LAS f32x4*)(DTF + h8 * 256 + sb);
                        const f32x4 es = *(const LAS f32x4*)(EB + h8 * 256 + sb), db = *(const LAS f32x4*)(DTB + h8 * 256 + sb);
#pragma unroll
                        for (int e = 0; e < 4; ++e) { const int s = sb + e; float w = 0.f;
                            if (s <= l_loc) w += fexp(fminf(pf_l - ps[e], 0.f)) * df[e];
                            if (s >= l_loc) w += fexp(fminf(es[e] - eb_l, 0.f)) * db[e];
                            mv[hf * 4 + e] = gt[t][e] * w; }
                    }
                }
                const bf16x8 mf = as_bf16x8(pack8(mv));
#pragma unroll
                for (int p4 = 0; p4 < 4; ++p4) {
                    const u32x2 v0 = *(const LAS u32x2*)(Xl + (16 * p4 + r) * 264 + 32 * blk + 4 * kq), v1 = *(const LAS u32x2*)(Xl + (16 * p4 + r) * 264 + 32 * blk + 16 + 4 * kq);
                    y[p4] = MFMA16(as_bf16x8((u32x4){v0.x, v0.y, v1.x, v1.y}), mf, y[p4]); }
                __builtin_amdgcn_sched_barrier(0);
            }
            if (sample) {
#pragma unroll
                for (int dirn = 0; dirn < 2; ++dirn) {
                    f32x4 tmp[4];
#pragma unroll
                    for (int p4 = 0; p4 < 4; ++p4) tmp[p4] = (f32x4){0.f, 0.f, 0.f, 0.f};
#pragma unroll
                    for (int ks = 0; ks < 4; ++ks)
#pragma unroll
                        for (int p4 = 0; p4 < 4; ++p4) { const bf16x8 sa = *(const LAS bf16x8*)(Sl + (dirn * 64 + 16 * p4 + r) * 136 + 32 * ks + 8 * kq); tmp[p4] = MFMA16(sa, cf[ks], tmp[p4]); }
                    const float ev = dirn == 0 ? fexp(pf_l) : fexp(TOTB[h8] - eb_l);
#pragma unroll
                    for (int p4 = 0; p4 < 4; ++p4) y[p4] = y[p4] + tmp[p4] * ev;
                }
            }
            const float dsk = A.in[29][(size_t)j * 64 + h];
#pragma unroll
            for (int p4 = 0; p4 < 4; ++p4) { const int p0 = 16 * p4 + 4 * kq;
                const u32x2 zv = *(const u32x2*)(Z + tk * 4096 + h * 64 + p0);
                const float zz[4] = {bflo(zv.x), bfhi(zv.x), bflo(zv.y), bfhi(zv.y)};
                float yv[4];
#pragma unroll
                for (int e = 0; e < 4; ++e) { const float xs = bf2f(Xl[(p0 + e) * 264 + l_loc]); yv[e] = (y[p4][e] + dsk * xs) * fsilu(zz[e]); ssq += yv[e] * yv[e]; }
                u32x2 w; w.x = pk2(yv[0], yv[1]); w.y = pk2(yv[2], yv[3]);
                *(u32x2*)(MIX + tk * 4096 + h * 64 + p0) = w; }
        }
        ssq += __shfl_xor(ssq, 16); ssq += __shfl_xor(ssq, 32);
        const float rstd = 1.0f / sqrtf(ssq * (1.f / 512.f) + EPS);
        asm volatile("s_waitcnt vmcnt(0)" ::: "memory");
#pragma unroll 1
        for (int h8 = 0; h8 < 8; ++h8)
#pragma unroll
            for (int p4 = 0; p4 < 4; ++p4) { const int tid2 = otid(), kq2 = (tid2 & 63) >> 4; const size_t tk2 = (size_t)tile * 256 + half * 128 + (tid2 >> 6) * 16 + (tid2 & 15);
                const int cix = (g * 8 + h8) * 64 + 16 * p4 + 4 * kq2;
                unsigned long long* ptr = (unsigned long long*)(MIX + tk2 * 4096 + cix);
                const unsigned long long raw = __hip_atomic_load(ptr, __ATOMIC_RELAXED, __HIP_MEMORY_SCOPE_AGENT);
                const unsigned lo = (unsigned)raw, hi = (unsigned)(raw >> 32);
                const f32x4 nw = *(const f32x4*)(A.in[30] + (size_t)j * 4096 + cix);
                u32x2 w; w.x = pk2(bflo(lo) * rstd * nw[0], bfhi(lo) * rstd * nw[1]); w.y = pk2(bflo(hi) * rstd * nw[2], bfhi(hi) * rstd * nw[3]);
                *(u32x2*)ptr = w; }
    }
}

constexpr int N_PHASE_IDS = 2 + 9 * 4;
#ifndef DBG_MASK
#define DBG_MASK 0xFFFF
#endif
#ifndef MK_ONE_LAUNCH
#define MK_ONE_LAUNCH 0
#endif

__global__ void __launch_bounds__(512, 2) fwd_kernel(Args args) {
    extern __shared__ __attribute__((aligned(16))) unsigned char shm[];
    LAS unsigned char* lds = (LAS unsigned char*)shm;
    const int tid = threadIdx.x;
    unsigned char* ws = args.ws;
    if (tid < 4) ((LAS unsigned*)(lds + LDS_MISC))[tid] = 0u;
    __syncthreads();
    XcdBarrier bar = xcd_barrier_post((unsigned*)(ws + WS_CTL), (volatile LAS unsigned*)(lds + LDS_MISC));
    const int lo = args.ph_lo, hi = args.ph_hi;
    bool need_bar = false;
#define PHASE(id) if (lo <= (id) && (id) < hi && ((need_bar ? (xcd_barrier(bar), 0) : 0), need_bar = true, true))
    const float* ADA = (const float*)(ws + WS_ADA);
    bf16_t* H = (bf16_t*)(ws + WS_H);
    const int G = (int)gridDim.x, bx = (int)blockIdx.x;

    PHASE(0) { if (DBG_MASK & 1) phase_prologue(args, lds); }
    PHASE(1) { if (DBG_MASK & 2) phase_modulate(args, 0, 0); }
    for (int layer = 0; layer < 4; ++layer) {
        const int pb = 2 + 9 * layer, j = layer >> 1, even = (layer & 1) == 0;
        if (even) {
            PHASE(pb + 0) if (DBG_MASK & 4) { pg8::Gemm g{H, (const bf16_t*)(ws + WS_WEIN) + (size_t)j * 5120 * 2048, T, 5120, 2048}; pg8::StaticOrder S; S.init(T, 5120, G, bx);
                pg8::EpiStore E{(bf16_t*)(ws + WS_U5), 5120};
                pg8::gemm_phase<pg8::EpiStore, pg8::StaticOrder, true, true>(lds, g, S, E); }
            PHASE(pb + 1) { if (DBG_MASK & 8) phase_even_mix1(args, lds, j); }
            PHASE(pb + 2) { if (DBG_MASK & 16) phase_even_mix2(args, lds, j, layer); }
        } else {
            PHASE(pb + 0) if (DBG_MASK & 32) { pg8::Gemm g{H, (const bf16_t*)(ws + WS_WSIN) + (size_t)j * 10496 * 2048, T, 10496, 2048}; pg8::StaticOrder S; S.init(T, 10496, G, bx);
                pg8::EpiOdd1 E{(bf16_t*)(ws + WS_Z), (bf16_t*)(ws + WS_XBC), (float*)(ws + WS_DTRAW)};
                pg8::gemm_phase<pg8::EpiOdd1, pg8::StaticOrder, true, true>(lds, g, S, E); }
            PHASE(pb + 1) { if (DBG_MASK & 64) phase_ssd_prep(args, lds, j); }
            PHASE(pb + 2) { if (DBG_MASK & 128) phase_ssd_state(args, lds, j); }
            PHASE(pb + 3) { if (DBG_MASK & 256) phase_ssd_out(args, lds, j); }
        }
        PHASE(pb + 4) if (DBG_MASK & 512) {
            const bf16_t* Am = even ? (const bf16_t*)(ws + WS_MIXE) : (const bf16_t*)(ws + WS_MIXO);
            const bf16_t* Bm = even ? (const bf16_t*)(ws + WS_WEOUT) + (size_t)j * 2048 * 2048 : (const bf16_t*)(ws + WS_WSOUT) + (size_t)j * 2048 * 4096;
            pg8::Gemm g{Am, Bm, T, 2048, even ? 2048 : 4096}; pg8::StaticOrder S; S.init(T, 2048, G, bx);
            pg8::EpiResid E{args.out, ADA + (size_t)layer * 9 * 12288 + 2 * 2048};
            pg8::gemm_phase<pg8::EpiResid, pg8::StaticOrder, true, true>(lds, g, S, E); }
        PHASE(pb + 5) { if (DBG_MASK & 2) phase_modulate(args, layer, 1); }
        PHASE(pb + 6) if (DBG_MASK & 1024) { pg8::Gemm g{H, (const bf16_t*)(ws + WS_WFIN) + (size_t)layer * 11264 * 2048, T, 11264, 2048}; pg8::StaticOrder S; S.init(T, 11264, G, bx);
            pg8::EpiSwiGLU E{(bf16_t*)(ws + WS_HID), 5632};
            pg8::gemm_phase<pg8::EpiSwiGLU, pg8::StaticOrder, true, true>(lds, g, S, E); }
        PHASE(pb + 7) if (DBG_MASK & 2048) { pg8::Gemm g{(const bf16_t*)(ws + WS_HID), (const bf16_t*)(ws + WS_WFOUT) + (size_t)layer * 2048 * 5632, T, 2048, 5632}; pg8::StaticOrder S; S.init(T, 2048, G, bx);
            pg8::EpiResid E{args.out, ADA + (size_t)layer * 9 * 12288 + 5 * 2048};
            pg8::gemm_phase<pg8::EpiResid, pg8::StaticOrder, true, true>(lds, g, S, E); }
        if (layer < 3) { PHASE(pb + 8) { if (DBG_MASK & 2) phase_modulate(args, layer + 1, 0); } }
    }
#undef PHASE
}

extern "C" void kernel_launch(void* const* d_in, const int* in_sizes, int n_in, void* d_out, int out_size, void* d_ws, size_t ws_size, hipStream_t stream) {
    static int grid = 0;
    if (grid == 0) {
        if (n_in != 34 || out_size != 92340224 || ws_size < WS_END) { fprintf(stderr, "kernel_launch: unexpected shapes (n_in %d, out %d, ws %zu); nothing launched\n", n_in, out_size, ws_size); grid = -1; return; }
        int dev = 0, cus = 0, per_cu = 0;
        if (hipGetDevice(&dev) != hipSuccess || hipDeviceGetAttribute(&cus, hipDeviceAttributeMultiprocessorCount, dev) != hipSuccess) { grid = -1; return; }
        if (hipFuncSetAttribute((const void*)fwd_kernel, hipFuncAttributeMaxDynamicSharedMemorySize, LDS_BYTES) != hipSuccess) { fprintf(stderr, "kernel_launch: hipFuncSetAttribute failed\n"); grid = -1; return; }
        if (hipOccupancyMaxActiveBlocksPerMultiprocessor(&per_cu, (const void*)fwd_kernel, 512, LDS_BYTES) != hipSuccess || per_cu < 1)
            fprintf(stderr, "kernel_launch: occupancy query reports %d workgroups per CU\n", per_cu);
        (void)hipGetLastError();
        grid = cus;
    }
    if (grid < 0) return;
    (void)hipMemsetAsync(d_ws, 0, WS_ZERO_BYTES, stream);
    (void)hipMemcpyAsync(d_out, d_in[0], (size_t)8388608 * 4, hipMemcpyDeviceToDevice, stream);
    (void)hipMemcpyAsync((float*)d_out + 8388608, d_in[1], (size_t)33554432 * 4, hipMemcpyDeviceToDevice, stream);
    Args a{};
    for (int i = 0; i < 34; ++i) a.in[i] = (const float*)d_in[i];
    a.out = (float*)d_out; a.ws = (unsigned char*)d_ws;
#if MK_ONE_LAUNCH
    a.ph_lo = 0; a.ph_hi = N_PHASE_IDS;
    hipLaunchKernelGGL(fwd_kernel, dim3(grid), dim3(512), LDS_BYTES, stream, a);
#else
    for (int p = 0; p < N_PHASE_IDS; ++p) {
        if (p >= 2) { const int L = (p - 2) / 9, k = (p - 2) % 9; const bool even = (L & 1) == 0; if ((even && k == 3) || (L == 3 && k == 8)) continue; }
        a.ph_lo = p; a.ph_hi = p + 1;
        hipLaunchKernelGGL(fwd_kernel, dim3(grid), dim3(512), LDS_BYTES, stream, a);
    }
#endif
}
```

```cpp
#include <hip/hip_runtime.h>
#include <cstdio>
#include <cstdint>
namespace pg8 {
#define PG8_LAS __attribute__((address_space(3)))
typedef unsigned short bf16_t;
typedef short bf16x8 __attribute__((ext_vector_type(8)));
typedef float f32x4 __attribute__((ext_vector_type(4)));
typedef unsigned u32x4 __attribute__((ext_vector_type(4)));
constexpr int BM = 256, BK = 64, HALF = 128, HTB = HALF * BK * 2  , STAGE_BYTES = 8 * HTB, NXCD = 8, WGM = 8;

__host__ __device__ __forceinline__ int lds_byte(int r, int c) { const int st = (r >> 4) * 2 + (c >> 5), rr = r & 15, cc = c & 31, ob = rr * 64 + cc * 2; return st * 1024 + (ob ^ (((ob >> 9) & 1) << 5)); }
__host__ __device__ __forceinline__ void stage_rc(int b, int& R, int& C) { const int st = b / 1024, sb = b % 1024, swz = sb ^ (((sb >> 9) & 1) << 5); R = (st >> 1) * 16 + swz / 64; C = (st & 1) * 32 + (swz % 64) / 2; }
__host__ __device__ __forceinline__ int perm32(int rho) { const int n = rho >> 4, i = rho & 15; return 8 * (i >> 2) + 4 * n + (i & 3); }

struct Unit { int pm, pn; };
struct Gemm { const bf16_t* A; const bf16_t* Bt; int M, N, K; };

struct StaticOrder {
    int nM, nN, nwg, G, c;
    __host__ __device__ void init(int M, int N, int G_, int c_) { nM = M / BM; nN = N / BM; nwg = nM * nN; G = G_; c = c_; }
    __host__ __device__ bool next(int i, Unit& u) const {
        const long L = (long)i * G + c; if (L >= nwg) return false;
        int wgid = (int)L; { const int q = nwg / NXCD, r = nwg % NXCD, xcd = wgid % NXCD, off = wgid / NXCD; wgid = (xcd < r ? xcd * (q + 1) : r * (q + 1) + (xcd - r) * q) + off; }
        const int nig = WGM * nN, gid = wgid / nig, fm = gid * WGM, gsz = (nM - fm) < WGM ? (nM - fm) : WGM;
        u.pm = fm + ((wgid % nig) % gsz); u.pn = (wgid % nig) / gsz; return true;
    }
    __device__ __forceinline__ void a_ready(const Unit&) const {}
    __device__ __forceinline__ void done(const Unit&) const {}
};

__device__ __forceinline__ unsigned cvt_pk_bf16(float lo, float hi) { unsigned r; asm volatile("v_cvt_pk_bf16_f32 %0, %1, %2" : "=v"(r) : "v"(lo), "v"(hi)); return r; }
__device__ __forceinline__ float fast_sigmoid(float x) { return __builtin_amdgcn_rcpf(1.0f + __builtin_amdgcn_exp2f(-1.4426950408889634f * x)); }

struct EpiStore {
    static constexpr bool PERM = true, AFTER_DRAIN = false;
    bf16_t* O; int ldc;
    __device__ __forceinline__ void operator()(const f32x4 (&acc)[2][2][4][2], const Unit& u, int wr, int wc, int fr, int fq) const {
        const int row0 = u.pm * BM + wr * 64 + fr, col0 = u.pn * BM + wc * 32 + 8 * fq;
#pragma unroll
        for (int ai = 0; ai < 2; ++ai)
#pragma unroll
            for (int m = 0; m < 4; ++m) { bf16_t* rowp = O + (size_t)(row0 + ai * HALF + m * 16) * ldc + col0;
#pragma unroll
                for (int bj = 0; bj < 2; ++bj) { const f32x4 v0 = acc[ai][bj][m][0], v1 = acc[ai][bj][m][1];
                    u32x4 w; w.x = cvt_pk_bf16(v0[0], v0[1]); w.y = cvt_pk_bf16(v0[2], v0[3]); w.z = cvt_pk_bf16(v1[0], v1[1]); w.w = cvt_pk_bf16(v1[2], v1[3]);
                    *(u32x4*)(rowp + bj * HALF) = w; } }
    }
};
struct EpiOdd1 {
    static constexpr bool PERM = true, AFTER_DRAIN = false;
    bf16_t* Z; bf16_t* XBC; float* DTRAW;
    __device__ __forceinline__ void operator()(const f32x4 (&acc)[2][2][4][2], const Unit& u, int wr, int wc, int fr, int fq) const {
        const int row0 = u.pm * BM + wr * 64 + fr;
        if (u.pn >= 40) {
#pragma unroll
            for (int ai = 0; ai < 2; ++ai)
#pragma unroll
                for (int m = 0; m < 4; ++m) { float* rp = DTRAW + (size_t)(row0 + ai * HALF + m * 16) * 128 + wc * 32 + 8 * fq;
                    *(f32x4*)(rp) = acc[ai][0][m][0]; *(f32x4*)(rp + 4) = acc[ai][0][m][1]; }
            return;
        }
        bf16_t* base; int ldc, colt;
        if (u.pn < 16) { base = Z; ldc = 4096; colt = u.pn * BM; } else { base = XBC; ldc = 6144; colt = (u.pn - 16) * BM; }
        const int col0 = colt + wc * 32 + 8 * fq;
#pragma unroll
        for (int ai = 0; ai < 2; ++ai)
#pragma unroll
            for (int m = 0; m < 4; ++m) { bf16_t* rowp = base + (size_t)(row0 + ai * HALF + m * 16) * ldc + col0;
#pragma unroll
                for (int bj = 0; bj < 2; ++bj) { const f32x4 v0 = acc[ai][bj][m][0], v1 = acc[ai][bj][m][1];
                    u32x4 w; w.x = cvt_pk_bf16(v0[0], v0[1]); w.y = cvt_pk_bf16(v0[2], v0[3]); w.z = cvt_pk_bf16(v1[0], v1[1]); w.w = cvt_pk_bf16(v1[2], v1[3]);
                    *(u32x4*)(rowp + bj * HALF) = w; } }
    }
};
struct EpiSwiGLU {
    static constexpr bool PERM = true, AFTER_DRAIN = false;
    bf16_t* O; int ldc;
    __device__ __forceinline__ void operator()(const f32x4 (&acc)[2][2][4][2], const Unit& u, int wr, int wc, int fr, int fq) const {
        const int row0 = u.pm * BM + wr * 64 + fr, col0 = u.pn * HALF + wc * 32 + 8 * fq;
#pragma unroll
        for (int ai = 0; ai < 2; ++ai)
#pragma unroll
            for (int m = 0; m < 4; ++m) { bf16_t* rowp = O + (size_t)(row0 + ai * HALF + m * 16) * ldc + col0;
                float o[8];
#pragma unroll
                for (int n = 0; n < 2; ++n)
#pragma unroll
                    for (int j = 0; j < 4; ++j) { const float g = acc[ai][0][m][n][j], uu = acc[ai][1][m][n][j]; o[n * 4 + j] = g * fast_sigmoid(g) * uu; }
                u32x4 w; w.x = cvt_pk_bf16(o[0], o[1]); w.y = cvt_pk_bf16(o[2], o[3]); w.z = cvt_pk_bf16(o[4], o[5]); w.w = cvt_pk_bf16(o[6], o[7]);
                *(u32x4*)(rowp) = w; }
    }
};
struct EpiResid {
    static constexpr bool PERM = false, AFTER_DRAIN = false;
    float* Y; const float* gate;
    __device__ __forceinline__ void operator()(const f32x4 (&acc)[2][2][4][2], const Unit& u, int wr, int wc, int fr, int fq) const {
        const int row0 = u.pm * BM + wr * 64 + fr, col0 = u.pn * BM + wc * 32 + 4 * fq;
        const int cond = u.pm < 16 ? 0 : 1 + ((u.pm - 16) >> 3);
        const float* gp = gate + (size_t)cond * 12288 + col0;
        f32x4 gv[2][2];
#pragma unroll
        for (int bj = 0; bj < 2; ++bj)
#pragma unroll
            for (int n = 0; n < 2; ++n) gv[bj][n] = *(const f32x4*)(gp + bj * HALF + n * 16);
#pragma unroll
        for (int ai = 0; ai < 2; ++ai)
#pragma unroll
            for (int m = 0; m < 4; ++m) { float* rowp = Y + (size_t)(row0 + ai * HALF + m * 16) * 2048 + col0;
#pragma unroll
                for (int bj = 0; bj < 2; ++bj)
#pragma unroll
                    for (int n = 0; n < 2; ++n) { f32x4* p = (f32x4*)(rowp + bj * HALF + n * 16); *p = *p + gv[bj][n] * acc[ai][bj][m][n]; } }
    }
};

template <class Epi, class Sched, bool ALIGN_EPI = false, bool SP2 = false>
__device__ __forceinline__ void gemm_phase(PG8_LAS unsigned char* lds, const Gemm g, const Sched& S, const Epi& E) {
    int tid_ = threadIdx.x; asm volatile("" : "+v"(tid_)); const int tid = tid_, wid = __builtin_amdgcn_readfirstlane(tid >> 6), lane = tid & 63, wr = wid >> 2, wc = wid & 3, fr = lane & 15, fq = lane >> 4;
    const int K = g.K, nt = K / BK;
    unsigned voffA[2], voffB[2];
#pragma unroll
    for (int i = 0; i < 2; ++i) { int R, C; stage_rc(tid * 16 + i * 8192, R, C); const int Rb = Epi::PERM ? ((R & ~31) + perm32(R & 31)) : R;
        voffA[i] = (unsigned)(R * K + C) * 2u; voffB[i] = (unsigned)(Rb * K + C) * 2u; }
    const size_t kstep = (size_t)(BK * 2);
    const size_t hstep = (size_t)HALF * K * 2;
    const size_t tstep = 2 * hstep;
    const unsigned ldsw = (unsigned)wid * 1024u;
    const int aoff = lds_byte(wr * 64 + fr, fq * 8), boff = lds_byte(wc * 32 + fr, fq * 8);
#define PG8_SA(b, h) (((b) * 2 + (h)) * HTB)
#define PG8_SB(b, h) ((4 + (b) * 2 + (h)) * HTB)
#define PG8_STAGE(bufoff, gbase, voff) do { _Pragma("unroll") for (int _i = 0; _i < 2; ++_i) \
        __builtin_amdgcn_global_load_lds((const unsigned*)((const char*)(gbase) + (voff)[_i]), (PG8_LAS unsigned*)(lds + (bufoff) + ldsw + _i * 8192), 16, 0, 0); } while (0)
#define PG8_LDA(dst, b, h) do { _Pragma("unroll") for (int m = 0; m < 4; ++m) _Pragma("unroll") for (int k = 0; k < 2; ++k) dst[m][k] = *(const PG8_LAS bf16x8*)(lds + PG8_SA(b, h) + aoff + m * 2048 + k * 1024); } while (0)
#define PG8_LDB(dst, b, h) do { _Pragma("unroll") for (int n = 0; n < 2; ++n) _Pragma("unroll") for (int k = 0; k < 2; ++k) dst[n][k] = *(const PG8_LAS bf16x8*)(lds + PG8_SB(b, h) + boff + n * 2048 + k * 1024); } while (0)
#define PG8_MMA(ai, bj, At, Bt) do { __builtin_amdgcn_s_setprio(1); _Pragma("unroll") for (int m = 0; m < 4; ++m) _Pragma("unroll") for (int n = 0; n < 2; ++n) _Pragma("unroll") for (int k = 0; k < 2; ++k) \
        acc[ai][bj][m][n] = __builtin_amdgcn_mfma_f32_16x16x32_bf16(Bt[n][k], At[m][k], acc[ai][bj][m][n], 0, 0, 0); __builtin_amdgcn_s_setprio(0); } while (0)
#define PG8_WAIT_V(n) asm volatile("s_waitcnt vmcnt(" #n ")" ::: "memory")
#define PG8_WAIT_L(n) asm volatile("s_waitcnt lgkmcnt(" #n ")" ::: "memory")
#define PG8_BAR __builtin_amdgcn_s_barrier()
#define PG8_SCHED __builtin_amdgcn_sched_barrier(0)
    Unit cur, nxt; int ui = 0;
    if (!S.next(0, cur)) return;
    f32x4 acc[2][2][4][2];
#pragma unroll
    for (int a = 0; a < 2; ++a)
#pragma unroll
        for (int b = 0; b < 2; ++b)
#pragma unroll
            for (int m = 0; m < 4; ++m)
#pragma unroll
                for (int n = 0; n < 2; ++n) acc[a][b][m][n] = (f32x4){0.f, 0.f, 0.f, 0.f};
    bf16x8 At[4][2], B0[2][2], B1[2][2];
    const char* cA = (const char*)g.A + (size_t)cur.pm * tstep; const char* cB = (const char*)g.Bt + (size_t)cur.pn * tstep;
    S.a_ready(cur);
    if constexpr (SP2) {
        PG8_STAGE(PG8_SB(0, 0), cB, voffB); PG8_STAGE(PG8_SB(0, 1), cB + hstep, voffB); PG8_STAGE(PG8_SA(0, 0), cA, voffA); PG8_STAGE(PG8_SA(0, 1), cA + hstep, voffA);
        if (wr == 1) PG8_BAR;
        PG8_WAIT_V(2); PG8_BAR;
        PG8_STAGE(PG8_SB(1, 0), cB + kstep, voffB); PG8_STAGE(PG8_SA(1, 0), cA + kstep, voffA); PG8_STAGE(PG8_SB(1, 1), cB + hstep + kstep, voffB);
        PG8_WAIT_V(6); PG8_BAR;
    } else {
        PG8_STAGE(PG8_SB(0, 0), cB, voffB); PG8_STAGE(PG8_SA(0, 0), cA, voffA); PG8_STAGE(PG8_SB(0, 1), cB + hstep, voffB); PG8_STAGE(PG8_SA(0, 1), cA + hstep, voffA);
        if (wr == 1) PG8_BAR;
        PG8_WAIT_V(4); PG8_BAR;
        PG8_STAGE(PG8_SB(1, 0), cB + kstep, voffB); PG8_STAGE(PG8_SA(1, 0), cA + kstep, voffA); PG8_STAGE(PG8_SB(1, 1), cB + hstep + kstep, voffB);
        PG8_WAIT_V(6); PG8_BAR;
    }
    for (;;) {
        const bool has_next = S.next(ui + 1, nxt);
        const char* nA = has_next ? (const char*)g.A + (size_t)nxt.pm * tstep : cA; const char* nB = has_next ? (const char*)g.Bt + (size_t)nxt.pn * tstep : cB;
        for (int t = 0; t < nt; t += 2) {
            const bool last = (t == nt - 2);
            const char* a1 = cA + (size_t)(t + 1) * kstep;
            const char* a2 = last ? nA : cA + (size_t)(t + 2) * kstep; const char* b2 = last ? nB : cB + (size_t)(t + 2) * kstep;
            const char* a3 = a2 + kstep; const char* b3 = b2 + kstep;
            if (last && has_next) S.a_ready(nxt);
            if constexpr (SP2) {
            PG8_LDB(B0, 0, 0); PG8_LDB(B1, 0, 1); PG8_SCHED; PG8_LDA(At, 0, 0); PG8_STAGE(PG8_SA(1, 1), a1 + hstep, voffA);
            PG8_WAIT_V(8); PG8_WAIT_L(0); PG8_BAR; PG8_MMA(0, 0, At, B0); PG8_MMA(0, 1, At, B1); PG8_BAR; PG8_SCHED;
            PG8_LDA(At, 0, 1); PG8_STAGE(PG8_SB(0, 0), b2, voffB); PG8_STAGE(PG8_SB(0, 1), b2 + hstep, voffB); PG8_STAGE(PG8_SA(0, 0), a2, voffA);
            PG8_WAIT_V(8); PG8_WAIT_L(0); PG8_BAR; PG8_MMA(1, 0, At, B0); PG8_MMA(1, 1, At, B1); PG8_BAR; PG8_SCHED;
            PG8_LDB(B0, 1, 0); PG8_LDB(B1, 1, 1); PG8_SCHED; PG8_LDA(At, 1, 0); PG8_STAGE(PG8_SA(0, 1), a2 + hstep, voffA);
            PG8_WAIT_V(8); PG8_WAIT_L(0); PG8_BAR; PG8_MMA(0, 0, At, B0); PG8_MMA(0, 1, At, B1); PG8_BAR; PG8_SCHED;
            PG8_LDA(At, 1, 1); PG8_STAGE(PG8_SB(1, 0), b3, voffB); PG8_STAGE(PG8_SB(1, 1), b3 + hstep, voffB); PG8_STAGE(PG8_SA(1, 0), a3, voffA);
            PG8_WAIT_V(8); PG8_WAIT_L(0); PG8_BAR; PG8_MMA(1, 0, At, B0); PG8_MMA(1, 1, At, B1); PG8_BAR; PG8_SCHED;
            } else {
            PG8_LDB(B0, 0, 0); PG8_SCHED; PG8_LDA(At, 0, 0); PG8_STAGE(PG8_SA(1, 1), a1 + hstep, voffA);
            PG8_WAIT_L(8); PG8_BAR; PG8_WAIT_L(0); PG8_MMA(0, 0, At, B0); PG8_BAR; PG8_SCHED;
            PG8_LDB(B1, 0, 1); PG8_STAGE(PG8_SB(0, 0), b2, voffB);
            PG8_BAR; PG8_WAIT_L(0); PG8_MMA(0, 1, At, B1); PG8_BAR;
            PG8_LDA(At, 0, 1); PG8_STAGE(PG8_SA(0, 0), a2, voffA);
            PG8_BAR; PG8_WAIT_L(0); PG8_MMA(1, 0, At, B0); PG8_BAR; PG8_SCHED;
            PG8_STAGE(PG8_SB(0, 1), b2 + hstep, voffB);
            PG8_WAIT_V(6); PG8_BAR; PG8_MMA(1, 1, At, B1); PG8_BAR;
            PG8_LDB(B0, 1, 0); PG8_SCHED; PG8_LDA(At, 1, 0); PG8_STAGE(PG8_SA(0, 1), a2 + hstep, voffA);
            PG8_WAIT_L(8); PG8_BAR; PG8_WAIT_L(0); PG8_MMA(0, 0, At, B0); PG8_BAR; PG8_SCHED;
            PG8_LDB(B1, 1, 1); PG8_STAGE(PG8_SB(1, 0), b3, voffB);
            PG8_BAR; PG8_WAIT_L(0); PG8_MMA(0, 1, At, B1); PG8_BAR;
            PG8_LDA(At, 1, 1); PG8_STAGE(PG8_SA(1, 0), a3, voffA);
            PG8_BAR; PG8_WAIT_L(0); PG8_MMA(1, 0, At, B0); PG8_BAR; PG8_SCHED;
            PG8_STAGE(PG8_SB(1, 1), b3 + hstep, voffB);
            PG8_WAIT_V(6); PG8_BAR; PG8_MMA(1, 1, At, B1); PG8_BAR;
            }
        }
        if constexpr (ALIGN_EPI) { if (wr == 0) PG8_BAR; }
        if constexpr (!Epi::AFTER_DRAIN) { E(acc, cur, wr, wc, fr, fq); S.done(cur); }
        if (!has_next) break;
#pragma unroll
        for (int a = 0; a < 2; ++a)
#pragma unroll
            for (int b = 0; b < 2; ++b)
#pragma unroll
                for (int m = 0; m < 4; ++m)
#pragma unroll
                    for (int n = 0; n < 2; ++n) acc[a][b][m][n] = (f32x4){0.f, 0.f, 0.f, 0.f};
        cur = nxt; cA = nA; cB = nB; ++ui;
        if constexpr (ALIGN_EPI) { if (wr == 1) PG8_BAR; }
    }
    PG8_WAIT_V(0);
    if constexpr (!ALIGN_EPI) { if (wr == 0) PG8_BAR; }
    PG8_BAR;
    if constexpr (Epi::AFTER_DRAIN) { E.fused(acc, cur, wr, wc, fr, fq, lds, wid, lane); S.done(cur); }
#undef PG8_SA
#undef PG8_SB
#undef PG8_STAGE
#undef PG8_LDA
#undef PG8_LDB
#undef PG8_MMA
#undef PG8_WAIT_V
#undef PG8_WAIT_L
#undef PG8_BAR
#undef PG8_SCHED
}
}

#define GAS __attribute__((address_space(1)))
#define LAS __attribute__((address_space(3)))
typedef unsigned short bf16_t;
typedef short bf16x8 __attribute__((ext_vector_type(8)));
typedef short bf16x4 __attribute__((ext_vector_type(4)));
typedef float f32x4 __attribute__((ext_vector_type(4)));
typedef float f32x2 __attribute__((ext_vector_type(2)));
typedef unsigned u32x4 __attribute__((ext_vector_type(4)));
typedef unsigned u32x2 __attribute__((ext_vector_type(2)));
#define MFMA16(a, b, c) __builtin_amdgcn_mfma_f32_16x16x32_bf16((a), (b), (c), 0, 0, 0)

constexpr int D = 2048, T = 20480, TP = 4096, NT = 80;
constexpr float EPS = 1e-6f;
constexpr size_t MiB = 1u << 20;
constexpr size_t WS_CTL = 0, WS_ADA = 1 * MiB, WS_ZERO_BYTES = 3 * MiB;
constexpr size_t WS_ROPE = 3 * MiB, WS_LRUW = 4 * MiB, WS_CHS = 6 * MiB;
constexpr size_t WS_WEIN = 16 * MiB, WS_WEOUT = 56 * MiB, WS_WSIN = 72 * MiB, WS_WSOUT = 154 * MiB, WS_WFIN = 186 * MiB, WS_WFOUT = 362 * MiB;
constexpr size_t WS_H = 450 * MiB, WS_R1 = 530 * MiB, WS_R2 = 770 * MiB, WS_R3 = 930 * MiB, WS_R4 = 1090 * MiB, WS_R5 = 1210 * MiB, WS_END = 1242 * MiB;
constexpr size_t WS_U5 = WS_R1, WS_Q = WS_R2, WS_K = WS_R2 + 40 * MiB, WS_KC = WS_R2 + 80 * MiB, WS_VTP = WS_R2 + 84 * MiB, WS_VTS = WS_R2 + 92 * MiB, WS_MIXE = WS_R3;
constexpr size_t WS_XBC = WS_R1, WS_Z = WS_R2, WS_XT = WS_R3, WS_BN = WS_R4, WS_BT = WS_R4 + 40 * MiB, WS_CN = WS_R4 + 80 * MiB, WS_DTRAW = WS_R5;
constexpr size_t WS_SIN = WS_H, WS_MIXO = WS_R1 + 80 * MiB;
constexpr size_t WS_HID = WS_R1;
constexpr size_t OUT_K = 41943040, OUT_V = 50331648, OUT_LRU = 58720256, OUT_SSD = 58785792;
constexpr int LDS_MISC = 131072, LDS_BYTES = 131072 + 1024;

struct Args { const float* in[34]; float* out; unsigned char* ws; int ph_lo, ph_hi; };

__device__ __forceinline__ float bf2f(unsigned short b) { return __uint_as_float(((unsigned)b) << 16); }
__device__ __forceinline__ float bflo(unsigned w) { return __uint_as_float(w << 16); }
__device__ __forceinline__ float bfhi(unsigned w) { return __uint_as_float(w & 0xffff0000u); }
__device__ __forceinline__ unsigned pk2(float lo, float hi) { return pg8::cvt_pk_bf16(lo, hi); }
__device__ __forceinline__ float fexp(float x) { return __builtin_amdgcn_exp2f(1.4426950408889634f * x); }
__device__ __forceinline__ float fsigmoid(float x) { return __builtin_amdgcn_rcpf(1.0f + __builtin_amdgcn_exp2f(-1.4426950408889634f * x)); }
__device__ __forceinline__ float fsilu(float x) { return x * fsigmoid(x); }
__device__ __forceinline__ float fsoftplus(float x) { return fmaxf(x, 0.f) + log1pf(fexp(-fabsf(x))); }
__device__ __forceinline__ float fgelu_tanh(float x) { const float u = 0.7978845608028654f * (x + 0.044715f * x * x * x); const float t = 1.f - 2.f * __builtin_amdgcn_rcpf(fexp(2.f * u) + 1.f); return 0.5f * x * (1.f + t); }
__device__ __forceinline__ float wave_sum(float v) {
#pragma unroll
    for (int o = 1; o < 64; o <<= 1) v += __shfl_xor(v, o);
    return v;
}
__device__ __forceinline__ void unpack8(const u32x4 v, float (&f)[8]) { f[0] = bflo(v.x); f[1] = bfhi(v.x); f[2] = bflo(v.y); f[3] = bfhi(v.y); f[4] = bflo(v.z); f[5] = bfhi(v.z); f[6] = bflo(v.w); f[7] = bfhi(v.w); }
__device__ __forceinline__ u32x4 pack8(const float (&f)[8]) { u32x4 w; w.x = pk2(f[0], f[1]); w.y = pk2(f[2], f[3]); w.z = pk2(f[4], f[5]); w.w = pk2(f[6], f[7]); return w; }
__device__ __forceinline__ bf16x8 as_bf16x8(u32x4 v) { return __builtin_bit_cast(bf16x8, v); }
__device__ __forceinline__ int cond_of_tok(int t) { return t < TP ? 0 : 1 + ((t - TP) >> 11); }
__device__ __forceinline__ int otid() { int t = threadIdx.x; asm volatile("" : "+v"(t)); return t; }
#define WG_SYNC() __syncthreads()
#ifndef DBG_SUB
#define DBG_SUB 3
#endif

#define XB_TMO      128
#define XB_XCNT(j)  (256  + 64 * (j))
#define XB_XSUB(j)  (1280 + 64 * (j))
#define XB_XGEN(j)  (2304 + 64 * (j))
#define XB_TOP      3328
#define XB_TOPGEN   3392
#define XCD_BAR_WORDS 3456
#define XB_SPIN_CAP (1u << 18)

__device__ __forceinline__ unsigned xb_ld(unsigned* p)              { return __hip_atomic_load(p, __ATOMIC_RELAXED, __HIP_MEMORY_SCOPE_AGENT); }
__device__ __forceinline__ unsigned xb_add(unsigned* p, unsigned v) { return __hip_atomic_fetch_add(p, v, __ATOMIC_RELAXED, __HIP_MEMORY_SCOPE_AGENT); }
__device__ __forceinline__ unsigned xb_xcc_id() { return (unsigned)__builtin_amdgcn_s_getreg((3 << 11) | 20) & 0xFu; }
#define XB_SPIN(cond, bar) do { unsigned _sp = 0; while (cond) { __builtin_amdgcn_s_sleep(1); \
    if ((++_sp & 255u) == 0u) { if (xb_ld(&(bar)[XB_TMO])) break; if (_sp > XB_SPIN_CAP) { atomicAdd(&(bar)[XB_TMO], 1u); break; } } } } while (0)

struct XcdBarrier {
    unsigned* bar; unsigned x;
    volatile LAS unsigned* st;
};

__device__ __forceinline__ XcdBarrier xcd_barrier_post(unsigned* bar, volatile LAS unsigned* st) {
    XcdBarrier b; b.bar = bar; b.x = xb_xcc_id(); b.st = st;
    if (threadIdx.x == 0) (void)xb_add(&bar[XB_XCNT(b.x)], 1u);
    return b;
}
__device__ __forceinline__ void xcd_barrier_complete(unsigned* bar, unsigned x, unsigned& nloc, unsigned& nx) {
    const unsigned G = gridDim.x * gridDim.y * gridDim.z;
    unsigned sum, cnt, mine, sp = 0u;
    for (;;) {
        sum = 0u; cnt = 0u; mine = 0u;
#pragma unroll
        for (unsigned j = 0; j < 16; ++j) { const unsigned c = xb_ld(&bar[XB_XCNT(j)]); sum += c; cnt += (c > 0u) ? 1u : 0u; mine = (j == x) ? c : mine; }
        if (sum == G) break;
        __builtin_amdgcn_s_sleep(1);
        if ((++sp & 255u) == 0u) { if (xb_ld(&bar[XB_TMO])) break; if (sp > XB_SPIN_CAP) { atomicAdd(&bar[XB_TMO], 1u); break; } }
    }
    nloc = mine > 0u ? mine : 1u; nx = cnt > 0u ? cnt : 1u;
}

__device__ __forceinline__ void xcd_barrier(const XcdBarrier& b) {
    asm volatile("s_waitcnt vmcnt(0)" ::: "memory");
    __syncthreads();
    if (threadIdx.x == 0) {
        unsigned* bar = b.bar;
        __builtin_amdgcn_s_waitcnt(0);
        unsigned nloc = b.st[0], nx = b.st[1];
        if (nloc == 0u) { xcd_barrier_complete(bar, b.x, nloc, nx); b.st[0] = nloc; b.st[1] = nx; }
        const unsigned old = xb_add(&bar[XB_XSUB(b.x)], 1u);
        const unsigned gen = old / nloc;
        if (old + 1u == (gen + 1u) * nloc) {
            __builtin_amdgcn_fence(__ATOMIC_RELEASE, "agent");
            asm volatile("s_waitcnt vmcnt(0)" ::: "memory");
            const unsigned og = xb_add(&bar[XB_TOP], 1u);
            const unsigned tg = og / nx;
            if (og + 1u == (tg + 1u) * nx) xb_add(&bar[XB_TOPGEN], 1u);
            else XB_SPIN(xb_ld(&bar[XB_TOPGEN]) == tg, bar);
            __builtin_amdgcn_fence(__ATOMIC_ACQUIRE, "agent");
            xb_add(&bar[XB_XGEN(b.x)], 1u);
            asm volatile("s_waitcnt vmcnt(0)" ::: "memory");
        } else {
            XB_SPIN(xb_ld(&bar[XB_XGEN(b.x)]) == gen, bar);
            __builtin_amdgcn_fence(__ATOMIC_ACQUIRE, "agent");
            asm volatile("s_waitcnt vmcnt(0)" ::: "memory");
        }
    }
    __syncthreads();
}

__device__ __forceinline__ void transpose_item(const float* W, int N, bf16_t* WT, int ldk, int k0, int n0, int drow0, LAS float* scr, int lane) {
#pragma unroll 8
    for (int i = 0; i < 32; ++i) { const int kk = 2 * i + (lane >> 5); scr[kk * 33 + (lane & 31)] = W[(size_t)(k0 + kk) * N + n0 + (lane & 31)]; }
    asm volatile("s_waitcnt lgkmcnt(0)" ::: "memory");
    const int c = lane & 7;
#pragma unroll
    for (int jj = 0; jj < 4; ++jj) { const int n = (lane >> 3) + 8 * jj; const LAS float* s = scr + (8 * c) * 33 + n;
        u32x4 o; o.x = pk2(s[0 * 33], s[1 * 33]); o.y = pk2(s[2 * 33], s[3 * 33]); o.z = pk2(s[4 * 33], s[5 * 33]); o.w = pk2(s[6 * 33], s[7 * 33]);
        *(u32x4*)(WT + (size_t)(drow0 + n) * ldk + k0 + 8 * c) = o; }
    asm volatile("s_waitcnt lgkmcnt(0)" ::: "memory");
}

__device__ __forceinline__ void phase_prologue(const Args& A, LAS unsigned char* lds) {
    const int tid = otid(), lane = tid & 63, wave = tid >> 6;
    unsigned char* ws = A.ws;
    {
        LAS float* s = (LAS float*)lds;
        for (int idx = tid; idx < 9 * 2048; idx += 512) { const int cnd = idx >> 11, k = idx & 2047; const float v = cnd == 0 ? A.in[7][k] : A.in[2][(cnd - 1) * 2048 + k]; s[k * 12 + cnd] = v * fsigmoid(v); }
        WG_SYNC();
        float* ADA = (float*)(ws + WS_ADA);
        LAS float* red = (LAS float*)(lds + 98304);
        for (int it = blockIdx.x; it < 4 * 192; it += gridDim.x) {
            const int layer = it / 192, cg = it - layer * 192, col = cg * 64 + lane;
            float acc[9];
#pragma unroll
            for (int c = 0; c < 9; ++c) acc[c] = 0.f;
            const float* w = A.in[8] + ((size_t)layer * 2048 + wave * 256) * 12288 + col;
#pragma unroll 8
            for (int k = 0; k < 256; ++k) {
                const float wv = w[(size_t)k * 12288];
                const LAS f32x4* sp = (const LAS f32x4*)(s + (wave * 256 + k) * 12);
                const f32x4 s0 = sp[0], s1 = sp[1], s2 = sp[2];
                acc[0] += s0[0] * wv; acc[1] += s0[1] * wv; acc[2] += s0[2] * wv; acc[3] += s0[3] * wv;
                acc[4] += s1[0] * wv; acc[5] += s1[1] * wv; acc[6] += s1[2] * wv; acc[7] += s1[3] * wv; acc[8] += s2[0] * wv;
            }
            WG_SYNC();
#pragma unroll
            for (int c = 0; c < 9; ++c) red[(wave * 9 + c) * 64 + lane] = acc[c];
            WG_SYNC();
            for (int idx = tid; idx < 9 * 64; idx += 512) { const int c = idx >> 6, l = idx & 63; float v = A.in[9][(size_t)layer * 12288 + cg * 64 + l];
#pragma unroll
                for (int wv_ = 0; wv_ < 8; ++wv_) v += red[(wv_ * 9 + c) * 64 + l];
                ADA[((size_t)layer * 9 + c) * 12288 + cg * 64 + l] = v; }
        }
        WG_SYNC();
    }
    {
        float* rope = (float*)(ws + WS_ROPE);
        for (int idx = blockIdx.x * 512 + tid; idx < 2048 * 64; idx += gridDim.x * 512) {
            const int pos = idx >> 6, d = idx & 63, qtr = d >> 4, i = d & 15;
            const float inv = __builtin_amdgcn_exp2f(-(float)i * (13.287712379549449f / 16.0f));
            const float p = (qtr < 2) ? (float)(pos >> 6) : (float)(pos & 63);
            const float rev = p * inv * 0.15915494309189535f;
            rope[idx] = __builtin_amdgcn_cosf(rev); rope[2048 * 64 + idx] = __builtin_amdgcn_sinf(rev);
        }
    }
    {
        LAS float* scr = (LAS float*)(lds + wave * 16384);
        const int gw = blockIdx.x * 8 + wave, NGW = gridDim.x * 8;
        constexpr int I_EIN = 32 * 160, I_EOUT = 32 * 64, I_SIN = 32 * 324, I_SOUT = 64 * 64, I_FIN = 32 * 352, I_FOUT = 88 * 64, I_LRU = 8;
        constexpr int N0 = 2 * I_EIN, N1 = N0 + 2 * I_EOUT, N2 = N1 + 2 * I_SIN, N3 = N2 + 2 * I_SOUT, N4 = N3 + 4 * I_FIN, N5 = N4 + 4 * I_FOUT, N6 = N5 + 64 * I_LRU;
        for (int it = gw; it < N6; it += NGW) {
            if (it < N0) { const int mtx = it / I_EIN, r = it - mtx * I_EIN, kb = r / 160, nb = r - kb * 160;
                transpose_item(A.in[18] + (size_t)mtx * 2048 * 5120, 5120, (bf16_t*)(ws + WS_WEIN) + (size_t)mtx * 5120 * 2048, 2048, kb * 64, nb * 32, nb * 32, scr, lane); }
            else if (it < N1) { const int q = it - N0, mtx = q / I_EOUT, r = q - mtx * I_EOUT, kb = r / 64, nb = r - kb * 64;
                transpose_item(A.in[19] + (size_t)mtx * 2048 * 2048, 2048, (bf16_t*)(ws + WS_WEOUT) + (size_t)mtx * 2048 * 2048, 2048, kb * 64, nb * 32, nb * 32, scr, lane); }
            else if (it < N2) { const int q = it - N1, mtx = q / I_SIN, r = q - mtx * I_SIN, kb = r / 324, nb = r - kb * 324;
                transpose_item(A.in[24] + (size_t)mtx * 2048 * 10368, 10368, (bf16_t*)(ws + WS_WSIN) + (size_t)mtx * 10496 * 2048, 2048, kb * 64, nb * 32, nb * 32, scr, lane); }
            else if (it < N3) { const int q = it - N2, mtx = q / I_SOUT, r = q - mtx * I_SOUT, kb = r / 64, nb = r - kb * 64;
                transpose_item(A.in[31] + (size_t)mtx * 4096 * 2048, 2048, (bf16_t*)(ws + WS_WSOUT) + (size_t)mtx * 2048 * 4096, 4096, kb * 64, nb * 32, nb * 32, scr, lane); }
            else if (it < N4) { const int q = it - N3, mtx = q / I_FIN, r = q - mtx * I_FIN, kb = r / 352, nb = r - kb * 352;
                const int n0 = nb * 32; const int drow = n0 < 5632 ? (n0 >> 7) * 256 + (n0 & 127) : ((n0 - 5632) >> 7) * 256 + 128 + ((n0 - 5632) & 127);
                transpose_item(A.in[32] + (size_t)mtx * 2048 * 11264, 11264, (bf16_t*)(ws + WS_WFIN) + (size_t)mtx * 11264 * 2048, 2048, kb * 64, n0, drow, scr, lane); }
            else if (it < N5) { const int q = it - N4, mtx = q / I_FOUT, r = q - mtx * I_FOUT, kb = r / 64, nb = r - kb * 64;
                transpose_item(A.in[33] + (size_t)mtx * 5632 * 2048, 2048, (bf16_t*)(ws + WS_WFOUT) + (size_t)mtx * 2048 * 5632, 5632, kb * 64, nb * 32, nb * 32, scr, lane); }
            else { const int q = it - N5, mtx = q >> 3, r = q & 7, kb = r >> 2, nb = r & 3;
                const int blk = mtx & 7, gate = (mtx >> 3) & 1, jd = mtx >> 4;
                const float* src = (gate ? A.in[15] : A.in[13]) + ((size_t)jd * 8 + blk) * 16384;
                transpose_item(src, 128, (bf16_t*)(ws + WS_LRUW) + (size_t)mtx * 16384, 128, kb * 64, nb * 32, nb * 32, scr, lane); }
        }
        for (int idx = blockIdx.x * 512 + tid; idx < 2 * 128 * 2048 / 8; idx += gridDim.x * 512) {
            const int mtx = idx / (128 * 256), r = idx - mtx * (128 * 256);
            *(u32x4*)((bf16_t*)(ws + WS_WSIN) + (size_t)mtx * 10496 * 2048 + (size_t)10368 * 2048 + (size_t)r * 8) = (u32x4){0u, 0u, 0u, 0u};
        }
    }
}

__device__ __forceinline__ void phase_modulate(const Args& A, int layer, int which) {
    const int tid = otid(), lane = tid & 63, wave = tid >> 6;
    const int gw = blockIdx.x * 8 + wave, NGW = gridDim.x * 8;
    const float* g = A.in[10] + ((size_t)layer * 2 + which) * 2048;
    const float* ADA = (const float*)(A.ws + WS_ADA);
    bf16_t* H = (bf16_t*)(A.ws + WS_H);
    for (int row = gw; row < T; row += NGW) {
        const int cond = cond_of_tok(row);
        const float* shift = ADA + ((size_t)layer * 9 + cond) * 12288 + (which * 3 + 0) * 2048;
        const float* scale = shift + 2048;
        const f32x4* xr = (const f32x4*)(A.out + (size_t)row * 2048) + lane;
        f32x4 v[8]; float ss = 0.f;
#pragma unroll
        for (int jj = 0; jj < 8; ++jj) { v[jj] = xr[64 * jj]; ss += (v[jj][0] * v[jj][0] + v[jj][1] * v[jj][1]) + (v[jj][2] * v[jj][2] + v[jj][3] * v[jj][3]); }
        const float rstd = 1.0f / sqrtf(wave_sum(ss) * (1.f / 2048.f) + EPS);
        u32x2* o8 = (u32x2*)(H + (size_t)row * 2048) + lane;
#pragma unroll
        for (int jj = 0; jj < 8; ++jj) { const int c = 4 * lane + 256 * jj;
            const f32x4 gg = *(const f32x4*)(g + c), sc = *(const f32x4*)(scale + c), sh = *(const f32x4*)(shift + c);
            f32x4 o = v[jj] * rstd * gg * (sc + 1.0f) + sh;
            u32x2 w; w.x = pk2(o[0], o[1]); w.y = pk2(o[2], o[3]); o8[64 * jj] = w; }
    }
}

constexpr float QSCALE = 0.125f * 1.4426950408889634f;

template <bool F32SRC>
__device__ __forceinline__ void vt_tile(const void* src, size_t src_ld, bf16_t* dst, int Lk, LAS bf16_t* scr  , int lane) {
#pragma unroll 4
    for (int i = 0; i < 16; ++i) { const int p = lane + 64 * i, row = p >> 4, pc = p & 15;
        u32x4 v;
        if (F32SRC) { const float* s = (const float*)src + (size_t)row * src_ld + pc * 8; const f32x4 a = *(const f32x4*)s, b = *(const f32x4*)(s + 4);
            v.x = pk2(a[0], a[1]); v.y = pk2(a[2], a[3]); v.z = pk2(b[0], b[1]); v.w = pk2(b[2], b[3]); }
        else v = *(const u32x4*)((const bf16_t*)src + (size_t)row * src_ld + pc * 8);
        *(LAS u32x4*)(scr + row * 128 + pc * 8) = v; }
    asm volatile("s_waitcnt lgkmcnt(0)" ::: "memory");
#pragma unroll 4
    for (int i = 0; i < 16; ++i) { const int p = lane + 64 * i, dv = p & 127, tg = p >> 7;
        unsigned short e[8];
#pragma unroll
        for (int k = 0; k < 8; ++k) e[k] = scr[(8 * tg + k) * 128 + dv];
        u32x4 v; v.x = e[0] | ((unsigned)e[1] << 16); v.y = e[2] | ((unsigned)e[3] << 16); v.z = e[4] | ((unsigned)e[5] << 16); v.w = e[6] | ((unsigned)e[7] << 16);
        *(u32x4*)(dst + (size_t)dv * Lk + 8 * tg) = v; }
    asm volatile("s_waitcnt lgkmcnt(0)" ::: "memory");
}

__device__ __forceinline__ void phase_qkv_prep(const Args& A, LAS unsigned char* lds, int j) {
    const int tid = otid(), lane = tid & 63, wave = tid >> 6;
    unsigned char* ws = A.ws;
    const bf16_t* U5 = (const bf16_t*)(ws + WS_U5);
    bf16_t* Qb = (bf16_t*)(ws + WS_Q); bf16_t* Kb = (bf16_t*)(ws + WS_K); bf16_t* KC = (bf16_t*)(ws + WS_KC);
    bf16_t* VTP = (bf16_t*)(ws + WS_VTP); bf16_t* VTS = (bf16_t*)(ws + WS_VTS);
    const float* rope = (const float*)(ws + WS_ROPE);
    LAS bf16_t* scr = (LAS bf16_t*)(lds + wave * 16384);
    const int mq = (lane >> 2) & 1, aq = lane & 3;
    float qn[16], kn[16];
#pragma unroll
    for (int i = 0; i < 16; ++i) { qn[i] = A.in[20][((size_t)j * 2 + mq) * 64 + aq * 16 + i]; kn[i] = A.in[21][((size_t)j * 2 + mq) * 64 + aq * 16 + i]; }
    for (int u = blockIdx.x; u < 320 + 32; u += gridDim.x) {
        if (u < 320) {
            const int t0 = u * 64;
            const int sample = t0 >= TP, b = sample ? (t0 - TP) >> 11 : t0 >> 8, l0 = sample ? (t0 - TP) & 2047 : t0 & 255;
            for (int tt = 0; tt < 8; ++tt) {
                const int tok = wave * 8 + tt, t = t0 + tok, l = l0 + tok;
                float cs[16], sn[16];
                if (sample) {
#pragma unroll
                    for (int i = 0; i < 16; i += 4) { const f32x4 c4 = *(const f32x4*)(rope + (size_t)l * 64 + aq * 16 + i), s4 = *(const f32x4*)(rope + 2048 * 64 + (size_t)l * 64 + aq * 16 + i);
                        cs[i] = c4[0]; cs[i + 1] = c4[1]; cs[i + 2] = c4[2]; cs[i + 3] = c4[3]; sn[i] = s4[0]; sn[i + 1] = s4[1]; sn[i + 2] = s4[2]; sn[i + 3] = s4[3]; }
                }
#pragma unroll
                for (int qk = 0; qk < 2; ++qk) {
                    const bf16_t* src = U5 + (size_t)t * 5120 + (qk == 0 ? 2048 : 3072) + 16 * lane;
                    float x[16]; { float a[8], c[8]; unpack8(*(const u32x4*)src, a); unpack8(*(const u32x4*)(src + 8), c);
#pragma unroll
                        for (int i = 0; i < 8; ++i) { x[i] = a[i]; x[8 + i] = c[i]; } }
                    float ss = 0.f;
#pragma unroll
                    for (int i = 0; i < 16; ++i) ss += x[i] * x[i];
                    ss += __shfl_xor(ss, 1); ss += __shfl_xor(ss, 2);
                    const float rstd = 1.0f / sqrtf(ss * (1.f / 64.f) + EPS);
#pragma unroll
                    for (int i = 0; i < 16; ++i) x[i] = x[i] * rstd * (qk == 0 ? qn[i] : kn[i]);
                    if (qk == 1 && !sample) {
                        float* o = A.out + OUT_K + (((size_t)b * 2 + j) * 256 + l) * 1024 + 16 * lane;
#pragma unroll
                        for (int i = 0; i < 16; i += 4) *(f32x4*)(o + i) = (f32x4){x[i], x[i + 1], x[i + 2], x[i + 3]};
                    }
                    if (sample) {
#pragma unroll
                        for (int i = 0; i < 16; ++i) { const float partner = __shfl_xor(x[i], 1); x[i] = (aq & 1) ? (x[i] * cs[i] + partner * sn[i]) : (x[i] * cs[i] - partner * sn[i]); }
                    }
                    if (qk == 0) {
#pragma unroll
                        for (int i = 0; i < 16; ++i) x[i] *= QSCALE;
                    }
                    bf16_t* dst = (qk == 0 ? Qb : Kb) + (size_t)t * 1024 + 16 * lane;
                    u32x4 w0, w1; w0.x = pk2(x[0], x[1]); w0.y = pk2(x[2], x[3]); w0.z = pk2(x[4], x[5]); w0.w = pk2(x[6], x[7]);
                    w1.x = pk2(x[8], x[9]); w1.y = pk2(x[10], x[11]); w1.z = pk2(x[12], x[13]); w1.w = pk2(x[14], x[15]);
                    *(u32x4*)dst = w0; *(u32x4*)(dst + 8) = w1;
                }
                if (!sample) {
                    const bf16_t* src = U5 + (size_t)t * 5120 + 4096 + 16 * lane;
                    float a[8], c[8]; unpack8(*(const u32x4*)src, a); unpack8(*(const u32x4*)(src + 8), c);
                    float* o = A.out + OUT_V + (((size_t)b * 2 + j) * 256 + l) * 1024 + 16 * lane;
                    *(f32x4*)(o) = (f32x4){a[0], a[1], a[2], a[3]}; *(f32x4*)(o + 4) = (f32x4){a[4], a[5], a[6], a[7]};
                    *(f32x4*)(o + 8) = (f32x4){c[0], c[1], c[2], c[3]}; *(f32x4*)(o + 12) = (f32x4){c[4], c[5], c[6], c[7]};
                }
            }
            {
                const int h = wave;
                bf16_t* dst = sample ? VTS + (((size_t)b * 8 + h) * 128) * 2304 + l0 : VTP + (((size_t)b * 8 + h) * 128) * 256 + l0;
                vt_tile<false>(U5 + (size_t)t0 * 5120 + 4096 + h * 128, 5120, dst, sample ? 2304 : 256, scr, lane);
            }
        } else {
            const int uu = u - 320, b = uu >> 2, k0 = (uu & 3) * 64;
            const float* ck = A.in[3] + (((size_t)b * 2 + j) * 256 + k0) * 1024;
            for (int idx = tid; idx < 64 * 1024 / 8; idx += 512) { const float* s = ck + (size_t)idx * 8; const f32x4 a = *(const f32x4*)s, c = *(const f32x4*)(s + 4);
                u32x4 v; v.x = pk2(a[0], a[1]); v.y = pk2(a[2], a[3]); v.z = pk2(c[0], c[1]); v.w = pk2(c[2], c[3]);
                *(u32x4*)(KC + ((size_t)b * 256 + k0) * 1024 + (size_t)idx * 8) = v; }
            const int h = wave;
            const float* cv = A.in[4] + (((size_t)b * 2 + j) * 256 + k0) * 1024 + h * 128;
            vt_tile<true>(cv, 1024, VTS + (((size_t)b * 8 + h) * 128) * 2304 + 2048 + k0, 2304, scr, lane);
        }
    }
}

template <int PASS>
__device__ __forceinline__ void lru_unit(const Args& A, LAS unsigned char* lds, int j, int ci, int kblk) {
    const int tid = otid(), lane = tid & 63, wave = tid >> 6, r = lane & 15, kq = lane >> 4;
    unsigned char* ws = A.ws;
    const bf16_t* U5 = (const bf16_t*)(ws + WS_U5);
    const bf16_t* LRUW = (const bf16_t*)(ws + WS_LRUW);
    f32x2* CHS = (f32x2*)(ws + WS_CHS);
    const int t0 = ci * 128;
    const int sample = t0 >= TP, b = sample ? (t0 - TP) >> 11 : t0 >> 8, l0 = sample ? (t0 - TP) & 2047 : t0 & 255, L = sample ? 2048 : 256;
    const int cis = l0 >> 7, nch = L >> 7, cbase = ci - cis;
    LAS bf16_t* X = (LAS bf16_t*)lds;
    WG_SYNC();
    {
        const int oct = tid & 15, tb = tid >> 4, ch0 = kblk * 128 + oct * 8;
        float cw[4][8], cb[8];
#pragma unroll
        for (int tp = 0; tp < 4; ++tp) { const f32x4 a = *(const f32x4*)(A.in[11] + ((size_t)j * 4 + tp) * 1024 + ch0), c = *(const f32x4*)(A.in[11] + ((size_t)j * 4 + tp) * 1024 + ch0 + 4);
            cw[tp][0] = a[0]; cw[tp][1] = a[1]; cw[tp][2] = a[2]; cw[tp][3] = a[3]; cw[tp][4] = c[0]; cw[tp][5] = c[1]; cw[tp][6] = c[2]; cw[tp][7] = c[3]; }
        { const f32x4 a = *(const f32x4*)(A.in[12] + (size_t)j * 1024 + ch0), c = *(const f32x4*)(A.in[12] + (size_t)j * 1024 + ch0 + 4);
            cb[0] = a[0]; cb[1] = a[1]; cb[2] = a[2]; cb[3] = a[3]; cb[4] = c[0]; cb[5] = c[1]; cb[6] = c[2]; cb[7] = c[3]; }
#pragma unroll
        for (int it = 0; it < 4; ++it) {
            const int tok = tb + 32 * it, l = l0 + tok;
            float o[8];
#pragma unroll
            for (int i = 0; i < 8; ++i) o[i] = cb[i];
#pragma unroll
            for (int tp = 0; tp < 4; ++tp) { const int ll = l - 2 + tp;
                if (ll >= 0 && ll < L) { float x[8]; unpack8(*(const u32x4*)(U5 + (size_t)(t0 + tok - 2 + tp) * 5120 + 1024 + ch0), x);
#pragma unroll
                    for (int i = 0; i < 8; ++i) o[i] += x[i] * cw[tp][i]; } }
            *(LAS u32x4*)(X + tok * 136 + oct * 8) = pack8(o);
        }
    }
    WG_SYNC();
    const int chl = wave * 16 + 4 * kq, C0 = kblk * 128 + chl;
    float hsum[8][4];
#pragma unroll
    for (int nt = 0; nt < 8; ++nt)
#pragma unroll
        for (int e = 0; e < 4; ++e) hsum[nt][e] = 0.f;
#pragma unroll
    for (int d = 0; d < 2; ++d) {
        f32x4 ar[8], ai[8];
#pragma unroll
        for (int nt = 0; nt < 8; ++nt) { ar[nt] = (f32x4){0.f, 0.f, 0.f, 0.f}; ai[nt] = (f32x4){0.f, 0.f, 0.f, 0.f}; }
        const bf16_t* Wr = LRUW + ((((size_t)j * 2 + d) * 2 + 0) * 8 + kblk) * 16384 + (size_t)(wave * 16 + r) * 128 + 8 * kq;
        const bf16_t* Wi = LRUW + ((((size_t)j * 2 + d) * 2 + 1) * 8 + kblk) * 16384 + (size_t)(wave * 16 + r) * 128 + 8 * kq;
#pragma unroll
        for (int ks = 0; ks < 4; ++ks) {
            const bf16x8 fr_ = as_bf16x8(*(const u32x4*)(Wr + 32 * ks)), fi_ = as_bf16x8(*(const u32x4*)(Wi + 32 * ks));
#pragma unroll
            for (int nt = 0; nt < 8; ++nt) { const bf16x8 fb = *(const LAS bf16x8*)(X + (16 * nt + r) * 136 + 32 * ks + 8 * kq);
                ar[nt] = MFMA16(fr_, fb, ar[nt]); ai[nt] = MFMA16(fi_, fb, ai[nt]); }
        }
        float br[4], bi[4], sp[4];
        { const f32x4 v0 = *(const f32x4*)(A.in[14] + ((size_t)j * 2 + d) * 1024 + C0), v1 = *(const f32x4*)(A.in[16] + ((size_t)j * 2 + d) * 1024 + C0), v2 = *(const f32x4*)(A.in[17] + ((size_t)j * 2 + d) * 1024 + C0);
#pragma unroll
            for (int e = 0; e < 4; ++e) { br[e] = v0[e]; bi[e] = v1[e]; sp[e] = fsoftplus(-v2[e]); } }
#pragma unroll
        for (int nt = 0; nt < 8; ++nt) {
            const u32x2 xv = *(const LAS u32x2*)(X + (16 * nt + r) * 136 + chl);
            const float xc[4] = {bflo(xv.x), bfhi(xv.x), bflo(xv.y), bfhi(xv.y)};
#pragma unroll
            for (int e = 0; e < 4; ++e) {
                const float rr = fsigmoid(ar[nt][e] + br[e]), gi = fsigmoid(ai[nt][e] + bi[e]);
                const float la = -8.0f * rr * sp[e];
                const float av = fexp(la);
                const float t2 = 2.0f * la; const float om = t2 > -0.03f ? -t2 * (1.0f + t2 * (0.5f + t2 * (0.16666667f + t2 * 0.041666668f))) : 1.0f - av * av;
                const float bt = __builtin_amdgcn_sqrtf(om) * gi * xc[e];
                ar[nt][e] = av; ai[nt][e] = bt;
            }
            __builtin_amdgcn_sched_barrier(0);
        }
#pragma unroll
        for (int nt = 0; nt < 8; ++nt)
#pragma unroll
            for (int e = 0; e < 4; ++e) {
                float Av = ar[nt][e], Bv = ai[nt][e];
#pragma unroll
                for (int dl = 1; dl < 16; dl <<= 1) {
                    if (d == 0) { const float Ap = __shfl_up(Av, dl, 16), Bp = __shfl_up(Bv, dl, 16); if (r >= dl) { Bv = Av * Bp + Bv; Av = Av * Ap; } }
                    else        { const float An = __shfl_down(Av, dl, 16), Bn = __shfl_down(Bv, dl, 16); if (r + dl < 16) { Bv = Av * Bn + Bv; Av = Av * An; } }
                }
                ar[nt][e] = Av; ai[nt][e] = Bv;
                if (e & 1) __builtin_amdgcn_sched_barrier(0);
            }
        if (PASS == 1) {
#pragma unroll
            for (int e = 0; e < 4; ++e) {
                float P = 1.f, E = 0.f;
#pragma unroll
                for (int q = 0; q < 8; ++q) { const int nt = d == 0 ? q : 7 - q; const int sl = d == 0 ? 15 : 0;
                    const float At = __shfl(ar[nt][e], sl, 16), Bt = __shfl(ai[nt][e], sl, 16);
                    E = At * E + Bt; P = P * At; }
                if (r == 0) CHS[((size_t)ci * 2 + d) * 1024 + C0 + e] = (f32x2){P, E};
            }
        } else {
#pragma unroll
            for (int e = 0; e < 4; ++e) {
                float h = sample ? A.in[5][(((size_t)b * 2 + j) * 2 + d) * 1024 + C0 + e] : 0.f;
                if (d == 0) { for (int cj = 0; cj < cis; ++cj) { const f32x2 pe = CHS[((size_t)(cbase + cj) * 2 + 0) * 1024 + C0 + e]; h = pe.x * h + pe.y; } }
                else        { for (int cj = nch - 1; cj > cis; --cj) { const f32x2 pe = CHS[((size_t)(cbase + cj) * 2 + 1) * 1024 + C0 + e]; h = pe.x * h + pe.y; } }
#pragma unroll
                for (int q = 0; q < 8; ++q) { const int nt = d == 0 ? q : 7 - q; const int sl = d == 0 ? 15 : 0;
                    const float hv = ar[nt][e] * h + ai[nt][e];
                    hsum[nt][e] += hv;
                    h = __shfl(hv, sl, 16); }
                if (!sample && r == 0) {
                    if (d == 0 && cis == nch - 1) A.out[OUT_LRU + (((size_t)b * 2 + j) * 2 + 0) * 1024 + C0 + e] = h;
                    if (d == 1 && cis == 0)       A.out[OUT_LRU + (((size_t)b * 2 + j) * 2 + 1) * 1024 + C0 + e] = h;
                }
            }
        }
    }
    if (PASS == 2) {
        bf16_t* MIX = (bf16_t*)(ws + WS_MIXE);
#pragma unroll
        for (int nt = 0; nt < 8; ++nt) { const int t = t0 + 16 * nt + r;
            const u32x2 gv = *(const u32x2*)(U5 + (size_t)t * 5120 + C0);
            const float g[4] = {bflo(gv.x), bfhi(gv.x), bflo(gv.y), bfhi(gv.y)};
            u32x2 o; o.x = pk2(hsum[nt][0] * fgelu_tanh(g[0]), hsum[nt][1] * fgelu_tanh(g[1])); o.y = pk2(hsum[nt][2] * fgelu_tanh(g[2]), hsum[nt][3] * fgelu_tanh(g[3]));
            *(u32x2*)(MIX + (size_t)t * 2048 + C0) = o; }
    }
}

__device__ __forceinline__ void attn_unit(const Args& A, LAS unsigned char* lds, int j, int sample, int b, int h, int qb, float lam, float lam_init) {
    const int tid = otid(), lane = tid & 63, wave = tid >> 6, r = lane & 15, kq = lane >> 4;
    unsigned char* ws = A.ws;
    const bf16_t* Qb = (const bf16_t*)(ws + WS_Q); const bf16_t* Kb = (const bf16_t*)(ws + WS_K); const bf16_t* KC = (const bf16_t*)(ws + WS_KC);
    const int L = sample ? 2048 : 256, Lk = sample ? 2304 : 256;
    const int tbase = sample ? TP + b * 2048 : b * 256;
    const bf16_t* VT = sample ? (const bf16_t*)(ws + WS_VTS) + (((size_t)b * 8 + h) * 128) * 2304 : (const bf16_t*)(ws + WS_VTP) + (((size_t)b * 8 + h) * 128) * 256;
    const int m = wave >> 2, qs = (wave & 3) * 32, q0 = tbase + qb * 128 + qs;
    constexpr int KT_BYTES = 64 * 136 * 2, VT_BYTES = 128 * 72 * 2;
    bf16x8 qf[2][2];
#pragma unroll
    for (int qt = 0; qt < 2; ++qt)
#pragma unroll
        for (int ks = 0; ks < 2; ++ks) qf[qt][ks] = as_bf16x8(*(const u32x4*)(Qb + (size_t)(q0 + 16 * qt + r) * 1024 + h * 128 + m * 64 + 32 * ks + 8 * kq));
    f32x4 o[8][2];
#pragma unroll
    for (int dt = 0; dt < 8; ++dt) { o[dt][0] = (f32x4){0.f, 0.f, 0.f, 0.f}; o[dt][1] = (f32x4){0.f, 0.f, 0.f, 0.f}; }
    float mrun[2] = {-1e30f, -1e30f}, lrun[2] = {0.f, 0.f};
    const int nkt = Lk >> 6;
    u32x4 pk_[2], pv_[2];
#define ATT_LOAD(kt_) do { const int key0_ = (kt_) * 64; \
        _Pragma("unroll") for (int i_ = 0; i_ < 2; ++i_) { const int p_ = tid + 512 * i_; \
            { const int row_ = p_ >> 4, pc_ = p_ & 15, key_ = key0_ + row_; \
              const bf16_t* s_ = key_ < L ? Kb + (size_t)(tbase + key_) * 1024 + h * 128 + pc_ * 8 : KC + ((size_t)b * 256 + (key_ - 2048)) * 1024 + h * 128 + pc_ * 8; \
              pk_[i_] = *(const u32x4*)s_; } \
            { const int row_ = p_ >> 3, pc_ = p_ & 7; pv_[i_] = *(const u32x4*)(VT + (size_t)row_ * Lk + key0_ + pc_ * 8); } } } while (0)
#define ATT_STORE(buf_) do { LAS unsigned char* kb_ = lds + (buf_) * KT_BYTES; LAS unsigned char* vb_ = lds + 2 * KT_BYTES + (buf_) * VT_BYTES; \
        _Pragma("unroll") for (int i_ = 0; i_ < 2; ++i_) { const int p_ = tid + 512 * i_; \
            *(LAS u32x4*)(kb_ + ((p_ >> 4) * 136 + (p_ & 15) * 8) * 2) = pk_[i_]; \
            *(LAS u32x4*)(vb_ + ((p_ >> 3) * 72 + (p_ & 7) * 8) * 2) = pv_[i_]; } } while (0)
    WG_SYNC();
    ATT_LOAD(0); ATT_STORE(0);
    WG_SYNC();
    for (int kt = 0; kt < nkt; ++kt) {
        if (kt + 1 < nkt) ATT_LOAD(kt + 1);
        const LAS bf16_t* Kl = (const LAS bf16_t*)(lds + (kt & 1) * KT_BYTES);
        const LAS bf16_t* Vl = (const LAS bf16_t*)(lds + 2 * KT_BYTES + (kt & 1) * VT_BYTES);
        f32x4 s[4][2];
#pragma unroll
        for (int t = 0; t < 4; ++t) { s[t][0] = (f32x4){0.f, 0.f, 0.f, 0.f}; s[t][1] = (f32x4){0.f, 0.f, 0.f, 0.f}; }
#pragma unroll
        for (int ks = 0; ks < 2; ++ks)
#pragma unroll
            for (int t = 0; t < 4; ++t) { const bf16x8 ka = *(const LAS bf16x8*)(Kl + (16 * t + r) * 136 + m * 64 + 32 * ks + 8 * kq);
                s[t][0] = MFMA16(ka, qf[0][ks], s[t][0]); s[t][1] = MFMA16(ka, qf[1][ks], s[t][1]); }
        bf16x8 pf[2][2];
#pragma unroll
        for (int qt = 0; qt < 2; ++qt) {
            float mx = s[0][qt][0];
#pragma unroll
            for (int t = 0; t < 4; ++t)
#pragma unroll
                for (int e = 0; e < 4; ++e) mx = fmaxf(mx, s[t][qt][e]);
            mx = fmaxf(mx, __shfl_xor(mx, 16)); mx = fmaxf(mx, __shfl_xor(mx, 32));
            const float mnew = fmaxf(mrun[qt], mx), alpha = __builtin_amdgcn_exp2f(mrun[qt] - mnew);
            mrun[qt] = mnew;
            float ps = 0.f;
#pragma unroll
            for (int t = 0; t < 4; ++t)
#pragma unroll
                for (int e = 0; e < 4; ++e) { const float p = __builtin_amdgcn_exp2f(s[t][qt][e] - mnew); s[t][qt][e] = p; ps += p; }
            lrun[qt] = lrun[qt] * alpha + ps;
#pragma unroll
            for (int dt = 0; dt < 8; ++dt) o[dt][qt] = o[dt][qt] * alpha;
#pragma unroll
            for (int blk = 0; blk < 2; ++blk) { u32x4 w; w.x = pk2(s[2 * blk][qt][0], s[2 * blk][qt][1]); w.y = pk2(s[2 * blk][qt][2], s[2 * blk][qt][3]);
                w.z = pk2(s[2 * blk + 1][qt][0], s[2 * blk + 1][qt][1]); w.w = pk2(s[2 * blk + 1][qt][2], s[2 * blk + 1][qt][3]); pf[blk][qt] = as_bf16x8(w); }
        }
#pragma unroll
        for (int blk = 0; blk < 2; ++blk)
#pragma unroll
            for (int dt = 0; dt < 8; ++dt) {
                const u32x2 v0 = *(const LAS u32x2*)(Vl + (16 * dt + r) * 72 + 32 * blk + 4 * kq), v1 = *(const LAS u32x2*)(Vl + (16 * dt + r) * 72 + 32 * blk + 16 + 4 * kq);
                const bf16x8 va = as_bf16x8((u32x4){v0.x, v0.y, v1.x, v1.y});
                o[dt][0] = MFMA16(va, pf[blk][0], o[dt][0]); o[dt][1] = MFMA16(va, pf[blk][1], o[dt][1]); }
        if (kt + 1 < nkt) ATT_STORE((kt + 1) & 1);
        WG_SYNC();
    }
#undef ATT_LOAD
#undef ATT_STORE
#pragma unroll
    for (int qt = 0; qt < 2; ++qt) { float l = lrun[qt]; l += __shfl_xor(l, 16); l += __shfl_xor(l, 32); const float inv = 1.0f / l;
#pragma unroll
        for (int dt = 0; dt < 8; ++dt) o[dt][qt] = o[dt][qt] * inv; }
    LAS f32x4* ex = (LAS f32x4*)lds;
    if (m == 1) {
#pragma unroll
        for (int dt = 0; dt < 8; ++dt) { ex[((wave & 3) * 16 + dt * 2 + 0) * 64 + lane] = o[dt][0]; ex[((wave & 3) * 16 + dt * 2 + 1) * 64 + lane] = o[dt][1]; }
    }
    WG_SYNC();
    if (m == 0) {
        bf16_t* MIX = (bf16_t*)(ws + WS_MIXE);
        const float* subln = A.in[23] + (size_t)j * 128;
        float ss[2] = {0.f, 0.f};
#pragma unroll
        for (int dt = 0; dt < 8; ++dt)
#pragma unroll
            for (int qt = 0; qt < 2; ++qt) { const f32x4 o1 = ex[((wave & 3) * 16 + dt * 2 + qt) * 64 + lane]; o[dt][qt] = o[dt][qt] - o1 * lam;
                ss[qt] += (o[dt][qt][0] * o[dt][qt][0] + o[dt][qt][1] * o[dt][qt][1]) + (o[dt][qt][2] * o[dt][qt][2] + o[dt][qt][3] * o[dt][qt][3]); }
#pragma unroll
        for (int qt = 0; qt < 2; ++qt) { float v = ss[qt]; v += __shfl_xor(v, 16); v += __shfl_xor(v, 32); const float rstd = (1.0f - lam_init) / sqrtf(v * (1.f / 128.f) + EPS);
#pragma unroll
            for (int dt = 0; dt < 8; ++dt) { const f32x4 g = *(const f32x4*)(subln + 16 * dt + 4 * kq); const f32x4 v4 = o[dt][qt] * rstd * g;
                u32x2 w; w.x = pk2(v4[0], v4[1]); w.y = pk2(v4[2], v4[3]);
                *(u32x2*)(MIX + (size_t)(q0 + 16 * qt + r) * 2048 + 1024 + h * 128 + 16 * dt + 4 * kq) = w; } }
    }
}

__device__ __forceinline__ void phase_even_mix1(const Args& A, LAS unsigned char* lds, int j) {
    if (DBG_SUB & 1) phase_qkv_prep(A, lds, j);
    if (DBG_SUB & 2) for (int u = blockIdx.x; u < 1280; u += gridDim.x) lru_unit<1>(A, lds, j, u >> 3, u & 7);
}
__device__ __forceinline__ void phase_even_mix2(const Args& A, LAS unsigned char* lds, int j, int layer) {
    float lam;
    { const float* dl = A.in[22] + (size_t)j * 256; float s0 = 0.f, s1 = 0.f;
      for (int i = 0; i < 64; ++i) { s0 += dl[i] * dl[64 + i]; s1 += dl[128 + i] * dl[192 + i]; }
      const float lam_init = 0.8f - 0.6f * expf(-0.3f * (float)layer); lam = expf(s0) - expf(s1) + lam_init;
      if (DBG_SUB & 1) for (int u = blockIdx.x; u < 1024 + 256; u += gridDim.x) {
          if (u < 1024) attn_unit(A, lds, j, 1, u >> 7, (u >> 4) & 7, u & 15, lam, lam_init);
          else { const int v = u - 1024; attn_unit(A, lds, j, 0, v >> 4, (v >> 1) & 7, v & 1, lam, lam_init); }
      }
    }
    if (DBG_SUB & 2) for (int u = blockIdx.x; u < 1280; u += gridDim.x) lru_unit<2>(A, lds, j, u >> 3, u & 7);
}

__device__ __forceinline__ void phase_ssd_prep(const Args& A, LAS unsigned char* lds, int j) {
    const int tid = otid(), wave = tid >> 6;
    unsigned char* ws = A.ws;
    const bf16_t* XBC = (const bf16_t*)(ws + WS_XBC);
    bf16_t* XT = (bf16_t*)(ws + WS_XT); bf16_t* BN = (bf16_t*)(ws + WS_BN); bf16_t* BT = (bf16_t*)(ws + WS_BT); bf16_t* CN = (bf16_t*)(ws + WS_CN);
    LAS bf16_t* Tl = (LAS bf16_t*)lds;
    for (int u = blockIdx.x; u < 320 * 12; u += gridDim.x) {
        const int slab = u / 12, cb = u - slab * 12, t0 = slab * 64;
        const int sample = t0 >= TP, l0 = sample ? (t0 - TP) & 2047 : t0 & 255, L = sample ? 2048 : 256;
        const int co = tid & 63, ch = cb * 512 + co * 8;
        float cw[4][8], cbias[8];
#pragma unroll
        for (int tp = 0; tp < 4; ++tp) { const f32x4 a = *(const f32x4*)(A.in[25] + ((size_t)j * 4 + tp) * 6144 + ch), c = *(const f32x4*)(A.in[25] + ((size_t)j * 4 + tp) * 6144 + ch + 4);
            cw[tp][0] = a[0]; cw[tp][1] = a[1]; cw[tp][2] = a[2]; cw[tp][3] = a[3]; cw[tp][4] = c[0]; cw[tp][5] = c[1]; cw[tp][6] = c[2]; cw[tp][7] = c[3]; }
        { const f32x4 a = *(const f32x4*)(A.in[26] + (size_t)j * 6144 + ch), c = *(const f32x4*)(A.in[26] + (size_t)j * 6144 + ch + 4);
            cbias[0] = a[0]; cbias[1] = a[1]; cbias[2] = a[2]; cbias[3] = a[3]; cbias[4] = c[0]; cbias[5] = c[1]; cbias[6] = c[2]; cbias[7] = c[3]; }
        WG_SYNC();
#pragma unroll
        for (int it = 0; it < 4; ++it) {
            const int tp0 = 2 * (wave + 8 * it);
            float xr[5][8];
#pragma unroll
            for (int rr = 0; rr < 5; ++rr) { const int ll = l0 + tp0 - 2 + rr;
                if (ll >= 0 && ll < L) unpack8(*(const u32x4*)(XBC + (size_t)(t0 + tp0 - 2 + rr) * 6144 + ch), xr[rr]);
                else {
#pragma unroll
                    for (int i = 0; i < 8; ++i) xr[rr][i] = 0.f; } }
#pragma unroll
            for (int tk = 0; tk < 2; ++tk) {
                float o[8];
#pragma unroll
                for (int i = 0; i < 8; ++i) { float v = cbias[i];
#pragma unroll
                    for (int tp = 0; tp < 4; ++tp) v += xr[tk + tp][i] * cw[tp][i];
                    o[i] = fsilu(v); }
                const u32x4 pk = pack8(o);
                const int tok = tp0 + tk;
                if (cb >= 8) { bf16_t* dst = (cb < 10 ? BN + (size_t)(t0 + tok) * 1024 + (cb - 8) * 512 : CN + (size_t)(t0 + tok) * 1024 + (cb - 10) * 512) + co * 8; *(u32x4*)dst = pk; }
                if (cb < 10) *(LAS u32x4*)(Tl + tok * 520 + co * 8) = pk;
            }
        }
        if (cb < 10) {
            WG_SYNC();
            const int tile = t0 >> 8, so = t0 & 255;
#pragma unroll
            for (int i = 0; i < 8; ++i) { const int p = tid + 512 * i, c = p & 511, tg = p >> 9;
                unsigned short e[8];
#pragma unroll
                for (int k = 0; k < 8; ++k) e[k] = Tl[(8 * tg + k) * 520 + c];
                u32x4 v; v.x = e[0] | ((unsigned)e[1] << 16); v.y = e[2] | ((unsigned)e[3] << 16); v.z = e[4] | ((unsigned)e[5] << 16); v.w = e[6] | ((unsigned)e[7] << 16);
                bf16_t* dst;
                if (cb < 8) { const int cg = cb * 512 + c; dst = XT + (((size_t)tile * 64 + (cg >> 6)) * 64 + (cg & 63)) * 256 + so + 8 * tg; }
                else { const int cg = (cb - 8) * 512 + c; dst = BT + (((size_t)tile * 8 + (cg >> 7)) * 128 + (cg & 127)) * 256 + so + 8 * tg; }
                *(u32x4*)dst = v; }
        }
    }
}

template <int NV>
__device__ __forceinline__ void scan256(float (&v)[NV], LAS float* wtot, int lane, int wave_in_grp, float (&tot)[NV]) {
#pragma unroll
    for (int dl = 1; dl < 64; dl <<= 1) {
#pragma unroll
        for (int k = 0; k < NV; ++k) { const float up = __shfl_up(v[k], dl, 64); if (lane >= dl) v[k] += up; }
    }
    if (lane == 63) {
#pragma unroll
        for (int k = 0; k < NV; ++k) wtot[wave_in_grp * NV + k] = v[k];
    }
    WG_SYNC();
#pragma unroll
    for (int k = 0; k < NV; ++k) { float pre = 0.f, all = 0.f;
#pragma unroll
        for (int w = 0; w < 4; ++w) { const float x = wtot[w * NV + k]; all += x; if (w < wave_in_grp) pre += x; }
        v[k] += pre; tot[k] = all; }
}

__device__ __forceinline__ void phase_ssd_state(const Args& A, LAS unsigned char* lds, int j) {
    const int tid = otid(), lane = tid & 63, wave = tid >> 6, r = lane & 15, kq = lane >> 4;
    unsigned char* ws = A.ws;
    const bf16_t* XT = (const bf16_t*)(ws + WS_XT); const bf16_t* BT = (const bf16_t*)(ws + WS_BT);
    const float* DTRAW = (const float*)(ws + WS_DTRAW);
    bf16_t* SIN = (bf16_t*)(ws + WS_SIN);
    LAS bf16_t* Bl = (LAS bf16_t*)lds;
    LAS bf16_t* Xl = (LAS bf16_t*)(lds + 67584);
    LAS float* Wl = (LAS float*)(lds + 67584 + 33792);
    LAS float* TOT = Wl + 1024;
    LAS float* WT_ = TOT + 16;
    const int pt = wave & 3, nh = wave >> 2;
    for (int u = blockIdx.x; u < 256 + 512; u += gridDim.x) {
        const int sample = u < 256, v = sample ? u : u - 256;
        const int b = v >> 5, g = (v >> 2) & 7, dir = (v >> 1) & 1, half = v & 1;
        const int tile0 = sample ? 16 + b * 8 : b, ntile = sample ? 8 : 1;
        const int h0 = g * 8 + half * 4;
        f32x4 acc[4][4];
#pragma unroll
        for (int hh = 0; hh < 4; ++hh)
#pragma unroll
            for (int nt = 0; nt < 4; ++nt) {
                if (sample) {
#pragma unroll
                    for (int e = 0; e < 4; ++e) acc[hh][nt][e] = A.in[6][((((size_t)b * 2 + j) * 2 + dir) * 64 + h0 + hh) * 8192 + (size_t)(16 * pt + 4 * kq + e) * 128 + 16 * (nh * 4 + nt) + r];
                } else acc[hh][nt] = (f32x4){0.f, 0.f, 0.f, 0.f};
            }
        float adec[4], dtb[4];
#pragma unroll
        for (int hh = 0; hh < 4; ++hh) { adec[hh] = -expf(A.in[28][((size_t)j * 2 + dir) * 64 + h0 + hh]); dtb[hh] = A.in[27][((size_t)j * 2 + dir) * 64 + h0 + hh]; }
        for (int st = 0; st < ntile; ++st) {
            const int c = dir == 0 ? st : ntile - 1 - st, tile = tile0 + c;
            if (sample) {
#pragma unroll
                for (int hh = 0; hh < 4; ++hh)
#pragma unroll
                    for (int nt = 0; nt < 4; ++nt)
#pragma unroll
                        for (int e = 0; e < 4; ++e)
                            SIN[((((size_t)(tile - 16) * 2 + dir) * 64 + h0 + hh) * 64 + 16 * pt + 4 * kq + e) * 128 + 16 * (nh * 4 + nt) + r] = (bf16_t)(pk2(acc[hh][nt][e], 0.f) & 0xffffu);
                if (st == ntile - 1) break;
            }
            WG_SYNC();
            {
                float val[4], dtv[4], tot[4];
                if (tid < 256) {
#pragma unroll
                    for (int hh = 0; hh < 4; ++hh) { dtv[hh] = fsoftplus(DTRAW[(size_t)(tile * 256 + tid) * 128 + dir * 64 + h0 + hh] + dtb[hh]); val[hh] = adec[hh] * dtv[hh]; }
                } else {
#pragma unroll
                    for (int hh = 0; hh < 4; ++hh) { dtv[hh] = 0.f; val[hh] = 0.f; }
                }
                float adt[4];
#pragma unroll
                for (int hh = 0; hh < 4; ++hh) adt[hh] = val[hh];
                scan256<4>(val, WT_ + (tid < 256 ? 0 : 16), lane, wave & 3, tot);
                if (tid < 256) {
#pragma unroll
                    for (int hh = 0; hh < 4; ++hh) { const float w = dir == 0 ? fexp(tot[hh] - val[hh]) * dtv[hh] : fexp(val[hh] - adt[hh]) * dtv[hh]; Wl[hh * 256 + tid] = w; }
                    if (tid == 0) {
#pragma unroll
                        for (int hh = 0; hh < 4; ++hh) TOT[hh] = tot[hh];
                    }
                }
            }
#pragma unroll
            for (int i = 0; i < 8; ++i) { const int p = tid + 512 * i, row = p >> 5, pc = p & 31;
                *(LAS u32x4*)(Bl + row * 264 + pc * 8) = *(const u32x4*)(BT + (((size_t)tile * 8 + g) * 128 + row) * 256 + pc * 8); }
#pragma unroll
            for (int hh = 0; hh < 4; ++hh) {
                WG_SYNC();
#pragma unroll
                for (int i = 0; i < 4; ++i) { const int p = tid + 512 * i, row = p >> 5, pc = p & 31;
                    float x[8]; unpack8(*(const u32x4*)(XT + (((size_t)tile * 64 + h0 + hh) * 64 + row) * 256 + pc * 8), x);
                    const f32x4 w0 = *(const LAS f32x4*)(Wl + hh * 256 + pc * 8), w1 = *(const LAS f32x4*)(Wl + hh * 256 + pc * 8 + 4);
                    x[0] *= w0[0]; x[1] *= w0[1]; x[2] *= w0[2]; x[3] *= w0[3]; x[4] *= w1[0]; x[5] *= w1[1]; x[6] *= w1[2]; x[7] *= w1[3];
                    *(LAS u32x4*)(Xl + row * 264 + pc * 8) = pack8(x); }
                WG_SYNC();
                const float dec = fexp(TOT[hh]);
#pragma unroll
                for (int nt = 0; nt < 4; ++nt) acc[hh][nt] = acc[hh][nt] * dec;
#pragma unroll
                for (int ks = 0; ks < 8; ++ks) { const bf16x8 fa = *(const LAS bf16x8*)(Xl + (16 * pt + r) * 264 + 32 * ks + 8 * kq);
#pragma unroll
                    for (int nt = 0; nt < 4; ++nt) { const bf16x8 fb = *(const LAS bf16x8*)(Bl + (16 * (nh * 4 + nt) + r) * 264 + 32 * ks + 8 * kq);
                        acc[hh][nt] = MFMA16(fa, fb, acc[hh][nt]); } }
            }
        }
        if (!sample) {
#pragma unroll
            for (int hh = 0; hh < 4; ++hh)
#pragma unroll
                for (int nt = 0; nt < 4; ++nt)
#pragma unroll
                    for (int e = 0; e < 4; ++e)
                        A.out[OUT_SSD + ((((size_t)b * 2 + j) * 2 + dir) * 64 + h0 + hh) * 8192 + (size_t)(16 * pt + 4 * kq + e) * 128 + 16 * (nh * 4 + nt) + r] = acc[hh][nt][e];
        }
    }
}

__device__ __forceinline__ void phase_ssd_out(const Args& A, LAS unsigned char* lds, int j) {
    const int tid = otid(), lane = tid & 63, wave = tid >> 6, r = lane & 15, kq = lane >> 4;
    unsigned char* ws = A.ws;
    const bf16_t* XT = (const bf16_t*)(ws + WS_XT); const bf16_t* BN = (const bf16_t*)(ws + WS_BN); const bf16_t* CN = (const bf16_t*)(ws + WS_CN);
    const bf16_t* Z = (const bf16_t*)(ws + WS_Z); const float* DTRAW = (const float*)(ws + WS_DTRAW); const bf16_t* SIN = (const bf16_t*)(ws + WS_SIN);
    bf16_t* MIX = (bf16_t*)(ws + WS_MIXO);
    LAS float* PF = (LAS float*)lds;
    LAS float* DTF = PF + 2048;
    LAS float* EB = DTF + 2048;
    LAS float* DTB = EB + 2048;
    LAS float* TOTB = (LAS float*)(lds + LDS_MISC + 256);
    LAS float* WT_ = (LAS float*)(lds + LDS_MISC + 320);
    LAS bf16_t* Bl = (LAS bf16_t*)(lds + 32768);
    LAS bf16_t* Xl = (LAS bf16_t*)(lds + 32768);
    LAS bf16_t* Sl = (LAS bf16_t*)(lds + 32768 + 33792);
    for (int u = blockIdx.x; u < 160 * 8; u += gridDim.x) {
        const int rt = u >> 3, g = u & 7, tile = rt >> 1, half = rt & 1;
        const int sample = tile >= 16;
        const int l_loc = half * 128 + wave * 16 + r;
        const size_t tk = (size_t)tile * 256 + l_loc;
        WG_SYNC();
        {
            const int dir = tid >> 8, s = tid & 255;
            float val[8], dtv[8], tot[8], adt[8];
#pragma unroll
            for (int h8 = 0; h8 < 8; ++h8) { const int h = g * 8 + h8;
                dtv[h8] = fsoftplus(DTRAW[((size_t)tile * 256 + s) * 128 + dir * 64 + h] + A.in[27][((size_t)j * 2 + dir) * 64 + h]);
                val[h8] = -expf(A.in[28][((size_t)j * 2 + dir) * 64 + h]) * dtv[h8]; adt[h8] = val[h8]; }
            scan256<8>(val, WT_ + dir * 32, lane, wave & 3, tot);
            if (dir == 0) {
#pragma unroll
                for (int h8 = 0; h8 < 8; ++h8) { PF[h8 * 256 + s] = val[h8]; DTF[h8 * 256 + s] = dtv[h8]; }
            } else {
#pragma unroll
                for (int h8 = 0; h8 < 8; ++h8) { EB[h8 * 256 + s] = val[h8] - adt[h8]; DTB[h8 * 256 + s] = dtv[h8]; }
                if (s == 0) {
#pragma unroll
                    for (int h8 = 0; h8 < 8; ++h8) TOTB[h8] = tot[h8];
                }
            }
        }
#pragma unroll
        for (int i = 0; i < 8; ++i) { const int p = tid + 512 * i, row = p >> 4, pc = p & 15;
            *(LAS u32x4*)(Bl + row * 136 + pc * 8) = *(const u32x4*)(BN + ((size_t)tile * 256 + row) * 1024 + g * 128 + pc * 8); }
        bf16x8 cf[4];
#pragma unroll
        for (int ks = 0; ks < 4; ++ks) cf[ks] = as_bf16x8(*(const u32x4*)(CN + tk * 1024 + g * 128 + 32 * ks + 8 * kq));
        WG_SYNC();
        f32x4 gt[16];
#pragma unroll
        for (int t = 0; t < 16; ++t) gt[t] = (f32x4){0.f, 0.f, 0.f, 0.f};
#pragma unroll
        for (int ks = 0; ks < 4; ++ks)
#pragma unroll
            for (int t = 0; t < 16; ++t) { const bf16x8 fa = *(const LAS bf16x8*)(Bl + (16 * t + r) * 136 + 32 * ks + 8 * kq); gt[t] = MFMA16(fa, cf[ks], gt[t]); }
        float ssq = 0.f;
        const int tdiag = half * 8 + wave;
#pragma unroll 1
        for (int h8 = 0; h8 < 8; ++h8) {
            const int h = g * 8 + h8;
            const int tid = otid(), lane = tid & 63, wave = __builtin_amdgcn_readfirstlane(tid >> 6), r = lane & 15, kq = lane >> 4;
            const int l_loc = half * 128 + wave * 16 + r; const size_t tk = (size_t)tile * 256 + l_loc; const int tdiag = half * 8 + wave;
            WG_SYNC();
#pragma unroll
            for (int i = 0; i < 4; ++i) { const int p = tid + 512 * i, row = p >> 5, pc = p & 31;
                *(LAS u32x4*)(Xl + row * 264 + pc * 8) = *(const u32x4*)(XT + (((size_t)tile * 64 + h) * 64 + row) * 256 + pc * 8); }
            if (sample) {
#pragma unroll
                for (int i = 0; i < 4; ++i) { const int p = tid + 512 * i, dirn = p >> 10, row = (p >> 4) & 63, pc = p & 15;
                    *(LAS u32x4*)(Sl + (dirn * 64 + row) * 136 + pc * 8) = *(const u32x4*)(SIN + ((((size_t)(tile - 16) * 2 + dirn) * 64 + h) * 64 + row) * 128 + pc * 8); }
            }
            WG_SYNC();
            const float pf_l = PF[h8 * 256 + l_loc], eb_l = EB[h8 * 256 + l_loc];
            f32x4 y[4];
#pragma unroll
            for (int p4 = 0; p4 < 4; ++p4) y[p4] = (f32x4){0.f, 0.f, 0.f, 0.f};
#pragma unroll
            for (int blk = 0; blk < 8; ++blk) {
                float mv[8];
#pragma unroll
                for (int hf = 0; hf < 2; ++hf) {
                    const int t = 2 * blk + hf, sb = 16 * t + 4 * kq;
                    if (t < tdiag) {
                        const f32x4 ps = *(const LAS f32x4*)(PF + h8 * 256 + sb), ds = *(const LAS f32x4*)(DTF + h8 * 256 + sb);
#pragma unroll
                        for (int e = 0; e < 4; ++e) mv[hf * 4 + e] = gt[t][e] * fexp(pf_l - ps[e]) * ds[e];
                    } else if (t > tdiag) {
                        const f32x4 es = *(const LAS f32x4*)(EB + h8 * 256 + sb), ds = *(const LAS f32x4*)(DTB + h8 * 256 + sb);
#pragma unroll
                        for (int e = 0; e < 4; ++e) mv[hf * 4 + e] = gt[t][e] * fexp(es[e] - eb_l) * ds[e];
                    } else {
                        const f32x4 ps = *(const LAS f32x4*)(PF + h8 * 256 + sb), df = *(const LAS f32x4*)(DTF + h8 * 256 + sb);
                        const f32x4 es = *(const LAS f32x4*)(EB + h8 * 256 + sb), db = *(const LAS f32x4*)(DTB + h8 * 256 + sb);
#pragma unroll
                        for (int e = 0; e < 4; ++e) { const int s = sb + e; float w = 0.f;
                            if (s <= l_loc) w += fexp(fminf(pf_l - ps[e], 0.f)) * df[e];
                            if (s >= l_loc) w += fexp(fminf(es[e] - eb_l, 0.f)) * db[e];
                            mv[hf * 4 + e] = gt[t][e] * w; }
                    }
                }
                const bf16x8 mf = as_bf16x8(pack8(mv));
#pragma unroll
                for (int p4 = 0; p4 < 4; ++p4) {
                    const u32x2 v0 = *(const LAS u32x2*)(Xl + (16 * p4 + r) * 264 + 32 * blk + 4 * kq), v1 = *(const LAS u32x2*)(Xl + (16 * p4 + r) * 264 + 32 * blk + 16 + 4 * kq);
                    y[p4] = MFMA16(as_bf16x8((u32x4){v0.x, v0.y, v1.x, v1.y}), mf, y[p4]); }
                __builtin_amdgcn_sched_barrier(0);
            }
            if (sample) {
#pragma unroll
                for (int dirn = 0; dirn < 2; ++dirn) {
                    f32x4 tmp[4];
#pragma unroll
                    for (int p4 = 0; p4 < 4; ++p4) tmp[p4] = (f32x4){0.f, 0.f, 0.f, 0.f};
#pragma unroll
                    for (int ks = 0; ks < 4; ++ks)
#pragma unroll
                        for (int p4 = 0; p4 < 4; ++p4) { const bf16x8 sa = *(const LAS bf16x8*)(Sl + (dirn * 64 + 16 * p4 + r) * 136 + 32 * ks + 8 * kq); tmp[p4] = MFMA16(sa, cf[ks], tmp[p4]); }
                    const float ev = dirn == 0 ? fexp(pf_l) : fexp(TOTB[h8] - eb_l);
#pragma unroll
                    for (int p4 = 0; p4 < 4; ++p4) y[p4] = y[p4] + tmp[p4] * ev;
                }
            }
            const float dsk = A.in[29][(size_t)j * 64 + h];
#pragma unroll
            for (int p4 = 0; p4 < 4; ++p4) { const int p0 = 16 * p4 + 4 * kq;
                const u32x2 zv = *(const u32x2*)(Z + tk * 4096 + h * 64 + p0);
                const float zz[4] = {bflo(zv.x), bfhi(zv.x), bflo(zv.y), bfhi(zv.y)};
                float yv[4];
#pragma unroll
                for (int e = 0; e < 4; ++e) { const float xs = bf2f(Xl[(p0 + e) * 264 + l_loc]); yv[e] = (y[p4][e] + dsk * xs) * fsilu(zz[e]); ssq += yv[e] * yv[e]; }
                u32x2 w; w.x = pk2(yv[0], yv[1]); w.y = pk2(yv[2], yv[3]);
                *(u32x2*)(MIX + tk * 4096 + h * 64 + p0) = w; }
        }
        ssq += __shfl_xor(ssq, 16); ssq += __shfl_xor(ssq, 32);
        const float rstd = 1.0f / sqrtf(ssq * (1.f / 512.f) + EPS);
        asm volatile("s_waitcnt vmcnt(0)" ::: "memory");
#pragma unroll 1
        for (int h8 = 0; h8 < 8; ++h8)
#pragma unroll
            for (int p4 = 0; p4 < 4; ++p4) { const int tid2 = otid(), kq2 = (tid2 & 63) >> 4; const size_t tk2 = (size_t)tile * 256 + half * 128 + (tid2 >> 6) * 16 + (tid2 & 15);
                const int cix = (g * 8 + h8) * 64 + 16 * p4 + 4 * kq2;
                unsigned long long* ptr = (unsigned long long*)(MIX + tk2 * 4096 + cix);
                const unsigned long long raw = __hip_atomic_load(ptr, __ATOMIC_RELAXED, __HIP_MEMORY_SCOPE_AGENT);
                const unsigned lo = (unsigned)raw, hi = (unsigned)(raw >> 32);
                const f32x4 nw = *(const f32x4*)(A.in[30] + (size_t)j * 4096 + cix);
                u32x2 w; w.x = pk2(bflo(lo) * rstd * nw[0], bfhi(lo) * rstd * nw[1]); w.y = pk2(bflo(hi) * rstd * nw[2], bfhi(hi) * rstd * nw[3]);
                *(u32x2*)ptr = w; }
    }
}

constexpr int N_PHASE_IDS = 2 + 9 * 4;
#ifndef DBG_MASK
#define DBG_MASK 0xFFFF
#endif
#ifndef MK_ONE_LAUNCH
#define MK_ONE_LAUNCH 1
#endif

__global__ void __launch_bounds__(512, 2) fwd_kernel(Args args) {
    extern __shared__ __attribute__((aligned(16))) unsigned char shm[];
    LAS unsigned char* lds = (LAS unsigned char*)shm;
    const int tid = threadIdx.x;
    unsigned char* ws = args.ws;
    if (tid < 4) ((LAS unsigned*)(lds + LDS_MISC))[tid] = 0u;
    __syncthreads();
    XcdBarrier bar = xcd_barrier_post((unsigned*)(ws + WS_CTL), (volatile LAS unsigned*)(lds + LDS_MISC));
    const int lo = args.ph_lo, hi = args.ph_hi;
    bool need_bar = false;
#define PHASE(id) if (lo <= (id) && (id) < hi && ((need_bar ? (xcd_barrier(bar), 0) : 0), need_bar = true, true))
    const float* ADA = (const float*)(ws + WS_ADA);
    bf16_t* H = (bf16_t*)(ws + WS_H);
    const int G = (int)gridDim.x, bx = (int)blockIdx.x;

    PHASE(0) { if (DBG_MASK & 1) phase_prologue(args, lds); }
    PHASE(1) { if (DBG_MASK & 2) phase_modulate(args, 0, 0); }
    for (int layer = 0; layer < 4; ++layer) {
        const int pb = 2 + 9 * layer, j = layer >> 1, even = (layer & 1) == 0;
        if (even) {
            PHASE(pb + 0) if (DBG_MASK & 4) { pg8::Gemm g{H, (const bf16_t*)(ws + WS_WEIN) + (size_t)j * 5120 * 2048, T, 5120, 2048}; pg8::StaticOrder S; S.init(T, 5120, G, bx);
                pg8::EpiStore E{(bf16_t*)(ws + WS_U5), 5120};
                pg8::gemm_phase<pg8::EpiStore, pg8::StaticOrder, true, true>(lds, g, S, E); }
            PHASE(pb + 1) { if (DBG_MASK & 8) phase_even_mix1(args, lds, j); }
            PHASE(pb + 2) { if (DBG_MASK & 16) phase_even_mix2(args, lds, j, layer); }
        } else {
            PHASE(pb + 0) if (DBG_MASK & 32) { pg8::Gemm g{H, (const bf16_t*)(ws + WS_WSIN) + (size_t)j * 10496 * 2048, T, 10496, 2048}; pg8::StaticOrder S; S.init(T, 10496, G, bx);
                pg8::EpiOdd1 E{(bf16_t*)(ws + WS_Z), (bf16_t*)(ws + WS_XBC), (float*)(ws + WS_DTRAW)};
                pg8::gemm_phase<pg8::EpiOdd1, pg8::StaticOrder, true, true>(lds, g, S, E); }
            PHASE(pb + 1) { if (DBG_MASK & 64) phase_ssd_prep(args, lds, j); }
            PHASE(pb + 2) { if (DBG_MASK & 128) phase_ssd_state(args, lds, j); }
            PHASE(pb + 3) { if (DBG_MASK & 256) phase_ssd_out(args, lds, j); }
        }
        PHASE(pb + 4) if (DBG_MASK & 512) {
            const bf16_t* Am = even ? (const bf16_t*)(ws + WS_MIXE) : (const bf16_t*)(ws + WS_MIXO);
            const bf16_t* Bm = even ? (const bf16_t*)(ws + WS_WEOUT) + (size_t)j * 2048 * 2048 : (const bf16_t*)(ws + WS_WSOUT) + (size_t)j * 2048 * 4096;
            pg8::Gemm g{Am, Bm, T, 2048, even ? 2048 : 4096}; pg8::StaticOrder S; S.init(T, 2048, G, bx);
            pg8::EpiResid E{args.out, ADA + (size_t)layer * 9 * 12288 + 2 * 2048};
            pg8::gemm_phase<pg8::EpiResid, pg8::StaticOrder, true, true>(lds, g, S, E); }
        PHASE(pb + 5) { if (DBG_MASK & 2) phase_modulate(args, layer, 1); }
        PHASE(pb + 6) if (DBG_MASK & 1024) { pg8::Gemm g{H, (const bf16_t*)(ws + WS_WFIN) + (size_t)layer * 11264 * 2048, T, 11264, 2048}; pg8::StaticOrder S; S.init(T, 11264, G, bx);
            pg8::EpiSwiGLU E{(bf16_t*)(ws + WS_HID), 5632};
            pg8::gemm_phase<pg8::EpiSwiGLU, pg8::StaticOrder, true, true>(lds, g, S, E); }
        PHASE(pb + 7) if (DBG_MASK & 2048) { pg8::Gemm g{(const bf16_t*)(ws + WS_HID), (const bf16_t*)(ws + WS_WFOUT) + (size_t)layer * 2048 * 5632, T, 2048, 5632}; pg8::StaticOrder S; S.init(T, 2048, G, bx);
            pg8::EpiResid E{args.out, ADA + (size_t)layer * 9 * 12288 + 5 * 2048};
            pg8::gemm_phase<pg8::EpiResid, pg8::StaticOrder, true, true>(lds, g, S, E); }
        if (layer < 3) { PHASE(pb + 8) { if (DBG_MASK & 2) phase_modulate(args, layer + 1, 0); } }
    }
#undef PHASE
}

extern "C" void kernel_launch(void* const* d_in, const int* in_sizes, int n_in, void* d_out, int out_size, void* d_ws, size_t ws_size, hipStream_t stream) {
    static int grid = 0;
    if (grid == 0) {
        if (n_in != 34 || out_size != 92340224 || ws_size < WS_END) { fprintf(stderr, "kernel_launch: unexpected shapes (n_in %d, out %d, ws %zu); nothing launched\n", n_in, out_size, ws_size); grid = -1; return; }
        int dev = 0, cus = 0, per_cu = 0;
        if (hipGetDevice(&dev) != hipSuccess || hipDeviceGetAttribute(&cus, hipDeviceAttributeMultiprocessorCount, dev) != hipSuccess) { grid = -1; return; }
        if (hipFuncSetAttribute((const void*)fwd_kernel, hipFuncAttributeMaxDynamicSharedMemorySize, LDS_BYTES) != hipSuccess) { fprintf(stderr, "kernel_launch: hipFuncSetAttribute failed\n"); grid = -1; return; }
        if (hipOccupancyMaxActiveBlocksPerMultiprocessor(&per_cu, (const void*)fwd_kernel, 512, LDS_BYTES) != hipSuccess || per_cu < 1)
            fprintf(stderr, "kernel_launch: occupancy query reports %d workgroups per CU\n", per_cu);
        (void)hipGetLastError();
        grid = cus;
    }
    if (grid < 0) return;
    (void)hipMemsetAsync(d_ws, 0, WS_ZERO_BYTES, stream);
    (void)hipMemcpyAsync(d_out, d_in[0], (size_t)8388608 * 4, hipMemcpyDeviceToDevice, stream);
    (void)hipMemcpyAsync((float*)d_out + 8388608, d_in[1], (size_t)33554432 * 4, hipMemcpyDeviceToDevice, stream);
    Args a{};
    for (int i = 0; i < 34; ++i) a.in[i] = (const float*)d_in[i];
    a.out = (float*)d_out; a.ws = (unsigned char*)d_ws;
#if MK_ONE_LAUNCH
    a.ph_lo = 0; a.ph_hi = N_PHASE_IDS;
    hipLaunchKernelGGL(fwd_kernel, dim3(grid), dim3(512), LDS_BYTES, stream, a);
#else
    for (int p = 0; p < N_PHASE_IDS; ++p) {
        if (p >= 2) { const int L = (p - 2) / 9, k = (p - 2) % 9; const bool even = (L & 1) == 0; if ((even && k == 3) || (L == 3 && k == 8)) continue; }
        a.ph_lo = p; a.ph_hi = p + 1;
        hipLaunchKernelGGL(fwd_kernel, dim3(grid), dim3(512), LDS_BYTES, stream, a);
    }
#endif
}
```

```cpp
#include <hip/hip_runtime.h>
#include <cstdio>
#include <cstdint>
namespace pg8 {
#define PG8_LAS __attribute__((address_space(3)))
typedef unsigned short bf16_t;
typedef short bf16x8 __attribute__((ext_vector_type(8)));
typedef float f32x4 __attribute__((ext_vector_type(4)));
typedef unsigned u32x4 __attribute__((ext_vector_type(4)));
constexpr int BM = 256, BK = 64, HALF = 128, HTB = HALF * BK * 2  , STAGE_BYTES = 8 * HTB, NXCD = 8, WGM = 8;

__host__ __device__ __forceinline__ int lds_byte(int r, int c) { const int st = (r >> 4) * 2 + (c >> 5), rr = r & 15, cc = c & 31, ob = rr * 64 + cc * 2; return st * 1024 + (ob ^ (((ob >> 9) & 1) << 5)); }
__host__ __device__ __forceinline__ void stage_rc(int b, int& R, int& C) { const int st = b / 1024, sb = b % 1024, swz = sb ^ (((sb >> 9) & 1) << 5); R = (st >> 1) * 16 + swz / 64; C = (st & 1) * 32 + (swz % 64) / 2; }
__host__ __device__ __forceinline__ int perm32(int rho) { const int n = rho >> 4, i = rho & 15; return 8 * (i >> 2) + 4 * n + (i & 3); }

struct Unit { int pm, pn; };
struct Gemm { const bf16_t* A; const bf16_t* Bt; int M, N, K; };

struct StaticOrder {
    int nM, nN, nwg, G, c;
    __host__ __device__ void init(int M, int N, int G_, int c_) { nM = M / BM; nN = N / BM; nwg = nM * nN; G = G_; c = c_; }
    __host__ __device__ bool next(int i, Unit& u) const {
        const long L = (long)i * G + c; if (L >= nwg) return false;
        int wgid = (int)L; { const int q = nwg / NXCD, r = nwg % NXCD, xcd = wgid % NXCD, off = wgid / NXCD; wgid = (xcd < r ? xcd * (q + 1) : r * (q + 1) + (xcd - r) * q) + off; }
        const int nig = WGM * nN, gid = wgid / nig, fm = gid * WGM, gsz = (nM - fm) < WGM ? (nM - fm) : WGM;
        u.pm = fm + ((wgid % nig) % gsz); u.pn = (wgid % nig) / gsz; return true;
    }
    __device__ __forceinline__ void a_ready(const Unit&) const {}
    __device__ __forceinline__ void done(const Unit&) const {}
};

__device__ __forceinline__ unsigned cvt_pk_bf16(float lo, float hi) { unsigned r; asm volatile("v_cvt_pk_bf16_f32 %0, %1, %2" : "=v"(r) : "v"(lo), "v"(hi)); return r; }
__device__ __forceinline__ float fast_sigmoid(float x) { return __builtin_amdgcn_rcpf(1.0f + __builtin_amdgcn_exp2f(-1.4426950408889634f * x)); }

struct EpiStore {
    static constexpr bool PERM = true, AFTER_DRAIN = false;
    bf16_t* O; int ldc;
    __device__ __forceinline__ void operator()(const f32x4 (&acc)[2][2][4][2], const Unit& u, int wr, int wc, int fr, int fq) const {
        const int row0 = u.pm * BM + wr * 64 + fr, col0 = u.pn * BM + wc * 32 + 8 * fq;
#pragma unroll
        for (int ai = 0; ai < 2; ++ai)
#pragma unroll
            for (int m = 0; m < 4; ++m) { bf16_t* rowp = O + (size_t)(row0 + ai * HALF + m * 16) * ldc + col0;
#pragma unroll
                for (int bj = 0; bj < 2; ++bj) { const f32x4 v0 = acc[ai][bj][m][0], v1 = acc[ai][bj][m][1];
                    u32x4 w; w.x = cvt_pk_bf16(v0[0], v0[1]); w.y = cvt_pk_bf16(v0[2], v0[3]); w.z = cvt_pk_bf16(v1[0], v1[1]); w.w = cvt_pk_bf16(v1[2], v1[3]);
                    *(u32x4*)(rowp + bj * HALF) = w; } }
    }
};
struct EpiOdd1 {
    static constexpr bool PERM = true, AFTER_DRAIN = false;
    bf16_t* Z; bf16_t* XBC; float* DTRAW;
    __device__ __forceinline__ void operator()(const f32x4 (&acc)[2][2][4][2], const Unit& u, int wr, int wc, int fr, int fq) const {
        const int row0 = u.pm * BM + wr * 64 + fr;
        if (u.pn >= 40) {
#pragma unroll
            for (int ai = 0; ai < 2; ++ai)
#pragma unroll
                for (int m = 0; m < 4; ++m) { float* rp = DTRAW + (size_t)(row0 + ai * HALF + m * 16) * 128 + wc * 32 + 8 * fq;
                    *(f32x4*)(rp) = acc[ai][0][m][0]; *(f32x4*)(rp + 4) = acc[ai][0][m][1]; }
            return;
        }
        bf16_t* base; int ldc, colt;
        if (u.pn < 16) { base = Z; ldc = 4096; colt = u.pn * BM; } else { base = XBC; ldc = 6144; colt = (u.pn - 16) * BM; }
        const int col0 = colt + wc * 32 + 8 * fq;
#pragma unroll
        for (int ai = 0; ai < 2; ++ai)
#pragma unroll
            for (int m = 0; m < 4; ++m) { bf16_t* rowp = base + (size_t)(row0 + ai * HALF + m * 16) * ldc + col0;
#pragma unroll
                for (int bj = 0; bj < 2; ++bj) { const f32x4 v0 = acc[ai][bj][m][0], v1 = acc[ai][bj][m][1];
                    u32x4 w; w.x = cvt_pk_bf16(v0[0], v0[1]); w.y = cvt_pk_bf16(v0[2], v0[3]); w.z = cvt_pk_bf16(v1[0], v1[1]); w.w = cvt_pk_bf16(v1[2], v1[3]);
                    *(u32x4*)(rowp + bj * HALF) = w; } }
    }
};
struct EpiSwiGLU {
    static constexpr bool PERM = true, AFTER_DRAIN = false;
    bf16_t* O; int ldc;
    __device__ __forceinline__ void operator()(const f32x4 (&acc)[2][2][4][2], const Unit& u, int wr, int wc, int fr, int fq) const {
        const int row0 = u.pm * BM + wr * 64 + fr, col0 = u.pn * HALF + wc * 32 + 8 * fq;
#pragma unroll
        for (int ai = 0; ai < 2; ++ai)
#pragma unroll
            for (int m = 0; m < 4; ++m) { bf16_t* rowp = O + (size_t)(row0 + ai * HALF + m * 16) * ldc + col0;
                float o[8];
#pragma unroll
                for (int n = 0; n < 2; ++n)
#pragma unroll
                    for (int j = 0; j < 4; ++j) { const float g = acc[ai][0][m][n][j], uu = acc[ai][1][m][n][j]; o[n * 4 + j] = g * fast_sigmoid(g) * uu; }
                u32x4 w; w.x = cvt_pk_bf16(o[0], o[1]); w.y = cvt_pk_bf16(o[2], o[3]); w.z = cvt_pk_bf16(o[4], o[5]); w.w = cvt_pk_bf16(o[6], o[7]);
                *(u32x4*)(rowp) = w; }
    }
};
struct EpiResid {
    static constexpr bool PERM = false, AFTER_DRAIN = false;
    float* Y; const float* gate;
    __device__ __forceinline__ void operator()(const f32x4 (&acc)[2][2][4][2], const Unit& u, int wr, int wc, int fr, int fq) const {
        const int row0 = u.pm * BM + wr * 64 + fr, col0 = u.pn * BM + wc * 32 + 4 * fq;
        const int cond = u.pm < 16 ? 0 : 1 + ((u.pm - 16) >> 3);
        const float* gp = gate + (size_t)cond * 12288 + col0;
        f32x4 gv[2][2];
#pragma unroll
        for (int bj = 0; bj < 2; ++bj)
#pragma unroll
            for (int n = 0; n < 2; ++n) gv[bj][n] = *(const f32x4*)(gp + bj * HALF + n * 16);
#pragma unroll
        for (int ai = 0; ai < 2; ++ai)
#pragma unroll
            for (int m = 0; m < 4; ++m) { float* rowp = Y + (size_t)(row0 + ai * HALF + m * 16) * 2048 + col0;
#pragma unroll
                for (int bj = 0; bj < 2; ++bj)
#pragma unroll
                    for (int n = 0; n < 2; ++n) { f32x4* p = (f32x4*)(rowp + bj * HALF + n * 16); *p = *p + gv[bj][n] * acc[ai][bj][m][n]; } }
    }
};

template <class Epi, class Sched, bool ALIGN_EPI = false, bool SP2 = false>
__device__ __forceinline__ void gemm_phase(PG8_LAS unsigned char* lds, const Gemm g, const Sched& S, const Epi& E) {
    int tid_ = threadIdx.x; asm volatile("" : "+v"(tid_)); const int tid = tid_, wid = __builtin_amdgcn_readfirstlane(tid >> 6), lane = tid & 63, wr = wid >> 2, wc = wid & 3, fr = lane & 15, fq = lane >> 4;
    const int K = g.K, nt = K / BK;
    unsigned voffA[2], voffB[2];
#pragma unroll
    for (int i = 0; i < 2; ++i) { int R, C; stage_rc(tid * 16 + i * 8192, R, C); const int Rb = Epi::PERM ? ((R & ~31) + perm32(R & 31)) : R;
        voffA[i] = (unsigned)(R * K + C) * 2u; voffB[i] = (unsigned)(Rb * K + C) * 2u; }
    const size_t kstep = (size_t)(BK * 2);
    const size_t hstep = (size_t)HALF * K * 2;
    const size_t tstep = 2 * hstep;
    const unsigned ldsw = (unsigned)wid * 1024u;
    const int aoff = lds_byte(wr * 64 + fr, fq * 8), boff = lds_byte(wc * 32 + fr, fq * 8);
#define PG8_SA(b, h) (((b) * 2 + (h)) * HTB)
#define PG8_SB(b, h) ((4 + (b) * 2 + (h)) * HTB)
#define PG8_STAGE(bufoff, gbase, voff) do { _Pragma("unroll") for (int _i = 0; _i < 2; ++_i) \
        __builtin_amdgcn_global_load_lds((const unsigned*)((const char*)(gbase) + (voff)[_i]), (PG8_LAS unsigned*)(lds + (bufoff) + ldsw + _i * 8192), 16, 0, 0); } while (0)
#define PG8_LDA(dst, b, h) do { _Pragma("unroll") for (int m = 0; m < 4; ++m) _Pragma("unroll") for (int k = 0; k < 2; ++k) dst[m][k] = *(const PG8_LAS bf16x8*)(lds + PG8_SA(b, h) + aoff + m * 2048 + k * 1024); } while (0)
#define PG8_LDB(dst, b, h) do { _Pragma("unroll") for (int n = 0; n < 2; ++n) _Pragma("unroll") for (int k = 0; k < 2; ++k) dst[n][k] = *(const PG8_LAS bf16x8*)(lds + PG8_SB(b, h) + boff + n * 2048 + k * 1024); } while (0)
#define PG8_MMA(ai, bj, At, Bt) do { __builtin_amdgcn_s_setprio(1); _Pragma("unroll") for (int m = 0; m < 4; ++m) _Pragma("unroll") for (int n = 0; n < 2; ++n) _Pragma("unroll") for (int k = 0; k < 2; ++k) \
        acc[ai][bj][m][n] = __builtin_amdgcn_mfma_f32_16x16x32_bf16(Bt[n][k], At[m][k], acc[ai][bj][m][n], 0, 0, 0); __builtin_amdgcn_s_setprio(0); } while (0)
#define PG8_WAIT_V(n) asm volatile("s_waitcnt vmcnt(" #n ")" ::: "memory")
#define PG8_WAIT_L(n) asm volatile("s_waitcnt lgkmcnt(" #n ")" ::: "memory")
#define PG8_BAR __builtin_amdgcn_s_barrier()
#define PG8_SCHED __builtin_amdgcn_sched_barrier(0)
    Unit cur, nxt; int ui = 0;
    if (!S.next(0, cur)) return;
    f32x4 acc[2][2][4][2];
#pragma unroll
    for (int a = 0; a < 2; ++a)
#pragma unroll
        for (int b = 0; b < 2; ++b)
#pragma unroll
            for (int m = 0; m < 4; ++m)
#pragma unroll
                for (int n = 0; n < 2; ++n) acc[a][b][m][n] = (f32x4){0.f, 0.f, 0.f, 0.f};
    bf16x8 At[4][2], B0[2][2], B1[2][2];
    const char* cA = (const char*)g.A + (size_t)cur.pm * tstep; const char* cB = (const char*)g.Bt + (size_t)cur.pn * tstep;
    S.a_ready(cur);
    if constexpr (SP2) {
        PG8_STAGE(PG8_SB(0, 0), cB, voffB); PG8_STAGE(PG8_SB(0, 1), cB + hstep, voffB); PG8_STAGE(PG8_SA(0, 0), cA, voffA); PG8_STAGE(PG8_SA(0, 1), cA + hstep, voffA);
        if (wr == 1) PG8_BAR;
        PG8_WAIT_V(2); PG8_BAR;
        PG8_STAGE(PG8_SB(1, 0), cB + kstep, voffB); PG8_STAGE(PG8_SA(1, 0), cA + kstep, voffA); PG8_STAGE(PG8_SB(1, 1), cB + hstep + kstep, voffB);
        PG8_WAIT_V(6); PG8_BAR;
    } else {
        PG8_STAGE(PG8_SB(0, 0), cB, voffB); PG8_STAGE(PG8_SA(0, 0), cA, voffA); PG8_STAGE(PG8_SB(0, 1), cB + hstep, voffB); PG8_STAGE(PG8_SA(0, 1), cA + hstep, voffA);
        if (wr == 1) PG8_BAR;
        PG8_WAIT_V(4); PG8_BAR;
        PG8_STAGE(PG8_SB(1, 0), cB + kstep, voffB); PG8_STAGE(PG8_SA(1, 0), cA + kstep, voffA); PG8_STAGE(PG8_SB(1, 1), cB + hstep + kstep, voffB);
        PG8_WAIT_V(6); PG8_BAR;
    }
    for (;;) {
        const bool has_next = S.next(ui + 1, nxt);
        const char* nA = has_next ? (const char*)g.A + (size_t)nxt.pm * tstep : cA; const char* nB = has_next ? (const char*)g.Bt + (size_t)nxt.pn * tstep : cB;
        for (int t = 0; t < nt; t += 2) {
            const bool last = (t == nt - 2);
            const char* a1 = cA + (size_t)(t + 1) * kstep;
            const char* a2 = last ? nA : cA + (size_t)(t + 2) * kstep; const char* b2 = last ? nB : cB + (size_t)(t + 2) * kstep;
            const char* a3 = a2 + kstep; const char* b3 = b2 + kstep;
            if (last && has_next) S.a_ready(nxt);
            if constexpr (SP2) {
            PG8_LDB(B0, 0, 0); PG8_LDB(B1, 0, 1); PG8_SCHED; PG8_LDA(At, 0, 0); PG8_STAGE(PG8_SA(1, 1), a1 + hstep, voffA);
            PG8_WAIT_V(8); PG8_WAIT_L(0); PG8_BAR; PG8_MMA(0, 0, At, B0); PG8_MMA(0, 1, At, B1); PG8_BAR; PG8_SCHED;
            PG8_LDA(At, 0, 1); PG8_STAGE(PG8_SB(0, 0), b2, voffB); PG8_STAGE(PG8_SB(0, 1), b2 + hstep, voffB); PG8_STAGE(PG8_SA(0, 0), a2, voffA);
            PG8_WAIT_V(8); PG8_WAIT_L(0); PG8_BAR; PG8_MMA(1, 0, At, B0); PG8_MMA(1, 1, At, B1); PG8_BAR; PG8_SCHED;
            PG8_LDB(B0, 1, 0); PG8_LDB(B1, 1, 1); PG8_SCHED; PG8_LDA(At, 1, 0); PG8_STAGE(PG8_SA(0, 1), a2 + hstep, voffA);
            PG8_WAIT_V(8); PG8_WAIT_L(0); PG8_BAR; PG8_MMA(0, 0, At, B0); PG8_MMA(0, 1, At, B1); PG8_BAR; PG8_SCHED;
            PG8_LDA(At, 1, 1); PG8_STAGE(PG8_SB(1, 0), b3, voffB); PG8_STAGE(PG8_SB(1, 1), b3 + hstep, voffB); PG8_STAGE(PG8_SA(1, 0), a3, voffA);
            PG8_WAIT_V(8); PG8_WAIT_L(0); PG8_BAR; PG8_MMA(1, 0, At, B0); PG8_MMA(1, 1, At, B1); PG8_BAR; PG8_SCHED;
            } else {
            PG8_LDB(B0, 0, 0); PG8_SCHED; PG8_LDA(At, 0, 0); PG8_STAGE(PG8_SA(1, 1), a1 + hstep, voffA);
            PG8_WAIT_L(8); PG8_BAR; PG8_WAIT_L(0); PG8_MMA(0, 0, At, B0); PG8_BAR; PG8_SCHED;
            PG8_LDB(B1, 0, 1); PG8_STAGE(PG8_SB(0, 0), b2, voffB);
            PG8_BAR; PG8_WAIT_L(0); PG8_MMA(0, 1, At, B1); PG8_BAR;
            PG8_LDA(At, 0, 1); PG8_STAGE(PG8_SA(0, 0), a2, voffA);
            PG8_BAR; PG8_WAIT_L(0); PG8_MMA(1, 0, At, B0); PG8_BAR; PG8_SCHED;
            PG8_STAGE(PG8_SB(0, 1), b2 + hstep, voffB);
            PG8_WAIT_V(6); PG8_BAR; PG8_MMA(1, 1, At, B1); PG8_BAR;
            PG8_LDB(B0, 1, 0); PG8_SCHED; PG8_LDA(At, 1, 0); PG8_STAGE(PG8_SA(0, 1), a2 + hstep, voffA);
            PG8_WAIT_L(8); PG8_BAR; PG8_WAIT_L(0); PG8_MMA(0, 0, At, B0); PG8_BAR; PG8_SCHED;
            PG8_LDB(B1, 1, 1); PG8_STAGE(PG8_SB(1, 0), b3, voffB);
            PG8_BAR; PG8_WAIT_L(0); PG8_MMA(0, 1, At, B1); PG8_BAR;
            PG8_LDA(At, 1, 1); PG8_STAGE(PG8_SA(1, 0), a3, voffA);
            PG8_BAR; PG8_WAIT_L(0); PG8_MMA(1, 0, At, B0); PG8_BAR; PG8_SCHED;
            PG8_STAGE(PG8_SB(1, 1), b3 + hstep, voffB);
            PG8_WAIT_V(6); PG8_BAR; PG8_MMA(1, 1, At, B1); PG8_BAR;
            }
        }
        if constexpr (ALIGN_EPI) { if (wr == 0) PG8_BAR; }
        if constexpr (!Epi::AFTER_DRAIN) { E(acc, cur, wr, wc, fr, fq); S.done(cur); }
        if (!has_next) break;
#pragma unroll
        for (int a = 0; a < 2; ++a)
#pragma unroll
            for (int b = 0; b < 2; ++b)
#pragma unroll
                for (int m = 0; m < 4; ++m)
#pragma unroll
                    for (int n = 0; n < 2; ++n) acc[a][b][m][n] = (f32x4){0.f, 0.f, 0.f, 0.f};
        cur = nxt; cA = nA; cB = nB; ++ui;
        if constexpr (ALIGN_EPI) { if (wr == 1) PG8_BAR; }
    }
    PG8_WAIT_V(0);
    if constexpr (!ALIGN_EPI) { if (wr == 0) PG8_BAR; }
    PG8_BAR;
    if constexpr (Epi::AFTER_DRAIN) { E.fused(acc, cur, wr, wc, fr, fq, lds, wid, lane); S.done(cur); }
#undef PG8_SA
#undef PG8_SB
#undef PG8_STAGE
#undef PG8_LDA
#undef PG8_LDB
#undef PG8_MMA
#undef PG8_WAIT_V
#undef PG8_WAIT_L
#undef PG8_BAR
#undef PG8_SCHED
}
}

#define GAS __attribute__((address_space(1)))
#define LAS __attribute__((address_space(3)))
typedef unsigned short bf16_t;
typedef short bf16x8 __attribute__((ext_vector_type(8)));
typedef short bf16x4 __attribute__((ext_vector_type(4)));
typedef float f32x4 __attribute__((ext_vector_type(4)));
typedef float f32x2 __attribute__((ext_vector_type(2)));
typedef unsigned u32x4 __attribute__((ext_vector_type(4)));
typedef unsigned u32x2 __attribute__((ext_vector_type(2)));
#define MFMA16(a, b, c) __builtin_amdgcn_mfma_f32_16x16x32_bf16((a), (b), (c), 0, 0, 0)

constexpr int D = 2048, T = 20480, TP = 4096, NT = 80;
constexpr float EPS = 1e-6f;
constexpr size_t MiB = 1u << 20;
constexpr size_t WS_CTL = 0, WS_ADA = 1 * MiB, WS_ZERO_BYTES = 3 * MiB;
constexpr size_t WS_ROPE = 3 * MiB, WS_LRUW = 4 * MiB, WS_CHS = 6 * MiB;
constexpr size_t WS_WEIN = 16 * MiB, WS_WEOUT = 56 * MiB, WS_WSIN = 72 * MiB, WS_WSOUT = 154 * MiB, WS_WFIN = 186 * MiB, WS_WFOUT = 362 * MiB;
constexpr size_t WS_H = 450 * MiB, WS_R1 = 530 * MiB, WS_R2 = 770 * MiB, WS_R3 = 930 * MiB, WS_R4 = 1090 * MiB, WS_R5 = 1210 * MiB, WS_END = 1242 * MiB;
constexpr size_t WS_U5 = WS_R1, WS_Q = WS_R2, WS_K = WS_R2 + 40 * MiB, WS_KC = WS_R2 + 80 * MiB, WS_VTP = WS_R2 + 84 * MiB, WS_VTS = WS_R2 + 92 * MiB, WS_MIXE = WS_R3;
constexpr size_t WS_XBC = WS_R1, WS_Z = WS_R2, WS_XT = WS_R3, WS_BN = WS_R4, WS_BT = WS_R4 + 40 * MiB, WS_CN = WS_R4 + 80 * MiB, WS_DTRAW = WS_R5;
constexpr size_t WS_SIN = WS_H, WS_MIXO = WS_R1 + 80 * MiB;
constexpr size_t WS_HID = WS_R1;
constexpr size_t OUT_K = 41943040, OUT_V = 50331648, OUT_LRU = 58720256, OUT_SSD = 58785792;
constexpr int LDS_MISC = 131072, LDS_BYTES = 131072 + 1024;

struct Args { const float* in[34]; float* out; unsigned char* ws; int ph_lo, ph_hi; };

__device__ __forceinline__ float bf2f(unsigned short b) { return __uint_as_float(((unsigned)b) << 16); }
__device__ __forceinline__ float bflo(unsigned w) { return __uint_as_float(w << 16); }
__device__ __forceinline__ float bfhi(unsigned w) { return __uint_as_float(w & 0xffff0000u); }
__device__ __forceinline__ unsigned pk2(float lo, float hi) { return pg8::cvt_pk_bf16(lo, hi); }
__device__ __forceinline__ float fexp(float x) { return __builtin_amdgcn_exp2f(1.4426950408889634f * x); }
__device__ __forceinline__ float fsigmoid(float x) { return __builtin_amdgcn_rcpf(1.0f + __builtin_amdgcn_exp2f(-1.4426950408889634f * x)); }
__device__ __forceinline__ float fsilu(float x) { return x * fsigmoid(x); }
__device__ __forceinline__ float fsoftplus(float x) { return fmaxf(x, 0.f) + log1pf(fexp(-fabsf(x))); }
__device__ __forceinline__ float fgelu_tanh(float x) { const float u = 0.7978845608028654f * (x + 0.044715f * x * x * x); const float t = 1.f - 2.f * __builtin_amdgcn_rcpf(fexp(2.f * u) + 1.f); return 0.5f * x * (1.f + t); }
__device__ __forceinline__ float wave_sum(float v) {
#pragma unroll
    for (int o = 1; o < 64; o <<= 1) v += __shfl_xor(v, o);
    return v;
}
__device__ __forceinline__ void unpack8(const u32x4 v, float (&f)[8]) { f[0] = bflo(v.x); f[1] = bfhi(v.x); f[2] = bflo(v.y); f[3] = bfhi(v.y); f[4] = bflo(v.z); f[5] = bfhi(v.z); f[6] = bflo(v.w); f[7] = bfhi(v.w); }
__device__ __forceinline__ u32x4 pack8(const float (&f)[8]) { u32x4 w; w.x = pk2(f[0], f[1]); w.y = pk2(f[2], f[3]); w.z = pk2(f[4], f[5]); w.w = pk2(f[6], f[7]); return w; }
__device__ __forceinline__ bf16x8 as_bf16x8(u32x4 v) { return __builtin_bit_cast(bf16x8, v); }
__device__ __forceinline__ int cond_of_tok(int t) { return t < TP ? 0 : 1 + ((t - TP) >> 11); }
__device__ __forceinline__ int otid() { int t = threadIdx.x; asm volatile("" : "+v"(t)); return t; }
template <int N> __device__ __forceinline__ float dpp_row_shr(float v) { const int x = __builtin_bit_cast(int, v); return __builtin_bit_cast(float, __builtin_amdgcn_update_dpp(x, x, 0x110 + N, 0xf, 0xf, false)); }
template <int N> __device__ __forceinline__ float dpp_row_shl(float v) { const int x = __builtin_bit_cast(int, v); return __builtin_bit_cast(float, __builtin_amdgcn_update_dpp(x, x, 0x100 + N, 0xf, 0xf, false)); }
#define WG_SYNC() __syncthreads()
#ifndef DBG_TWICE
#define DBG_TWICE 0
#endif

#define XB_TMO      128
#define XB_XCNT(j)  (256  + 64 * (j))
#define XB_XSUB(j)  (1280 + 64 * (j))
#define XB_XGEN(j)  (2304 + 64 * (j))
#define XB_TOP      3328
#define XB_TOPGEN   3392
#define XCD_BAR_WORDS 3456
#define XB_SPIN_CAP (1u << 18)

__device__ __forceinline__ unsigned xb_ld(unsigned* p)              { return __hip_atomic_load(p, __ATOMIC_RELAXED, __HIP_MEMORY_SCOPE_AGENT); }
__device__ __forceinline__ unsigned xb_add(unsigned* p, unsigned v) { return __hip_atomic_fetch_add(p, v, __ATOMIC_RELAXED, __HIP_MEMORY_SCOPE_AGENT); }
__device__ __forceinline__ unsigned xb_xcc_id() { return (unsigned)__builtin_amdgcn_s_getreg((3 << 11) | 20) & 0xFu; }
#define XB_SPIN(cond, bar) do { unsigned _sp = 0; while (cond) { __builtin_amdgcn_s_sleep(1); \
    if ((++_sp & 255u) == 0u) { if (xb_ld(&(bar)[XB_TMO])) break; if (_sp > XB_SPIN_CAP) { atomicAdd(&(bar)[XB_TMO], 1u); break; } } } } while (0)

struct XcdBarrier {
    unsigned* bar; unsigned x;
    volatile LAS unsigned* st;
};

__device__ __forceinline__ XcdBarrier xcd_barrier_post(unsigned* bar, volatile LAS unsigned* st) {
    XcdBarrier b; b.bar = bar; b.x = xb_xcc_id(); b.st = st;
    if (threadIdx.x == 0) (void)xb_add(&bar[XB_XCNT(b.x)], 1u);
    return b;
}
__device__ __forceinline__ void xcd_barrier_complete(unsigned* bar, unsigned x, unsigned& nloc, unsigned& nx) {
    const unsigned G = gridDim.x * gridDim.y * gridDim.z;
    unsigned sum, cnt, mine, sp = 0u;
    for (;;) {
        sum = 0u; cnt = 0u; mine = 0u;
#pragma unroll
        for (unsigned j = 0; j < 16; ++j) { const unsigned c = xb_ld(&bar[XB_XCNT(j)]); sum += c; cnt += (c > 0u) ? 1u : 0u; mine = (j == x) ? c : mine; }
        if (sum == G) break;
        __builtin_amdgcn_s_sleep(1);
        if ((++sp & 255u) == 0u) { if (xb_ld(&bar[XB_TMO])) break; if (sp > XB_SPIN_CAP) { atomicAdd(&bar[XB_TMO], 1u); break; } }
    }
    nloc = mine > 0u ? mine : 1u; nx = cnt > 0u ? cnt : 1u;
}

__device__ __forceinline__ void xcd_barrier(const XcdBarrier& b) {
    asm volatile("s_waitcnt vmcnt(0)" ::: "memory");
    __syncthreads();
    if (threadIdx.x == 0) {
        unsigned* bar = b.bar;
        __builtin_amdgcn_s_waitcnt(0);
        unsigned nloc = b.st[0], nx = b.st[1];
        if (nloc == 0u) { xcd_barrier_complete(bar, b.x, nloc, nx); b.st[0] = nloc; b.st[1] = nx; }
        const unsigned old = xb_add(&bar[XB_XSUB(b.x)], 1u);
        const unsigned gen = old / nloc;
        if (old + 1u == (gen + 1u) * nloc) {
            __builtin_amdgcn_fence(__ATOMIC_RELEASE, "agent");
            asm volatile("s_waitcnt vmcnt(0)" ::: "memory");
            const unsigned og = xb_add(&bar[XB_TOP], 1u);
            const unsigned tg = og / nx;
            if (og + 1u == (tg + 1u) * nx) xb_add(&bar[XB_TOPGEN], 1u);
            else XB_SPIN(xb_ld(&bar[XB_TOPGEN]) == tg, bar);
            __builtin_amdgcn_fence(__ATOMIC_ACQUIRE, "agent");
            xb_add(&bar[XB_XGEN(b.x)], 1u);
            asm volatile("s_waitcnt vmcnt(0)" ::: "memory");
        } else {
            XB_SPIN(xb_ld(&bar[XB_XGEN(b.x)]) == gen, bar);
            __builtin_amdgcn_fence(__ATOMIC_ACQUIRE, "agent");
            asm volatile("s_waitcnt vmcnt(0)" ::: "memory");
        }
    }
    __syncthreads();
}

__device__ __forceinline__ void transpose_item(const float* W, int N, bf16_t* WT, int ldk, int k0, int n0, int drow0, LAS float* scr, int lane) {
#pragma unroll 8
    for (int i = 0; i < 32; ++i) { const int kk = 2 * i + (lane >> 5); scr[kk * 33 + (lane & 31)] = W[(size_t)(k0 + kk) * N + n0 + (lane & 31)]; }
    asm volatile("s_waitcnt lgkmcnt(0)" ::: "memory");
    const int c = lane & 7;
#pragma unroll
    for (int jj = 0; jj < 4; ++jj) { const int n = (lane >> 3) + 8 * jj; const LAS float* s = scr + (8 * c) * 33 + n;
        u32x4 o; o.x = pk2(s[0 * 33], s[1 * 33]); o.y = pk2(s[2 * 33], s[3 * 33]); o.z = pk2(s[4 * 33], s[5 * 33]); o.w = pk2(s[6 * 33], s[7 * 33]);
        *(u32x4*)(WT + (size_t)(drow0 + n) * ldk + k0 + 8 * c) = o; }
    asm volatile("s_waitcnt lgkmcnt(0)" ::: "memory");
}

__device__ __forceinline__ void phase_prologue(const Args& A, LAS unsigned char* lds) {
    const int tid = otid(), lane = tid & 63, wave = tid >> 6;
    unsigned char* ws = A.ws;
    {
        LAS float* s = (LAS float*)lds;
        for (int idx = tid; idx < 9 * 2048; idx += 512) { const int cnd = idx >> 11, k = idx & 2047; const float v = cnd == 0 ? A.in[7][k] : A.in[2][(cnd - 1) * 2048 + k]; s[k * 12 + cnd] = v * fsigmoid(v); }
        WG_SYNC();
        float* ADA = (float*)(ws + WS_ADA);
        LAS float* red = (LAS float*)(lds + 98304);
        for (int it = blockIdx.x; it < 4 * 192; it += gridDim.x) {
            const int layer = it / 192, cg = it - layer * 192, col = cg * 64 + lane;
            float acc[9];
#pragma unroll
            for (int c = 0; c < 9; ++c) acc[c] = 0.f;
            const float* w = A.in[8] + ((size_t)layer * 2048 + wave * 256) * 12288 + col;
#pragma unroll 8
            for (int k = 0; k < 256; ++k) {
                const float wv = w[(size_t)k * 12288];
                const LAS f32x4* sp = (const LAS f32x4*)(s + (wave * 256 + k) * 12);
                const f32x4 s0 = sp[0], s1 = sp[1], s2 = sp[2];
                acc[0] += s0[0] * wv; acc[1] += s0[1] * wv; acc[2] += s0[2] * wv; acc[3] += s0[3] * wv;
                acc[4] += s1[0] * wv; acc[5] += s1[1] * wv; acc[6] += s1[2] * wv; acc[7] += s1[3] * wv; acc[8] += s2[0] * wv;
            }
            WG_SYNC();
#pragma unroll
            for (int c = 0; c < 9; ++c) red[(wave * 9 + c) * 64 + lane] = acc[c];
            WG_SYNC();
            for (int idx = tid; idx < 9 * 64; idx += 512) { const int c = idx >> 6, l = idx & 63; float v = A.in[9][(size_t)layer * 12288 + cg * 64 + l];
#pragma unroll
                for (int wv_ = 0; wv_ < 8; ++wv_) v += red[(wv_ * 9 + c) * 64 + l];
                ADA[((size_t)layer * 9 + c) * 12288 + cg * 64 + l] = v; }
        }
        WG_SYNC();
    }
    {
        float* rope = (float*)(ws + WS_ROPE);
        for (int idx = blockIdx.x * 512 + tid; idx < 2048 * 64; idx += gridDim.x * 512) {
            const int pos = idx >> 6, d = idx & 63, qtr = d >> 4, i = d & 15;
            const float inv = __builtin_amdgcn_exp2f(-(float)i * (13.287712379549449f / 16.0f));
            const float p = (qtr < 2) ? (float)(pos >> 6) : (float)(pos & 63);
            const float rev = p * inv * 0.15915494309189535f;
            rope[idx] = __builtin_amdgcn_cosf(rev); rope[2048 * 64 + idx] = __builtin_amdgcn_sinf(rev);
        }
    }
    {
        LAS float* scr = (LAS float*)(lds + wave * 16384);
        const int gw = blockIdx.x * 8 + wave, NGW = gridDim.x * 8;
        constexpr int I_EIN = 32 * 160, I_EOUT = 32 * 64, I_SIN = 32 * 324, I_SOUT = 64 * 64, I_FIN = 32 * 352, I_FOUT = 88 * 64, I_LRU = 8;
        constexpr int N0 = 2 * I_EIN, N1 = N0 + 2 * I_EOUT, N2 = N1 + 2 * I_SIN, N3 = N2 + 2 * I_SOUT, N4 = N3 + 4 * I_FIN, N5 = N4 + 4 * I_FOUT, N6 = N5 + 64 * I_LRU;
        for (int it = gw; it < N6; it += NGW) {
            if (it < N0) { const int mtx = it / I_EIN, r = it - mtx * I_EIN, kb = r / 160, nb = r - kb * 160;
                transpose_item(A.in[18] + (size_t)mtx * 2048 * 5120, 5120, (bf16_t*)(ws + WS_WEIN) + (size_t)mtx * 5120 * 2048, 2048, kb * 64, nb * 32, nb * 32, scr, lane); }
            else if (it < N1) { const int q = it - N0, mtx = q / I_EOUT, r = q - mtx * I_EOUT, kb = r / 64, nb = r - kb * 64;
                transpose_item(A.in[19] + (size_t)mtx * 2048 * 2048, 2048, (bf16_t*)(ws + WS_WEOUT) + (size_t)mtx * 2048 * 2048, 2048, kb * 64, nb * 32, nb * 32, scr, lane); }
            else if (it < N2) { const int q = it - N1, mtx = q / I_SIN, r = q - mtx * I_SIN, kb = r / 324, nb = r - kb * 324;
                transpose_item(A.in[24] + (size_t)mtx * 2048 * 10368, 10368, (bf16_t*)(ws + WS_WSIN) + (size_t)mtx * 10496 * 2048, 2048, kb * 64, nb * 32, nb * 32, scr, lane); }
            else if (it < N3) { const int q = it - N2, mtx = q / I_SOUT, r = q - mtx * I_SOUT, kb = r / 64, nb = r - kb * 64;
                transpose_item(A.in[31] + (size_t)mtx * 4096 * 2048, 2048, (bf16_t*)(ws + WS_WSOUT) + (size_t)mtx * 2048 * 4096, 4096, kb * 64, nb * 32, nb * 32, scr, lane); }
            else if (it < N4) { const int q = it - N3, mtx = q / I_FIN, r = q - mtx * I_FIN, kb = r / 352, nb = r - kb * 352;
                const int n0 = nb * 32; const int drow = n0 < 5632 ? (n0 >> 7) * 256 + (n0 & 127) : ((n0 - 5632) >> 7) * 256 + 128 + ((n0 - 5632) & 127);
                transpose_item(A.in[32] + (size_t)mtx * 2048 * 11264, 11264, (bf16_t*)(ws + WS_WFIN) + (size_t)mtx * 11264 * 2048, 2048, kb * 64, n0, drow, scr, lane); }
            else if (it < N5) { const int q = it - N4, mtx = q / I_FOUT, r = q - mtx * I_FOUT, kb = r / 64, nb = r - kb * 64;
                transpose_item(A.in[33] + (size_t)mtx * 5632 * 2048, 2048, (bf16_t*)(ws + WS_WFOUT) + (size_t)mtx * 2048 * 5632, 5632, kb * 64, nb * 32, nb * 32, scr, lane); }
            else { const int q = it - N5, mtx = q >> 3, r = q & 7, kb = r >> 2, nb = r & 3;
                const int blk = mtx & 7, gate = (mtx >> 3) & 1, jd = mtx >> 4;
                const float* src = (gate ? A.in[15] : A.in[13]) + ((size_t)jd * 8 + blk) * 16384;
                transpose_item(src, 128, (bf16_t*)(ws + WS_LRUW) + (size_t)mtx * 16384, 128, kb * 64, nb * 32, nb * 32, scr, lane); }
        }
        for (int idx = blockIdx.x * 512 + tid; idx < 2 * 128 * 2048 / 8; idx += gridDim.x * 512) {
            const int mtx = idx / (128 * 256), r = idx - mtx * (128 * 256);
            *(u32x4*)((bf16_t*)(ws + WS_WSIN) + (size_t)mtx * 10496 * 2048 + (size_t)10368 * 2048 + (size_t)r * 8) = (u32x4){0u, 0u, 0u, 0u};
        }
    }
}

__device__ __forceinline__ void phase_modulate(const Args& A, int layer, int which) {
    const int tid = otid(), lane = tid & 63, wave = tid >> 6;
    const int gw = blockIdx.x * 8 + wave, NGW = gridDim.x * 8;
    const float* g = A.in[10] + ((size_t)layer * 2 + which) * 2048;
    const float* ADA = (const float*)(A.ws + WS_ADA);
    bf16_t* H = (bf16_t*)(A.ws + WS_H);
    for (int row = gw; row < T; row += NGW) {
        const int cond = cond_of_tok(row);
        const float* shift = ADA + ((size_t)layer * 9 + cond) * 12288 + (which * 3 + 0) * 2048;
        const float* scale = shift + 2048;
        const f32x4* xr = (const f32x4*)(A.out + (size_t)row * 2048) + lane;
        f32x4 v[8]; float ss = 0.f;
#pragma unroll
        for (int jj = 0; jj < 8; ++jj) { v[jj] = xr[64 * jj]; ss += (v[jj][0] * v[jj][0] + v[jj][1] * v[jj][1]) + (v[jj][2] * v[jj][2] + v[jj][3] * v[jj][3]); }
        const float rstd = 1.0f / sqrtf(wave_sum(ss) * (1.f / 2048.f) + EPS);
        u32x2* o8 = (u32x2*)(H + (size_t)row * 2048) + lane;
#pragma unroll
        for (int jj = 0; jj < 8; ++jj) { const int c = 4 * lane + 256 * jj;
            const f32x4 gg = *(const f32x4*)(g + c), sc = *(const f32x4*)(scale + c), sh = *(const f32x4*)(shift + c);
            f32x4 o = v[jj] * rstd * gg * (sc + 1.0f) + sh;
            u32x2 w; w.x = pk2(o[0], o[1]); w.y = pk2(o[2], o[3]); o8[64 * jj] = w; }
    }
}

constexpr float QSCALE = 0.125f * 1.4426950408889634f;

template <bool F32SRC>
__device__ __forceinline__ void vt_tile(const void* src, size_t src_ld, bf16_t* dst, int Lk, LAS bf16_t* scr  , int lane) {
#pragma unroll 4
    for (int i = 0; i < 16; ++i) { const int p = lane + 64 * i, row = p >> 4, pc = p & 15;
        u32x4 v;
        if (F32SRC) { const float* s = (const float*)src + (size_t)row * src_ld + pc * 8; const f32x4 a = *(const f32x4*)s, b = *(const f32x4*)(s + 4);
            v.x = pk2(a[0], a[1]); v.y = pk2(a[2], a[3]); v.z = pk2(b[0], b[1]); v.w = pk2(b[2], b[3]); }
        else v = *(const u32x4*)((const bf16_t*)src + (size_t)row * src_ld + pc * 8);
        *(LAS u32x4*)(scr + row * 128 + pc * 8) = v; }
    asm volatile("s_waitcnt lgkmcnt(0)" ::: "memory");
#pragma unroll 4
    for (int i = 0; i < 16; ++i) { const int p = lane + 64 * i, dv = p & 127, tg = p >> 7;
        unsigned short e[8];
#pragma unroll
        for (int k = 0; k < 8; ++k) e[k] = scr[(8 * tg + k) * 128 + dv];
        u32x4 v; v.x = e[0] | ((unsigned)e[1] << 16); v.y = e[2] | ((unsigned)e[3] << 16); v.z = e[4] | ((unsigned)e[5] << 16); v.w = e[6] | ((unsigned)e[7] << 16);
        *(u32x4*)(dst + (size_t)dv * Lk + 8 * tg) = v; }
    asm volatile("s_waitcnt lgkmcnt(0)" ::: "memory");
}

__device__ __forceinline__ void phase_qkv_prep(const Args& A, LAS unsigned char* lds, int j) {
    const int tid = otid(), lane = tid & 63, wave = tid >> 6;
    unsigned char* ws = A.ws;
    const bf16_t* U5 = (const bf16_t*)(ws + WS_U5);
    bf16_t* Qb = (bf16_t*)(ws + WS_Q); bf16_t* Kb = (bf16_t*)(ws + WS_K); bf16_t* KC = (bf16_t*)(ws + WS_KC);
    bf16_t* VTP = (bf16_t*)(ws + WS_VTP); bf16_t* VTS = (bf16_t*)(ws + WS_VTS);
    const float* rope = (const float*)(ws + WS_ROPE);
    LAS bf16_t* scr = (LAS bf16_t*)(lds + wave * 16384);
    const int mq = (lane >> 2) & 1, aq = lane & 3;
    float qn[16], kn[16];
#pragma unroll
    for (int i = 0; i < 16; ++i) { qn[i] = A.in[20][((size_t)j * 2 + mq) * 64 + aq * 16 + i]; kn[i] = A.in[21][((size_t)j * 2 + mq) * 64 + aq * 16 + i]; }
    for (int u = blockIdx.x; u < 320 + 32; u += gridDim.x) {
        if (u < 320) {
            const int t0 = u * 64;
            const int sample = t0 >= TP, b = sample ? (t0 - TP) >> 11 : t0 >> 8, l0 = sample ? (t0 - TP) & 2047 : t0 & 255;
            for (int tt = 0; tt < 8; ++tt) {
                const int tok = wave * 8 + tt, t = t0 + tok, l = l0 + tok;
                float cs[16], sn[16];
                if (sample) {
#pragma unroll
                    for (int i = 0; i < 16; i += 4) { const f32x4 c4 = *(const f32x4*)(rope + (size_t)l * 64 + aq * 16 + i), s4 = *(const f32x4*)(rope + 2048 * 64 + (size_t)l * 64 + aq * 16 + i);
                        cs[i] = c4[0]; cs[i + 1] = c4[1]; cs[i + 2] = c4[2]; cs[i + 3] = c4[3]; sn[i] = s4[0]; sn[i + 1] = s4[1]; sn[i + 2] = s4[2]; sn[i + 3] = s4[3]; }
                }
#pragma unroll
                for (int qk = 0; qk < 2; ++qk) {
                    const bf16_t* src = U5 + (size_t)t * 5120 + (qk == 0 ? 2048 : 3072) + 16 * lane;
                    float x[16]; { float a[8], c[8]; unpack8(*(const u32x4*)src, a); unpack8(*(const u32x4*)(src + 8), c);
#pragma unroll
                        for (int i = 0; i < 8; ++i) { x[i] = a[i]; x[8 + i] = c[i]; } }
                    float ss = 0.f;
#pragma unroll
                    for (int i = 0; i < 16; ++i) ss += x[i] * x[i];
                    ss += __shfl_xor(ss, 1); ss += __shfl_xor(ss, 2);
                    const float rstd = 1.0f / sqrtf(ss * (1.f / 64.f) + EPS);
#pragma unroll
                    for (int i = 0; i < 16; ++i) x[i] = x[i] * rstd * (qk == 0 ? qn[i] : kn[i]);
                    if (qk == 1 && !sample) {
                        float* o = A.out + OUT_K + (((size_t)b * 2 + j) * 256 + l) * 1024 + 16 * lane;
#pragma unroll
                        for (int i = 0; i < 16; i += 4) *(f32x4*)(o + i) = (f32x4){x[i], x[i + 1], x[i + 2], x[i + 3]};
                    }
                    if (sample) {
#pragma unroll
                        for (int i = 0; i < 16; ++i) { const float partner = __shfl_xor(x[i], 1); x[i] = (aq & 1) ? (x[i] * cs[i] + partner * sn[i]) : (x[i] * cs[i] - partner * sn[i]); }
                    }
                    if (qk == 0) {
#pragma unroll
                        for (int i = 0; i < 16; ++i) x[i] *= QSCALE;
                    }
                    bf16_t* dst = (qk == 0 ? Qb : Kb) + (size_t)t * 1024 + 16 * lane;
                    u32x4 w0, w1; w0.x = pk2(x[0], x[1]); w0.y = pk2(x[2], x[3]); w0.z = pk2(x[4], x[5]); w0.w = pk2(x[6], x[7]);
                    w1.x = pk2(x[8], x[9]); w1.y = pk2(x[10], x[11]); w1.z = pk2(x[12], x[13]); w1.w = pk2(x[14], x[15]);
                    *(u32x4*)dst = w0; *(u32x4*)(dst + 8) = w1;
                }
                if (!sample) {
                    const bf16_t* src = U5 + (size_t)t * 5120 + 4096 + 16 * lane;
                    float a[8], c[8]; unpack8(*(const u32x4*)src, a); unpack8(*(const u32x4*)(src + 8), c);
                    float* o = A.out + OUT_V + (((size_t)b * 2 + j) * 256 + l) * 1024 + 16 * lane;
                    *(f32x4*)(o) = (f32x4){a[0], a[1], a[2], a[3]}; *(f32x4*)(o + 4) = (f32x4){a[4], a[5], a[6], a[7]};
                    *(f32x4*)(o + 8) = (f32x4){c[0], c[1], c[2], c[3]}; *(f32x4*)(o + 12) = (f32x4){c[4], c[5], c[6], c[7]};
                }
            }
            {
                const int h = wave;
                bf16_t* dst = sample ? VTS + (((size_t)b * 8 + h) * 128) * 2304 + l0 : VTP + (((size_t)b * 8 + h) * 128) * 256 + l0;
                vt_tile<false>(U5 + (size_t)t0 * 5120 + 4096 + h * 128, 5120, dst, sample ? 2304 : 256, scr, lane);
            }
        } else {
            const int uu = u - 320, b = uu >> 2, k0 = (uu & 3) * 64;
            const float* ck = A.in[3] + (((size_t)b * 2 + j) * 256 + k0) * 1024;
            for (int idx = tid; idx < 64 * 1024 / 8; idx += 512) { const float* s = ck + (size_t)idx * 8; const f32x4 a = *(const f32x4*)s, c = *(const f32x4*)(s + 4);
                u32x4 v; v.x = pk2(a[0], a[1]); v.y = pk2(a[2], a[3]); v.z = pk2(c[0], c[1]); v.w = pk2(c[2], c[3]);
                *(u32x4*)(KC + ((size_t)b * 256 + k0) * 1024 + (size_t)idx * 8) = v; }
            const int h = wave;
            const float* cv = A.in[4] + (((size_t)b * 2 + j) * 256 + k0) * 1024 + h * 128;
            vt_tile<true>(cv, 1024, VTS + (((size_t)b * 8 + h) * 128) * 2304 + 2048 + k0, 2304, scr, lane);
        }
    }
}

template <int PASS>
__device__ __forceinline__ void lru_unit(const Args& A, LAS unsigned char* lds, int j, int ci, int kblk) {
    const int tid = otid(), lane = tid & 63, wave = tid >> 6, r = lane & 15, kq = lane >> 4;
    unsigned char* ws = A.ws;
    const bf16_t* U5 = (const bf16_t*)(ws + WS_U5);
    const bf16_t* LRUW = (const bf16_t*)(ws + WS_LRUW);
    f32x2* CHS = (f32x2*)(ws + WS_CHS);
    const int t0 = ci * 128;
    const int sample = t0 >= TP, b = sample ? (t0 - TP) >> 11 : t0 >> 8, l0 = sample ? (t0 - TP) & 2047 : t0 & 255, L = sample ? 2048 : 256;
    const int cis = l0 >> 7, nch = L >> 7, cbase = ci - cis;
    LAS bf16_t* X = (LAS bf16_t*)lds;
    u32x4 wfr[4], wfi[4];
    {
        const bf16_t* Wr0 = LRUW + ((((size_t)j * 2 + 0) * 2 + 0) * 8 + kblk) * 16384 + (size_t)(wave * 16 + r) * 128 + 8 * kq;
        const bf16_t* Wi0 = LRUW + ((((size_t)j * 2 + 0) * 2 + 1) * 8 + kblk) * 16384 + (size_t)(wave * 16 + r) * 128 + 8 * kq;
#pragma unroll
        for (int ks = 0; ks < 4; ++ks) { wfr[ks] = *(const u32x4*)(Wr0 + 32 * ks); wfi[ks] = *(const u32x4*)(Wi0 + 32 * ks); }
    }
    f32x4 pbr[2], pbi[2], plam[2];
    { const int C0_ = kblk * 128 + wave * 16 + 4 * kq;
#pragma unroll
      for (int d = 0; d < 2; ++d) { pbr[d] = *(const f32x4*)(A.in[14] + ((size_t)j * 2 + d) * 1024 + C0_); pbi[d] = *(const f32x4*)(A.in[16] + ((size_t)j * 2 + d) * 1024 + C0_); plam[d] = *(const f32x4*)(A.in[17] + ((size_t)j * 2 + d) * 1024 + C0_); } }
    WG_SYNC();
    {
        const int oct = tid & 15, tb = tid >> 4, ch0 = kblk * 128 + oct * 8;
        float cw[4][8], cb[8];
#pragma unroll
        for (int tp = 0; tp < 4; ++tp) { const f32x4 a = *(const f32x4*)(A.in[11] + ((size_t)j * 4 + tp) * 1024 + ch0), c = *(const f32x4*)(A.in[11] + ((size_t)j * 4 + tp) * 1024 + ch0 + 4);
            cw[tp][0] = a[0]; cw[tp][1] = a[1]; cw[tp][2] = a[2]; cw[tp][3] = a[3]; cw[tp][4] = c[0]; cw[tp][5] = c[1]; cw[tp][6] = c[2]; cw[tp][7] = c[3]; }
        { const f32x4 a = *(const f32x4*)(A.in[12] + (size_t)j * 1024 + ch0), c = *(const f32x4*)(A.in[12] + (size_t)j * 1024 + ch0 + 4);
            cb[0] = a[0]; cb[1] = a[1]; cb[2] = a[2]; cb[3] = a[3]; cb[4] = c[0]; cb[5] = c[1]; cb[6] = c[2]; cb[7] = c[3]; }
#pragma unroll
        for (int it = 0; it < 4; ++it) {
            const int tok = tb + 32 * it, l = l0 + tok;
            float o[8];
#pragma unroll
            for (int i = 0; i < 8; ++i) o[i] = cb[i];
#pragma unroll
            for (int tp = 0; tp < 4; ++tp) { const int ll = l - 2 + tp;
                if (ll >= 0 && ll < L) { float x[8]; unpack8(*(const u32x4*)(U5 + (size_t)(t0 + tok - 2 + tp) * 5120 + 1024 + ch0), x);
#pragma unroll
                    for (int i = 0; i < 8; ++i) o[i] += x[i] * cw[tp][i]; } }
            *(LAS u32x4*)(X + tok * 136 + oct * 8) = pack8(o);
        }
    }
    WG_SYNC();
    const int chl = wave * 16 + 4 * kq, C0 = kblk * 128 + chl;
    float hsum[8][4];
#pragma unroll
    for (int nt = 0; nt < 8; ++nt)
#pragma unroll
        for (int e = 0; e < 4; ++e) hsum[nt][e] = 0.f;
#pragma unroll
    for (int d = 0; d < 2; ++d) {
        f32x4 ar[8], ai[8];
#pragma unroll
        for (int nt = 0; nt < 8; ++nt) { ar[nt] = (f32x4){0.f, 0.f, 0.f, 0.f}; ai[nt] = (f32x4){0.f, 0.f, 0.f, 0.f}; }
#pragma unroll
        for (int ks = 0; ks < 4; ++ks) {
            const bf16x8 fr_ = as_bf16x8(wfr[ks]), fi_ = as_bf16x8(wfi[ks]);
#pragma unroll
            for (int nt = 0; nt < 8; ++nt) { const bf16x8 fb = *(const LAS bf16x8*)(X + (16 * nt + r) * 136 + 32 * ks + 8 * kq);
                ar[nt] = MFMA16(fr_, fb, ar[nt]); ai[nt] = MFMA16(fi_, fb, ai[nt]); }
        }
        if (d == 0) {
            const bf16_t* Wr1 = LRUW + ((((size_t)j * 2 + 1) * 2 + 0) * 8 + kblk) * 16384 + (size_t)(wave * 16 + r) * 128 + 8 * kq;
            const bf16_t* Wi1 = LRUW + ((((size_t)j * 2 + 1) * 2 + 1) * 8 + kblk) * 16384 + (size_t)(wave * 16 + r) * 128 + 8 * kq;
#pragma unroll
            for (int ks = 0; ks < 4; ++ks) { wfr[ks] = *(const u32x4*)(Wr1 + 32 * ks); wfi[ks] = *(const u32x4*)(Wi1 + 32 * ks); }
        }
        float br[4], bi[4], sp[4];
#pragma unroll
        for (int e = 0; e < 4; ++e) { br[e] = pbr[d][e]; bi[e] = pbi[d][e]; sp[e] = fsoftplus(-plam[d][e]); }
#pragma unroll
        for (int nt = 0; nt < 8; ++nt) {
            const u32x2 xv = *(const LAS u32x2*)(X + (16 * nt + r) * 136 + chl);
            const float xc[4] = {bflo(xv.x), bfhi(xv.x), bflo(xv.y), bfhi(xv.y)};
#pragma unroll
            for (int e = 0; e < 4; ++e) {
                const float rr = fsigmoid(ar[nt][e] + br[e]), gi = fsigmoid(ai[nt][e] + bi[e]);
                const float la = -8.0f * rr * sp[e];
                const float av = fexp(la);
                const float t2 = 2.0f * la; const float om = t2 > -0.03f ? -t2 * (1.0f + t2 * (0.5f + t2 * (0.16666667f + t2 * 0.041666668f))) : 1.0f - av * av;
                const float bt = __builtin_amdgcn_sqrtf(om) * gi * xc[e];
                ar[nt][e] = av; ai[nt][e] = bt;
            }
            __builtin_amdgcn_sched_barrier(0);
        }
#pragma unroll
        for (int nt = 0; nt < 8; ++nt)
#pragma unroll
            for (int e = 0; e < 4; ++e) {
                float Av = ar[nt][e], Bv = ai[nt][e];
#define LRU_STEP(DL) do { \
                    if (d == 0) { const float Ap = dpp_row_shr<DL>(Av), Bp = dpp_row_shr<DL>(Bv); if (r >= DL) { Bv = Av * Bp + Bv; Av = Av * Ap; } } \
                    else        { const float An = dpp_row_shl<DL>(Av), Bn = dpp_row_shl<DL>(Bv); if (r + DL < 16) { Bv = Av * Bn + Bv; Av = Av * An; } } } while (0)
                LRU_STEP(1); LRU_STEP(2); LRU_STEP(4); LRU_STEP(8);
#undef LRU_STEP
                ar[nt][e] = Av; ai[nt][e] = Bv;
                if (e & 1) __builtin_amdgcn_sched_barrier(0);
            }
        if (PASS == 1) {
#pragma unroll
            for (int e = 0; e < 4; ++e) {
                float P = 1.f, E = 0.f;
#pragma unroll
                for (int q = 0; q < 8; ++q) { const int nt = d == 0 ? q : 7 - q; const int sl = d == 0 ? 15 : 0;
                    const float At = __shfl(ar[nt][e], sl, 16), Bt = __shfl(ai[nt][e], sl, 16);
                    E = At * E + Bt; P = P * At; }
                if (r == 0) CHS[((size_t)ci * 2 + d) * 1024 + C0 + e] = (f32x2){P, E};
            }
        } else {
#pragma unroll
            for (int e = 0; e < 4; ++e) {
                float h = sample ? A.in[5][(((size_t)b * 2 + j) * 2 + d) * 1024 + C0 + e] : 0.f;
                if (d == 0) { for (int cj = 0; cj < cis; ++cj) { const f32x2 pe = CHS[((size_t)(cbase + cj) * 2 + 0) * 1024 + C0 + e]; h = pe.x * h + pe.y; } }
                else        { for (int cj = nch - 1; cj > cis; --cj) { const f32x2 pe = CHS[((size_t)(cbase + cj) * 2 + 1) * 1024 + C0 + e]; h = pe.x * h + pe.y; } }
#pragma unroll
                for (int q = 0; q < 8; ++q) { const int nt = d == 0 ? q : 7 - q; const int sl = d == 0 ? 15 : 0;
                    const float hv = ar[nt][e] * h + ai[nt][e];
                    hsum[nt][e] += hv;
                    h = __shfl(hv, sl, 16); }
                if (!sample && r == 0) {
                    if (d == 0 && cis == nch - 1) A.out[OUT_LRU + (((size_t)b * 2 + j) * 2 + 0) * 1024 + C0 + e] = h;
                    if (d == 1 && cis == 0)       A.out[OUT_LRU + (((size_t)b * 2 + j) * 2 + 1) * 1024 + C0 + e] = h;
                }
            }
        }
    }
    if (PASS == 2) {
        bf16_t* MIX = (bf16_t*)(ws + WS_MIXE);
#pragma unroll
        for (int nt = 0; nt < 8; ++nt) { const int t = t0 + 16 * nt + r;
            const u32x2 gv = *(const u32x2*)(U5 + (size_t)t * 5120 + C0);
            const float g[4] = {bflo(gv.x), bfhi(gv.x), bflo(gv.y), bfhi(gv.y)};
            u32x2 o; o.x = pk2(hsum[nt][0] * fgelu_tanh(g[0]), hsum[nt][1] * fgelu_tanh(g[1])); o.y = pk2(hsum[nt][2] * fgelu_tanh(g[2]), hsum[nt][3] * fgelu_tanh(g[3]));
            *(u32x2*)(MIX + (size_t)t * 2048 + C0) = o; }
    }
}

__device__ __forceinline__ void attn_unit(const Args& A, LAS unsigned char* lds, int j, int sample, int b, int h, int qb, float lam, float lam_init) {
    const int tid = otid(), lane = tid & 63, wave = tid >> 6, r = lane & 15, kq = lane >> 4;
    unsigned char* ws = A.ws;
    const bf16_t* Qb = (const bf16_t*)(ws + WS_Q); const bf16_t* Kb = (const bf16_t*)(ws + WS_K); const bf16_t* KC = (const bf16_t*)(ws + WS_KC);
    const int L = sample ? 2048 : 256, Lk = sample ? 2304 : 256;
    const int tbase = sample ? TP + b * 2048 : b * 256;
    const bf16_t* VT = sample ? (const bf16_t*)(ws + WS_VTS) + (((size_t)b * 8 + h) * 128) * 2304 : (const bf16_t*)(ws + WS_VTP) + (((size_t)b * 8 + h) * 128) * 256;
    const int m = wave >> 2, qs = (wave & 3) * 32, q0 = tbase + qb * 128 + qs;
    constexpr int KT_BYTES = 64 * 136 * 2, VT_BYTES = 128 * 72 * 2;
    bf16x8 qf[2][2];
#pragma unroll
    for (int qt = 0; qt < 2; ++qt)
#pragma unroll
        for (int ks = 0; ks < 2; ++ks) qf[qt][ks] = as_bf16x8(*(const u32x4*)(Qb + (size_t)(q0 + 16 * qt + r) * 1024 + h * 128 + m * 64 + 32 * ks + 8 * kq));
    f32x4 o[8][2];
#pragma unroll
    for (int dt = 0; dt < 8; ++dt) { o[dt][0] = (f32x4){0.f, 0.f, 0.f, 0.f}; o[dt][1] = (f32x4){0.f, 0.f, 0.f, 0.f}; }
    float mrun[2] = {-1e30f, -1e30f}, lrun[2] = {0.f, 0.f};
    const int nkt = Lk >> 6;
    u32x4 pk_[2], pv_[2];
#define ATT_LOAD(kt_) do { const int key0_ = (kt_) * 64; \
        _Pragma("unroll") for (int i_ = 0; i_ < 2; ++i_) { const int p_ = tid + 512 * i_; \
            { const int row_ = p_ >> 4, pc_ = p_ & 15, key_ = key0_ + row_; \
              const bf16_t* s_ = key_ < L ? Kb + (size_t)(tbase + key_) * 1024 + h * 128 + pc_ * 8 : KC + ((size_t)b * 256 + (key_ - 2048)) * 1024 + h * 128 + pc_ * 8; \
              pk_[i_] = *(const u32x4*)s_; } \
            { const int row_ = p_ >> 3, pc_ = p_ & 7; pv_[i_] = *(const u32x4*)(VT + (size_t)row_ * Lk + key0_ + pc_ * 8); } } } while (0)
#define ATT_STORE(buf_) do { LAS unsigned char* kb_ = lds + (buf_) * KT_BYTES; LAS unsigned char* vb_ = lds + 2 * KT_BYTES + (buf_) * VT_BYTES; \
        _Pragma("unroll") for (int i_ = 0; i_ < 2; ++i_) { const int p_ = tid + 512 * i_; \
            *(LAS u32x4*)(kb_ + ((p_ >> 4) * 136 + (p_ & 15) * 8) * 2) = pk_[i_]; \
            *(LAS u32x4*)(vb_ + ((p_ >> 3) * 72 + (p_ & 7) * 8) * 2) = pv_[i_]; } } while (0)
    WG_SYNC();
    ATT_LOAD(0); ATT_STORE(0);
    WG_SYNC();
    for (int kt = 0; kt < nkt; ++kt) {
        if (kt + 1 < nkt) ATT_LOAD(kt + 1);
        const LAS bf16_t* Kl = (const LAS bf16_t*)(lds + (kt & 1) * KT_BYTES);
        const LAS bf16_t* Vl = (const LAS bf16_t*)(lds + 2 * KT_BYTES + (kt & 1) * VT_BYTES);
        f32x4 s[4][2];
#pragma unroll
        for (int t = 0; t < 4; ++t) { s[t][0] = (f32x4){0.f, 0.f, 0.f, 0.f}; s[t][1] = (f32x4){0.f, 0.f, 0.f, 0.f}; }
#pragma unroll
        for (int ks = 0; ks < 2; ++ks)
#pragma unroll
            for (int t = 0; t < 4; ++t) { const bf16x8 ka = *(const LAS bf16x8*)(Kl + (16 * t + r) * 136 + m * 64 + 32 * ks + 8 * kq);
                s[t][0] = MFMA16(ka, qf[0][ks], s[t][0]); s[t][1] = MFMA16(ka, qf[1][ks], s[t][1]); }
        bf16x8 pf[2][2];
#pragma unroll
        for (int qt = 0; qt < 2; ++qt) {
            float mx = s[0][qt][0];
#pragma unroll
            for (int t = 0; t < 4; ++t)
#pragma unroll
                for (int e = 0; e < 4; ++e) mx = fmaxf(mx, s[t][qt][e]);
            mx = fmaxf(mx, __shfl_xor(mx, 16)); mx = fmaxf(mx, __shfl_xor(mx, 32));
            const float mnew = fmaxf(mrun[qt], mx), alpha = __builtin_amdgcn_exp2f(mrun[qt] - mnew);
            mrun[qt] = mnew;
            float ps = 0.f;
#pragma unroll
            for (int t = 0; t < 4; ++t)
#pragma unroll
                for (int e = 0; e < 4; ++e) { const float p = __builtin_amdgcn_exp2f(s[t][qt][e] - mnew); s[t][qt][e] = p; ps += p; }
            lrun[qt] = lrun[qt] * alpha + ps;
#pragma unroll
            for (int dt = 0; dt < 8; ++dt) o[dt][qt] = o[dt][qt] * alpha;
#pragma unroll
            for (int blk = 0; blk < 2; ++blk) { u32x4 w; w.x = pk2(s[2 * blk][qt][0], s[2 * blk][qt][1]); w.y = pk2(s[2 * blk][qt][2], s[2 * blk][qt][3]);
                w.z = pk2(s[2 * blk + 1][qt][0], s[2 * blk + 1][qt][1]); w.w = pk2(s[2 * blk + 1][qt][2], s[2 * blk + 1][qt][3]); pf[blk][qt] = as_bf16x8(w); }
        }
#pragma unroll
        for (int blk = 0; blk < 2; ++blk)
#pragma unroll
            for (int dt = 0; dt < 8; ++dt) {
                const u32x2 v0 = *(const LAS u32x2*)(Vl + (16 * dt + r) * 72 + 32 * blk + 4 * kq), v1 = *(const LAS u32x2*)(Vl + (16 * dt + r) * 72 + 32 * blk + 16 + 4 * kq);
                const bf16x8 va = as_bf16x8((u32x4){v0.x, v0.y, v1.x, v1.y});
                o[dt][0] = MFMA16(va, pf[blk][0], o[dt][0]); o[dt][1] = MFMA16(va, pf[blk][1], o[dt][1]); }
        if (kt + 1 < nkt) ATT_STORE((kt + 1) & 1);
        WG_SYNC();
    }
#undef ATT_LOAD
#undef ATT_STORE
#pragma unroll
    for (int qt = 0; qt < 2; ++qt) { float l = lrun[qt]; l += __shfl_xor(l, 16); l += __shfl_xor(l, 32); const float inv = 1.0f / l;
#pragma unroll
        for (int dt = 0; dt < 8; ++dt) o[dt][qt] = o[dt][qt] * inv; }
    LAS f32x4* ex = (LAS f32x4*)lds;
    if (m == 1) {
#pragma unroll
        for (int dt = 0; dt < 8; ++dt) { ex[((wave & 3) * 16 + dt * 2 + 0) * 64 + lane] = o[dt][0]; ex[((wave & 3) * 16 + dt * 2 + 1) * 64 + lane] = o[dt][1]; }
    }
    WG_SYNC();
    if (m == 0) {
        bf16_t* MIX = (bf16_t*)(ws + WS_MIXE);
        const float* subln = A.in[23] + (size_t)j * 128;
        float ss[2] = {0.f, 0.f};
#pragma unroll
        for (int dt = 0; dt < 8; ++dt)
#pragma unroll
            for (int qt = 0; qt < 2; ++qt) { const f32x4 o1 = ex[((wave & 3) * 16 + dt * 2 + qt) * 64 + lane]; o[dt][qt] = o[dt][qt] - o1 * lam;
                ss[qt] += (o[dt][qt][0] * o[dt][qt][0] + o[dt][qt][1] * o[dt][qt][1]) + (o[dt][qt][2] * o[dt][qt][2] + o[dt][qt][3] * o[dt][qt][3]); }
#pragma unroll
        for (int qt = 0; qt < 2; ++qt) { float v = ss[qt]; v += __shfl_xor(v, 16); v += __shfl_xor(v, 32); const float rstd = (1.0f - lam_init) / sqrtf(v * (1.f / 128.f) + EPS);
#pragma unroll
            for (int dt = 0; dt < 8; ++dt) { const f32x4 g = *(const f32x4*)(subln + 16 * dt + 4 * kq); const f32x4 v4 = o[dt][qt] * rstd * g;
                u32x2 w; w.x = pk2(v4[0], v4[1]); w.y = pk2(v4[2], v4[3]);
                *(u32x2*)(MIX + (size_t)(q0 + 16 * qt + r) * 2048 + 1024 + h * 128 + 16 * dt + 4 * kq) = w; } }
    }
}

__device__ __forceinline__ void phase_even_mix1(const Args& A, LAS unsigned char* lds, int j) {
    phase_qkv_prep(A, lds, j);
    for (int rep_ = 0; rep_ < ((DBG_TWICE & 4096) ? 2 : 1); ++rep_)
    for (int u = blockIdx.x; u < 1280; u += gridDim.x) lru_unit<1>(A, lds, j, u >> 3, u & 7);
}
__device__ __forceinline__ void phase_even_mix2(const Args& A, LAS unsigned char* lds, int j, int layer) {
    float lam;
    { const float* dl = A.in[22] + (size_t)j * 256; float s0 = 0.f, s1 = 0.f;
      for (int i = 0; i < 64; ++i) { s0 += dl[i] * dl[64 + i]; s1 += dl[128 + i] * dl[192 + i]; }
      const float lam_init = 0.8f - 0.6f * expf(-0.3f * (float)layer); lam = expf(s0) - expf(s1) + lam_init;
      for (int u = blockIdx.x; u < 1024 + 256; u += gridDim.x) {
          if (u < 1024) attn_unit(A, lds, j, 1, u >> 7, (u >> 4) & 7, u & 15, lam, lam_init);
          else { const int v = u - 1024; attn_unit(A, lds, j, 0, v >> 4, (v >> 1) & 7, v & 1, lam, lam_init); }
      }
    }
    for (int u = blockIdx.x; u < 1280; u += gridDim.x) lru_unit<2>(A, lds, j, u >> 3, u & 7);
}

__device__ __forceinline__ void phase_ssd_prep(const Args& A, LAS unsigned char* lds, int j) {
    const int tid = otid(), wave = tid >> 6;
    unsigned char* ws = A.ws;
    const bf16_t* XBC = (const bf16_t*)(ws + WS_XBC);
    bf16_t* XT = (bf16_t*)(ws + WS_XT); bf16_t* BN = (bf16_t*)(ws + WS_BN); bf16_t* BT = (bf16_t*)(ws + WS_BT); bf16_t* CN = (bf16_t*)(ws + WS_CN);
    LAS bf16_t* Tl = (LAS bf16_t*)lds;
    for (int u = blockIdx.x; u < 320 * 12; u += gridDim.x) {
        const int slab = u / 12, cb = u - slab * 12, t0 = slab * 64;
        const int sample = t0 >= TP, l0 = sample ? (t0 - TP) & 2047 : t0 & 255, L = sample ? 2048 : 256;
        const int co = tid & 63, ch = cb * 512 + co * 8;
        float cw[4][8], cbias[8];
#pragma unroll
        for (int tp = 0; tp < 4; ++tp) { const f32x4 a = *(const f32x4*)(A.in[25] + ((size_t)j * 4 + tp) * 6144 + ch), c = *(const f32x4*)(A.in[25] + ((size_t)j * 4 + tp) * 6144 + ch + 4);
            cw[tp][0] = a[0]; cw[tp][1] = a[1]; cw[tp][2] = a[2]; cw[tp][3] = a[3]; cw[tp][4] = c[0]; cw[tp][5] = c[1]; cw[tp][6] = c[2]; cw[tp][7] = c[3]; }
        { const f32x4 a = *(const f32x4*)(A.in[26] + (size_t)j * 6144 + ch), c = *(const f32x4*)(A.in[26] + (size_t)j * 6144 + ch + 4);
            cbias[0] = a[0]; cbias[1] = a[1]; cbias[2] = a[2]; cbias[3] = a[3]; cbias[4] = c[0]; cbias[5] = c[1]; cbias[6] = c[2]; cbias[7] = c[3]; }
        WG_SYNC();
#pragma unroll
        for (int it = 0; it < 4; ++it) {
            const int tp0 = 2 * (wave + 8 * it);
            float xr[5][8];
#pragma unroll
            for (int rr = 0; rr < 5; ++rr) { const int ll = l0 + tp0 - 2 + rr;
                if (ll >= 0 && ll < L) unpack8(*(const u32x4*)(XBC + (size_t)(t0 + tp0 - 2 + rr) * 6144 + ch), xr[rr]);
                else {
#pragma unroll
                    for (int i = 0; i < 8; ++i) xr[rr][i] = 0.f; } }
#pragma unroll
            for (int tk = 0; tk < 2; ++tk) {
                float o[8];
#pragma unroll
                for (int i = 0; i < 8; ++i) { float v = cbias[i];
#pragma unroll
                    for (int tp = 0; tp < 4; ++tp) v += xr[tk + tp][i] * cw[tp][i];
                    o[i] = fsilu(v); }
                const u32x4 pk = pack8(o);
                const int tok = tp0 + tk;
                if (cb >= 8) { bf16_t* dst = (cb < 10 ? BN + (size_t)(t0 + tok) * 1024 + (cb - 8) * 512 : CN + (size_t)(t0 + tok) * 1024 + (cb - 10) * 512) + co * 8; *(u32x4*)dst = pk; }
                if (cb < 10) *(LAS u32x4*)(Tl + tok * 520 + co * 8) = pk;
            }
        }
        if (cb < 10) {
            WG_SYNC();
            const int tile = t0 >> 8, so = t0 & 255;
#pragma unroll
            for (int i = 0; i < 8; ++i) { const int p = tid + 512 * i, c = p & 511, tg = p >> 9;
                unsigned short e[8];
#pragma unroll
                for (int k = 0; k < 8; ++k) e[k] = Tl[(8 * tg + k) * 520 + c];
                u32x4 v; v.x = e[0] | ((unsigned)e[1] << 16); v.y = e[2] | ((unsigned)e[3] << 16); v.z = e[4] | ((unsigned)e[5] << 16); v.w = e[6] | ((unsigned)e[7] << 16);
                bf16_t* dst;
                if (cb < 8) { const int cg = cb * 512 + c; dst = XT + (((size_t)tile * 64 + (cg >> 6)) * 64 + (cg & 63)) * 256 + so + 8 * tg; }
                else { const int cg = (cb - 8) * 512 + c; dst = BT + (((size_t)tile * 8 + (cg >> 7)) * 128 + (cg & 127)) * 256 + so + 8 * tg; }
                *(u32x4*)dst = v; }
        }
    }
}

template <int NV>
__device__ __forceinline__ void scan256(float (&v)[NV], LAS float* wtot, int lane, int wave_in_grp, float (&tot)[NV]) {
#pragma unroll
    for (int dl = 1; dl < 64; dl <<= 1) {
#pragma unroll
        for (int k = 0; k < NV; ++k) { const float up = __shfl_up(v[k], dl, 64); if (lane >= dl) v[k] += up; }
    }
    if (lane == 63) {
#pragma unroll
        for (int k = 0; k < NV; ++k) wtot[wave_in_grp * NV + k] = v[k];
    }
    WG_SYNC();
#pragma unroll
    for (int k = 0; k < NV; ++k) { float pre = 0.f, all = 0.f;
#pragma unroll
        for (int w = 0; w < 4; ++w) { const float x = wtot[w * NV + k]; all += x; if (w < wave_in_grp) pre += x; }
        v[k] += pre; tot[k] = all; }
}

__device__ __forceinline__ void phase_ssd_state(const Args& A, LAS unsigned char* lds, int j) {
    const int tid = otid(), lane = tid & 63, wave = tid >> 6, r = lane & 15, kq = lane >> 4;
    unsigned char* ws = A.ws;
    const bf16_t* XT = (const bf16_t*)(ws + WS_XT); const bf16_t* BT = (const bf16_t*)(ws + WS_BT);
    const float* DTRAW = (const float*)(ws + WS_DTRAW);
    bf16_t* SIN = (bf16_t*)(ws + WS_SIN);
    LAS bf16_t* Bl = (LAS bf16_t*)lds;
    LAS bf16_t* Xl = (LAS bf16_t*)(lds + 67584);
    LAS float* Wl = (LAS float*)(lds + 67584 + 33792);
    LAS float* TOT = Wl + 1024;
    LAS float* WT_ = TOT + 16;
    const int pt = wave & 3, nh = wave >> 2;
    for (int u = blockIdx.x; u < 256 + 512; u += gridDim.x) {
        const int sample = u < 256, v = sample ? u : u - 256;
        const int b = v >> 5, g = (v >> 2) & 7, dir = (v >> 1) & 1, half = v & 1;
        const int tile0 = sample ? 16 + b * 8 : b, ntile = sample ? 8 : 1;
        const int h0 = g * 8 + half * 4;
        f32x4 acc[4][4];
#pragma unroll
        for (int hh = 0; hh < 4; ++hh)
#pragma unroll
            for (int nt = 0; nt < 4; ++nt) {
                if (sample) {
#pragma unroll
                    for (int e = 0; e < 4; ++e) acc[hh][nt][e] = A.in[6][((((size_t)b * 2 + j) * 2 + dir) * 64 + h0 + hh) * 8192 + (size_t)(16 * pt + 4 * kq + e) * 128 + 16 * (nh * 4 + nt) + r];
                } else acc[hh][nt] = (f32x4){0.f, 0.f, 0.f, 0.f};
            }
        float adec[4], dtb[4];
#pragma unroll
        for (int hh = 0; hh < 4; ++hh) { adec[hh] = -expf(A.in[28][((size_t)j * 2 + dir) * 64 + h0 + hh]); dtb[hh] = A.in[27][((size_t)j * 2 + dir) * 64 + h0 + hh]; }
        for (int st = 0; st < ntile; ++st) {
            const int c = dir == 0 ? st : ntile - 1 - st, tile = tile0 + c;
            WG_SYNC();
            if (sample) {
                LAS bf16_t* St = (LAS bf16_t*)lds;
#pragma unroll
                for (int hh = 0; hh < 4; ++hh)
#pragma unroll
                    for (int nt = 0; nt < 4; ++nt)
#pragma unroll
                        for (int e = 0; e < 4; ++e)
                            St[(hh * 64 + 16 * pt + 4 * kq + e) * 136 + 16 * (nh * 4 + nt) + r] = (bf16_t)(pk2(acc[hh][nt][e], 0.f) & 0xffffu);
                WG_SYNC();
#pragma unroll
                for (int i = 0; i < 8; ++i) { const int p = tid + 512 * i, hh = p >> 10, row = (p >> 4) & 63, pc = p & 15;
                    *(u32x4*)(SIN + ((((size_t)(tile - 16) * 2 + dir) * 64 + h0 + hh) * 64 + row) * 128 + pc * 8) = *(const LAS u32x4*)(St + (hh * 64 + row) * 136 + pc * 8); }
                if (st == ntile - 1) break;
                WG_SYNC();
            }
            {
                float val[4], dtv[4], tot[4];
                if (tid < 256) {
#pragma unroll
                    for (int hh = 0; hh < 4; ++hh) { dtv[hh] = fsoftplus(DTRAW[(size_t)(tile * 256 + tid) * 128 + dir * 64 + h0 + hh] + dtb[hh]); val[hh] = adec[hh] * dtv[hh]; }
                } else {
#pragma unroll
                    for (int hh = 0; hh < 4; ++hh) { dtv[hh] = 0.f; val[hh] = 0.f; }
                }
                float adt[4];
#pragma unroll
                for (int hh = 0; hh < 4; ++hh) adt[hh] = val[hh];
                scan256<4>(val, WT_ + (tid < 256 ? 0 : 16), lane, wave & 3, tot);
                if (tid < 256) {
#pragma unroll
                    for (int hh = 0; hh < 4; ++hh) { const float w = dir == 0 ? fexp(tot[hh] - val[hh]) * dtv[hh] : fexp(val[hh] - adt[hh]) * dtv[hh]; Wl[hh * 256 + tid] = w; }
                    if (tid == 0) {
#pragma unroll
                        for (int hh = 0; hh < 4; ++hh) TOT[hh] = tot[hh];
                    }
                }
            }
#pragma unroll
            for (int i = 0; i < 8; ++i) { const int p = tid + 512 * i, row = p >> 5, pc = p & 31;
                *(LAS u32x4*)(Bl + row * 264 + pc * 8) = *(const u32x4*)(BT + (((size_t)tile * 8 + g) * 128 + row) * 256 + pc * 8); }
            u32x4 px[4];
#pragma unroll
            for (int i = 0; i < 4; ++i) { const int p = tid + 512 * i, row = p >> 5, pc = p & 31; px[i] = *(const u32x4*)(XT + (((size_t)tile * 64 + h0) * 64 + row) * 256 + pc * 8); }
#pragma unroll
            for (int hh = 0; hh < 4; ++hh) {
                WG_SYNC();
#pragma unroll
                for (int i = 0; i < 4; ++i) { const int p = tid + 512 * i, row = p >> 5, pc = p & 31;
                    float x[8]; unpack8(px[i], x);
                    if (hh < 3) px[i] = *(const u32x4*)(XT + (((size_t)tile * 64 + h0 + hh + 1) * 64 + row) * 256 + pc * 8);
                    const f32x4 w0 = *(const LAS f32x4*)(Wl + hh * 256 + pc * 8), w1 = *(const LAS f32x4*)(Wl + hh * 256 + pc * 8 + 4);
                    x[0] *= w0[0]; x[1] *= w0[1]; x[2] *= w0[2]; x[3] *= w0[3]; x[4] *= w1[0]; x[5] *= w1[1]; x[6] *= w1[2]; x[7] *= w1[3];
                    *(LAS u32x4*)(Xl + row * 264 + pc * 8) = pack8(x); }
                WG_SYNC();
                const float dec = fexp(TOT[hh]);
#pragma unroll
                for (int nt = 0; nt < 4; ++nt) acc[hh][nt] = acc[hh][nt] * dec;
#pragma unroll
                for (int ks = 0; ks < 8; ++ks) { const bf16x8 fa = *(const LAS bf16x8*)(Xl + (16 * pt + r) * 264 + 32 * ks + 8 * kq);
#pragma unroll
                    for (int nt = 0; nt < 4; ++nt) { const bf16x8 fb = *(const LAS bf16x8*)(Bl + (16 * (nh * 4 + nt) + r) * 264 + 32 * ks + 8 * kq);
                        acc[hh][nt] = MFMA16(fa, fb, acc[hh][nt]); } }
            }
        }
        if (!sample) {
#pragma unroll
            for (int hh = 0; hh < 4; ++hh)
#pragma unroll
                for (int nt = 0; nt < 4; ++nt)
#pragma unroll
                    for (int e = 0; e < 4; ++e)
                        A.out[OUT_SSD + ((((size_t)b * 2 + j) * 2 + dir) * 64 + h0 + hh) * 8192 + (size_t)(16 * pt + 4 * kq + e) * 128 + 16 * (nh * 4 + nt) + r] = acc[hh][nt][e];
        }
    }
}

__device__ __forceinline__ void phase_ssd_out(const Args& A, LAS unsigned char* lds, int j) {
    const int tid = otid(), lane = tid & 63, wave = tid >> 6, r = lane & 15, kq = lane >> 4;
    unsigned char* ws = A.ws;
    const bf16_t* XT = (const bf16_t*)(ws + WS_XT); const bf16_t* BN = (const bf16_t*)(ws + WS_BN); const bf16_t* CN = (const bf16_t*)(ws + WS_CN);
    const bf16_t* Z = (const bf16_t*)(ws + WS_Z); const float* DTRAW = (const float*)(ws + WS_DTRAW); const bf16_t* SIN = (const bf16_t*)(ws + WS_SIN);
    bf16_t* MIX = (bf16_t*)(ws + WS_MIXO);
    LAS float* PF = (LAS float*)lds;
    LAS float* DTF = PF + 2048;
    LAS float* EB = DTF + 2048;
    LAS float* DTB = EB + 2048;
    LAS float* TOTB = (LAS float*)(lds + LDS_MISC + 256);
    LAS float* WT_ = (LAS float*)(lds + LDS_MISC + 320);
    LAS bf16_t* Bl = (LAS bf16_t*)(lds + 32768);
    LAS bf16_t* Xl = (LAS bf16_t*)(lds + 32768);
    LAS bf16_t* Sl = (LAS bf16_t*)(lds + 32768 + 33792);
    for (int u = blockIdx.x; u < 160 * 8; u += gridDim.x) {
        const int rt = u >> 3, g = u & 7, tile = rt >> 1, half = rt & 1;
        const int sample = tile >= 16;
        const int l_loc = half * 128 + wave * 16 + r;
        const size_t tk = (size_t)tile * 256 + l_loc;
        WG_SYNC();
        {
            const int dir = tid >> 8, s = tid & 255;
            float val[8], dtv[8], tot[8], adt[8];
#pragma unroll
            for (int h8 = 0; h8 < 8; ++h8) { const int h = g * 8 + h8;
                dtv[h8] = fsoftplus(DTRAW[((size_t)tile * 256 + s) * 128 + dir * 64 + h] + A.in[27][((size_t)j * 2 + dir) * 64 + h]);
                val[h8] = -expf(A.in[28][((size_t)j * 2 + dir) * 64 + h]) * dtv[h8]; adt[h8] = val[h8]; }
            scan256<8>(val, WT_ + dir * 32, lane, wave & 3, tot);
            if (dir == 0) {
#pragma unroll
                for (int h8 = 0; h8 < 8; ++h8) { PF[h8 * 256 + s] = val[h8]; DTF[h8 * 256 + s] = dtv[h8]; }
            } else {
#pragma unroll
                for (int h8 = 0; h8 < 8; ++h8) { EB[h8 * 256 + s] = val[h8] - adt[h8]; DTB[h8 * 256 + s] = dtv[h8]; }
                if (s == 0) {
#pragma unroll
                    for (int h8 = 0; h8 < 8; ++h8) TOTB[h8] = tot[h8];
                }
            }
        }
#pragma unroll
        for (int i = 0; i < 8; ++i) { const int p = tid + 512 * i, row = p >> 4, pc = p & 15;
            *(LAS u32x4*)(Bl + row * 136 + pc * 8) = *(const u32x4*)(BN + ((size_t)tile * 256 + row) * 1024 + g * 128 + pc * 8); }
        bf16x8 cf[4];
#pragma unroll
        for (int ks = 0; ks < 4; ++ks) cf[ks] = as_bf16x8(*(const u32x4*)(CN + tk * 1024 + g * 128 + 32 * ks + 8 * kq));
        WG_SYNC();
        f32x4 gt[16];
#pragma unroll
        for (int t = 0; t < 16; ++t) gt[t] = (f32x4){0.f, 0.f, 0.f, 0.f};
#pragma unroll
        for (int ks = 0; ks < 4; ++ks)
#pragma unroll
            for (int t = 0; t < 16; ++t) { const bf16x8 fa = *(const LAS bf16x8*)(Bl + (16 * t + r) * 136 + 32 * ks + 8 * kq); gt[t] = MFMA16(fa, cf[ks], gt[t]); }
        float ssq = 0.f;
        u32x4 pfx[4], pfs[4];
#define SSDO_PREFETCH(HH) do { const int tidp = otid(); \
            _Pragma("unroll") for (int i = 0; i < 4; ++i) { const int p = tidp + 512 * i; \
                pfx[i] = *(const u32x4*)(XT + (((size_t)tile * 64 + g * 8 + (HH)) * 64 + (p >> 5)) * 256 + (p & 31) * 8); \
                if (sample) pfs[i] = *(const u32x4*)(SIN + ((((size_t)(tile - 16) * 2 + (p >> 10)) * 64 + g * 8 + (HH)) * 64 + ((p >> 4) & 63)) * 128 + (p & 15) * 8); } } while (0)
        SSDO_PREFETCH(0);
#pragma unroll 1
        for (int h8 = 0; h8 < 8; ++h8) {
            const int h = g * 8 + h8;
            const int tid = otid(), lane = tid & 63, wave = __builtin_amdgcn_readfirstlane(tid >> 6), r = lane & 15, kq = lane >> 4;
            const int l_loc = half * 128 + wave * 16 + r; const size_t tk = (size_t)tile * 256 + l_loc; const int tdiag = half * 8 + wave;
            WG_SYNC();
#pragma unroll
            for (int i = 0; i < 4; ++i) { const int p = tid + 512 * i, row = p >> 5, pc = p & 31;
                *(LAS u32x4*)(Xl + row * 264 + pc * 8) = pfx[i]; }
            if (sample) {
#pragma unroll
                for (int i = 0; i < 4; ++i) { const int p = tid + 512 * i, dirn = p >> 10, row = (p >> 4) & 63, pc = p & 15;
                    *(LAS u32x4*)(Sl + (dirn * 64 + row) * 136 + pc * 8) = pfs[i]; }
            }
            if (h8 < 7) SSDO_PREFETCH(h8 + 1);
            WG_SYNC();
            const float pf_l = PF[h8 * 256 + l_loc], eb_l = EB[h8 * 256 + l_loc];
            u32x2 zpre[4];
#pragma unroll
            for (int p4 = 0; p4 < 4; ++p4) zpre[p4] = *(const u32x2*)(Z + tk * 4096 + h * 64 + 16 * p4 + 4 * kq);
            const float dsk = A.in[29][(size_t)j * 64 + h];
            f32x4 y[4];
#pragma unroll
            for (int p4 = 0; p4 < 4; ++p4) y[p4] = (f32x4){0.f, 0.f, 0.f, 0.f};
#pragma unroll
            for (int blk = 0; blk < 8; ++blk) {
                float mv[8];
#pragma unroll
                for (int hf = 0; hf < 2; ++hf) {
                    const int t = 2 * blk + hf, sb = 16 * t + 4 * kq;
                    if (t < tdiag) {
                        const f32x4 ps = *(const LAS f32x4*)(PF + h8 * 256 + sb), ds = *(const LAS f32x4*)(DTF + h8 * 256 + sb);
#pragma unroll
                        for (int e = 0; e < 4; ++e) mv[hf * 4 + e] = gt[t][e] * fexp(pf_l - ps[e]) * ds[e];
                    } else if (t > tdiag) {
                        const f32x4 es = *(const LAS f32x4*)(EB + h8 * 256 + sb), ds = *(const LAS f32x4*)(DTB + h8 * 256 + sb);
#pragma unroll
                        for (int e = 0; e < 4; ++e) mv[hf * 4 + e] = gt[t][e] * fexp(es[e] - eb_l) * ds[e];
                    } else {
                        const f32x4 ps = *(const LAS f32x4*)(PF + h8 * 256 + sb), df = *(const LAS f32x4*)(DTF + h8 * 256 + sb);
                        const f32x4 es = *(const LAS f32x4*)(EB + h8 * 256 + sb), db = *(const LAS f32x4*)(DTB + h8 * 256 + sb);
#pragma unroll
                        for (int e = 0; e < 4; ++e) { const int s = sb + e; float w = 0.f;
                            if (s <= l_loc) w += fexp(fminf(pf_l - ps[e], 0.f)) * df[e];
                            if (s >= l_loc) w += fexp(fminf(es[e] - eb_l, 0.f)) * db[e];
                            mv[hf * 4 + e] = gt[t][e] * w; }
                    }
                }
                const bf16x8 mf = as_bf16x8(pack8(mv));
#pragma unroll
                for (int p4 = 0; p4 < 4; ++p4) {
                    const u32x2 v0 = *(const LAS u32x2*)(Xl + (16 * p4 + r) * 264 + 32 * blk + 4 * kq), v1 = *(const LAS u32x2*)(Xl + (16 * p4 + r) * 264 + 32 * blk + 16 + 4 * kq);
                    y[p4] = MFMA16(as_bf16x8((u32x4){v0.x, v0.y, v1.x, v1.y}), mf, y[p4]); }
                __builtin_amdgcn_sched_barrier(0);
            }
            if (sample) {
#pragma unroll
                for (int dirn = 0; dirn < 2; ++dirn) {
                    f32x4 tmp[4];
#pragma unroll
                    for (int p4 = 0; p4 < 4; ++p4) tmp[p4] = (f32x4){0.f, 0.f, 0.f, 0.f};
#pragma unroll
                    for (int ks = 0; ks < 4; ++ks)
#pragma unroll
                        for (int p4 = 0; p4 < 4; ++p4) { const bf16x8 sa = *(const LAS bf16x8*)(Sl + (dirn * 64 + 16 * p4 + r) * 136 + 32 * ks + 8 * kq); tmp[p4] = MFMA16(sa, cf[ks], tmp[p4]); }
                    const float ev = dirn == 0 ? fexp(pf_l) : fexp(TOTB[h8] - eb_l);
#pragma unroll
                    for (int p4 = 0; p4 < 4; ++p4) y[p4] = y[p4] + tmp[p4] * ev;
                }
            }
#pragma unroll
            for (int p4 = 0; p4 < 4; ++p4) { const int p0 = 16 * p4 + 4 * kq;
                const u32x2 zv = zpre[p4];
                const float zz[4] = {bflo(zv.x), bfhi(zv.x), bflo(zv.y), bfhi(zv.y)};
                float yv[4];
#pragma unroll
                for (int e = 0; e < 4; ++e) { const float xs = bf2f(Xl[(p0 + e) * 264 + l_loc]); yv[e] = (y[p4][e] + dsk * xs) * fsilu(zz[e]); ssq += yv[e] * yv[e]; }
                u32x2 w; w.x = pk2(yv[0], yv[1]); w.y = pk2(yv[2], yv[3]);
                *(u32x2*)(MIX + tk * 4096 + h * 64 + p0) = w; }
        }
        ssq += __shfl_xor(ssq, 16); ssq += __shfl_xor(ssq, 32);
        const float rstd = 1.0f / sqrtf(ssq * (1.f / 512.f) + EPS);
        asm volatile("s_waitcnt vmcnt(0)" ::: "memory");
#pragma unroll 2
        for (int h8 = 0; h8 < 8; ++h8)
#pragma unroll
            for (int p4 = 0; p4 < 4; ++p4) { const int tid2 = otid(), kq2 = (tid2 & 63) >> 4; const size_t tk2 = (size_t)tile * 256 + half * 128 + (tid2 >> 6) * 16 + (tid2 & 15);
                const int cix = (g * 8 + h8) * 64 + 16 * p4 + 4 * kq2;
                unsigned long long* ptr = (unsigned long long*)(MIX + tk2 * 4096 + cix);
                const unsigned long long raw = __hip_atomic_load(ptr, __ATOMIC_RELAXED, __HIP_MEMORY_SCOPE_AGENT);
                const unsigned lo = (unsigned)raw, hi = (unsigned)(raw >> 32);
                const f32x4 nw = *(const f32x4*)(A.in[30] + (size_t)j * 4096 + cix);
                u32x2 w; w.x = pk2(bflo(lo) * rstd * nw[0], bfhi(lo) * rstd * nw[1]); w.y = pk2(bflo(hi) * rstd * nw[2], bfhi(hi) * rstd * nw[3]);
                *(u32x2*)ptr = w; }
    }
#undef SSDO_PREFETCH
}

constexpr int N_PHASE_IDS = 2 + 9 * 4;
#ifndef DBG_TWICE
#define DBG_TWICE 0
#endif
#ifndef MK_ONE_LAUNCH
#define MK_ONE_LAUNCH 1
#endif

__global__ void __launch_bounds__(512, 2) fwd_kernel(Args args) {
    extern __shared__ __attribute__((aligned(16))) unsigned char shm[];
    LAS unsigned char* lds = (LAS unsigned char*)shm;
    const int tid = threadIdx.x;
    unsigned char* ws = args.ws;
    if (tid < 4) ((LAS unsigned*)(lds + LDS_MISC))[tid] = 0u;
    __syncthreads();
    XcdBarrier bar = xcd_barrier_post((unsigned*)(ws + WS_CTL), (volatile LAS unsigned*)(lds + LDS_MISC));
    const int lo = args.ph_lo, hi = args.ph_hi;
    bool need_bar = false;
#define PHASE(id) if (lo <= (id) && (id) < hi && ((need_bar ? (xcd_barrier(bar), 0) : 0), need_bar = true, true))
#define REP(bit) for (int rep_ = 0; rep_ < ((DBG_TWICE & (bit)) ? 2 : 1); ++rep_) if (((rep_ ? (xcd_barrier(bar), 0) : 0), true))
    const float* ADA = (const float*)(ws + WS_ADA);
    bf16_t* H = (bf16_t*)(ws + WS_H);
    const int G = (int)gridDim.x, bx = (int)blockIdx.x;

    PHASE(0) { REP(1) phase_prologue(args, lds); }
    PHASE(1) { REP(2) phase_modulate(args, 0, 0); }
    for (int layer = 0; layer < 4; ++layer) {
        const int pb = 2 + 9 * layer, j = layer >> 1, even = (layer & 1) == 0;
        if (even) {
            PHASE(pb + 0) REP(4) { pg8::Gemm g{H, (const bf16_t*)(ws + WS_WEIN) + (size_t)j * 5120 * 2048, T, 5120, 2048}; pg8::StaticOrder S; S.init(T, 5120, G, bx);
                pg8::EpiStore E{(bf16_t*)(ws + WS_U5), 5120};
                pg8::gemm_phase<pg8::EpiStore, pg8::StaticOrder, true, true>(lds, g, S, E); }
            PHASE(pb + 1) { REP(8) phase_even_mix1(args, lds, j); }
            PHASE(pb + 2) { REP(16) phase_even_mix2(args, lds, j, layer); }
        } else {
            PHASE(pb + 0) REP(32) { pg8::Gemm g{H, (const bf16_t*)(ws + WS_WSIN) + (size_t)j * 10496 * 2048, T, 10496, 2048}; pg8::StaticOrder S; S.init(T, 10496, G, bx);
                pg8::EpiOdd1 E{(bf16_t*)(ws + WS_Z), (bf16_t*)(ws + WS_XBC), (float*)(ws + WS_DTRAW)};
                pg8::gemm_phase<pg8::EpiOdd1, pg8::StaticOrder, true, true>(lds, g, S, E); }
            PHASE(pb + 1) { REP(64) phase_ssd_prep(args, lds, j); }
            PHASE(pb + 2) { REP(128) phase_ssd_state(args, lds, j); }
            PHASE(pb + 3) { REP(256) phase_ssd_out(args, lds, j); }
        }
        PHASE(pb + 4) {
            const bf16_t* Am = even ? (const bf16_t*)(ws + WS_MIXE) : (const bf16_t*)(ws + WS_MIXO);
            const bf16_t* Bm = even ? (const bf16_t*)(ws + WS_WEOUT) + (size_t)j * 2048 * 2048 : (const bf16_t*)(ws + WS_WSOUT) + (size_t)j * 2048 * 4096;
            pg8::Gemm g{Am, Bm, T, 2048, even ? 2048 : 4096}; pg8::StaticOrder S; S.init(T, 2048, G, bx);
            pg8::EpiResid E{args.out, ADA + (size_t)layer * 9 * 12288 + 2 * 2048};
            pg8::gemm_phase<pg8::EpiResid, pg8::StaticOrder, true, true>(lds, g, S, E); }
        PHASE(pb + 5) { REP(2) phase_modulate(args, layer, 1); }
        PHASE(pb + 6) REP(1024) { pg8::Gemm g{H, (const bf16_t*)(ws + WS_WFIN) + (size_t)layer * 11264 * 2048, T, 11264, 2048}; pg8::StaticOrder S; S.init(T, 11264, G, bx);
            pg8::EpiSwiGLU E{(bf16_t*)(ws + WS_HID), 5632};
            pg8::gemm_phase<pg8::EpiSwiGLU, pg8::StaticOrder, true, true>(lds, g, S, E); }
        PHASE(pb + 7) { pg8::Gemm g{(const bf16_t*)(ws + WS_HID), (const bf16_t*)(ws + WS_WFOUT) + (size_t)layer * 2048 * 5632, T, 2048, 5632}; pg8::StaticOrder S; S.init(T, 2048, G, bx);
            pg8::EpiResid E{args.out, ADA + (size_t)layer * 9 * 12288 + 5 * 2048};
            pg8::gemm_phase<pg8::EpiResid, pg8::StaticOrder, true, true>(lds, g, S, E); }
        if (layer < 3) { PHASE(pb + 8) { REP(2) phase_modulate(args, layer + 1, 0); } }
    }
#undef PHASE
}

extern "C" void kernel_launch(void* const* d_in, const int* in_sizes, int n_in, void* d_out, int out_size, void* d_ws, size_t ws_size, hipStream_t stream) {
    static int grid = 0;
    if (grid == 0) {
        if (n_in != 34 || out_size != 92340224 || ws_size < WS_END) { fprintf(stderr, "kernel_launch: unexpected shapes (n_in %d, out %d, ws %zu); nothing launched\n", n_in, out_size, ws_size); grid = -1; return; }
        int dev = 0, cus = 0, per_cu = 0;
        if (hipGetDevice(&dev) != hipSuccess || hipDeviceGetAttribute(&cus, hipDeviceAttributeMultiprocessorCount, dev) != hipSuccess) { grid = -1; return; }
        if (hipFuncSetAttribute((const void*)fwd_kernel, hipFuncAttributeMaxDynamicSharedMemorySize, LDS_BYTES) != hipSuccess) { fprintf(stderr, "kernel_launch: hipFuncSetAttribute failed\n"); grid = -1; return; }
        if (hipOccupancyMaxActiveBlocksPerMultiprocessor(&per_cu, (const void*)fwd_kernel, 512, LDS_BYTES) != hipSuccess || per_cu < 1)
            fprintf(stderr, "kernel_launch: occupancy query reports %d workgroups per CU\n", per_cu);
        (void)hipGetLastError();
        grid = cus;
    }
    if (grid < 0) return;
    (void)hipMemsetAsync(d_ws, 0, WS_ZERO_BYTES, stream);
    (void)hipMemcpyAsync(d_out, d_in[0], (size_t)8388608 * 4, hipMemcpyDeviceToDevice, stream);
    (void)hipMemcpyAsync((float*)d_out + 8388608, d_in[1], (size_t)33554432 * 4, hipMemcpyDeviceToDevice, stream);
    Args a{};
    for (int i = 0; i < 34; ++i) a.in[i] = (const float*)d_in[i];
    a.out = (float*)d_out; a.ws = (unsigned char*)d_ws;
#if MK_ONE_LAUNCH
    a.ph_lo = 0; a.ph_hi = N_PHASE_IDS;
    hipLaunchKernelGGL(fwd_kernel, dim3(grid), dim3(512), LDS_BYTES, stream, a);
#else
    for (int p = 0; p < N_PHASE_IDS; ++p) {
        if (p >= 2) { const int L = (p - 2) / 9, k = (p - 2) % 9; const bool even = (L & 1) == 0; if ((even && k == 3) || (L == 3 && k == 8)) continue; }
        a.ph_lo = p; a.ph_hi = p + 1;
        hipLaunchKernelGGL(fwd_kernel, dim3(grid), dim3(512), LDS_BYTES, stream, a);
    }
#endif
}
```

```cpp
#include <hip/hip_runtime.h>
#include <cstdio>
#include <cstdint>
#define PROF_LAS __attribute__((address_space(3)))
constexpr int LDS_MISC = 131072;
#ifndef DBG_PROF
#define DBG_PROF 0
#endif
#if DBG_PROF
#define PROF_DECL const bool prof_on = (blockIdx.x == 0 && __builtin_amdgcn_readfirstlane((int)threadIdx.x >> 6) == 0); long long prof_t[3] = {0, 0, 0};
#define PROF_START(lvl) do { if (prof_on) prof_t[lvl] = clock64(); } while (0)
#define PROF_STOP(lvl, k) do { if (prof_on) { const long long d_ = clock64() - prof_t[lvl]; if ((threadIdx.x & 63) == 0) { PROF_LAS long long* pa_ = (PROF_LAS long long*)(lds + LDS_MISC + 640); pa_[k] += d_; } } } while (0)
#else
#define PROF_DECL
#define PROF_START(lvl) do {} while (0)
#define PROF_STOP(lvl, k) do {} while (0)
#endif
#ifndef DBG_PROF_N
#define DBG_PROF_N 11264
#endif
namespace pg8 {
#define PG8_LAS __attribute__((address_space(3)))
typedef unsigned short bf16_t;
typedef short bf16x8 __attribute__((ext_vector_type(8)));
typedef float f32x4 __attribute__((ext_vector_type(4)));
typedef unsigned u32x4 __attribute__((ext_vector_type(4)));
constexpr int BM = 256, BK = 64, HALF = 128, HTB = HALF * BK * 2  , STAGE_BYTES = 8 * HTB, NXCD = 8, WGM = 8;

__host__ __device__ __forceinline__ int lds_byte(int r, int c) { const int st = (r >> 4) * 2 + (c >> 5), rr = r & 15, cc = c & 31, ob = rr * 64 + cc * 2; return st * 1024 + (ob ^ (((ob >> 9) & 1) << 5)); }
__host__ __device__ __forceinline__ void stage_rc(int b, int& R, int& C) { const int st = b / 1024, sb = b % 1024, swz = sb ^ (((sb >> 9) & 1) << 5); R = (st >> 1) * 16 + swz / 64; C = (st & 1) * 32 + (swz % 64) / 2; }
__host__ __device__ __forceinline__ int perm32(int rho) { const int n = rho >> 4, i = rho & 15; return 8 * (i >> 2) + 4 * n + (i & 3); }

struct Unit { int pm, pn; };
struct Gemm { const bf16_t* A; const bf16_t* Bt; int M, N, K; int kt; };

struct StaticOrder {
    int nM, nN, nwg, G, c;
    __host__ __device__ void init(int M, int N, int G_, int c_) { nM = M / BM; nN = N / BM; nwg = nM * nN; G = G_; c = c_; }
    __host__ __device__ bool next(int i, Unit& u) const {
        const long L = (long)i * G + c; if (L >= nwg) return false;
        int wgid = (int)L; { const int q = nwg / NXCD, r = nwg % NXCD, xcd = wgid % NXCD, off = wgid / NXCD; wgid = (xcd < r ? xcd * (q + 1) : r * (q + 1) + (xcd - r) * q) + off; }
        const int nig = WGM * nN, gid = wgid / nig, fm = gid * WGM, gsz = (nM - fm) < WGM ? (nM - fm) : WGM;
        u.pm = fm + ((wgid % nig) % gsz); u.pn = (wgid % nig) / gsz; return true;
    }
    __device__ __forceinline__ void a_ready(const Unit&) const {}
    __device__ __forceinline__ void done(const Unit&) const {}
};

struct TailOrder {
    int c;
    __host__ __device__ bool next(int i, Unit& u) const { if (i > 0 || c >= 128) return false; u.pm = 64 + (c >> 3); u.pn = c & 7; return true; }
    __device__ __forceinline__ void a_ready(const Unit&) const {}
    __device__ __forceinline__ void done(const Unit&) const {}
};

struct EarlyO1Order {
    int c;
    __host__ __device__ bool next(int i, Unit& u) const { if (i >= 2 || c < 128) return false; const int x = (c - 128) * 2 + i; u.pm = x >> 2; u.pn = x & 3; return true; }
    __device__ __forceinline__ void a_ready(const Unit&) const {}
    __device__ __forceinline__ void done(const Unit&) const {}
};
struct O1RestOrder {
    int G, c;
    __host__ __device__ bool next(int i, Unit& u) const {
        const int L = i * G + c; if (L >= 3024) return false;
        const int wgid = (L % NXCD) * (3024 / NXCD) + L / NXCD;
        if (wgid < 2368) { const int gid = wgid / 296, rem = wgid % 296; u.pm = gid * 8 + (rem & 7); u.pn = 4 + (rem >> 3); }
        else { const int w2 = wgid - 2368, gid = w2 / 328, rem = w2 % 328; u.pm = 64 + gid * 8 + (rem & 7); u.pn = rem >> 3; }
        return true;
    }
    __device__ __forceinline__ void a_ready(const Unit&) const {}
    __device__ __forceinline__ void done(const Unit&) const {}
};

struct TailOrderE {
    int G, c;
    __host__ __device__ bool next(int i, Unit& u) const { const int L = i * G + c; if (L >= 320) return false; u.pm = 64 + L / 20; u.pn = L % 20; return true; }
    __device__ __forceinline__ void a_ready(const Unit&) const {}
    __device__ __forceinline__ void done(const Unit&) const {}
};

typedef __bf16 bf16v2 __attribute__((ext_vector_type(2)));
typedef float f32v2 __attribute__((ext_vector_type(2)));
__device__ __forceinline__ unsigned cvt_pk_bf16(float lo, float hi) { const f32v2 v = {lo, hi}; const bf16v2 b = __builtin_convertvector(v, bf16v2); return __builtin_bit_cast(unsigned, b); }
__device__ __forceinline__ float fast_sigmoid(float x) { return __builtin_amdgcn_rcpf(1.0f + __builtin_amdgcn_exp2f(-1.4426950408889634f * x)); }

struct EpiStore {
    static constexpr bool PERM = true, AFTER_DRAIN = false;
    bf16_t* O; int ldc;
    __device__ __forceinline__ void operator()(const f32x4 (&acc)[2][2][4][2], const Unit& u, int wr, int wc, int fr, int fq) const {
        const int row0 = u.pm * BM + wr * 64 + fr, col0 = u.pn * BM + wc * 32 + 8 * fq;
#pragma unroll
        for (int ai = 0; ai < 2; ++ai)
#pragma unroll
            for (int m = 0; m < 4; ++m) { bf16_t* rowp = O + (size_t)(row0 + ai * HALF + m * 16) * ldc + col0;
#pragma unroll
                for (int bj = 0; bj < 2; ++bj) { const f32x4 v0 = acc[ai][bj][m][0], v1 = acc[ai][bj][m][1];
                    u32x4 w; w.x = cvt_pk_bf16(v0[0], v0[1]); w.y = cvt_pk_bf16(v0[2], v0[3]); w.z = cvt_pk_bf16(v1[0], v1[1]); w.w = cvt_pk_bf16(v1[2], v1[3]);
                    *(u32x4*)(rowp + bj * HALF) = w; } }
    }
};
struct EpiOdd1 {
    static constexpr bool PERM = true, AFTER_DRAIN = false;
    bf16_t* Z; bf16_t* XBC; float* DTRAW;
    __device__ __forceinline__ void operator()(const f32x4 (&acc)[2][2][4][2], const Unit& u, int wr, int wc, int fr, int fq) const {
        const int row0 = u.pm * BM + wr * 64 + fr;
        if (u.pn >= 40) {
#pragma unroll
            for (int ai = 0; ai < 2; ++ai)
#pragma unroll
                for (int m = 0; m < 4; ++m) { float* rp = DTRAW + (size_t)(row0 + ai * HALF + m * 16) * 128 + wc * 32 + 8 * fq;
                    *(f32x4*)(rp) = acc[ai][0][m][0]; *(f32x4*)(rp + 4) = acc[ai][0][m][1]; }
            return;
        }
        bf16_t* base; int ldc, colt;
        const bool zt = u.pn < 16;
        if (zt) { base = Z; ldc = 4096; colt = u.pn * BM; } else { base = XBC; ldc = 6144; colt = (u.pn - 16) * BM; }
        const int col0 = colt + wc * 32 + 8 * fq;
#pragma unroll
        for (int ai = 0; ai < 2; ++ai)
#pragma unroll
            for (int m = 0; m < 4; ++m) { bf16_t* rowp = base + (size_t)(row0 + ai * HALF + m * 16) * ldc + col0;
#pragma unroll
                for (int bj = 0; bj < 2; ++bj) { f32x4 v0 = acc[ai][bj][m][0], v1 = acc[ai][bj][m][1];
                    if (zt) {
#pragma unroll
                        for (int q = 0; q < 4; ++q) { v0[q] = v0[q] * fast_sigmoid(v0[q]); v1[q] = v1[q] * fast_sigmoid(v1[q]); } }
                    u32x4 w; w.x = cvt_pk_bf16(v0[0], v0[1]); w.y = cvt_pk_bf16(v0[2], v0[3]); w.z = cvt_pk_bf16(v1[0], v1[1]); w.w = cvt_pk_bf16(v1[2], v1[3]);
                    *(u32x4*)(rowp + bj * HALF) = w; } }
    }
};
struct EpiSwiGLU {
    static constexpr bool PERM = true, AFTER_DRAIN = false;
    bf16_t* O; int ldc;
    __device__ __forceinline__ void operator()(const f32x4 (&acc)[2][2][4][2], const Unit& u, int wr, int wc, int fr, int fq) const {
        const int row0 = u.pm * BM + wr * 64 + fr, col0 = u.pn * HALF + wc * 32 + 8 * fq;
#pragma unroll
        for (int ai = 0; ai < 2; ++ai)
#pragma unroll
            for (int m = 0; m < 4; ++m) { bf16_t* rowp = O + (size_t)(row0 + ai * HALF + m * 16) * ldc + col0;
                float o[8];
#pragma unroll
                for (int n = 0; n < 2; ++n)
#pragma unroll
                    for (int j = 0; j < 4; ++j) { const float g = acc[ai][0][m][n][j], uu = acc[ai][1][m][n][j]; o[n * 4 + j] = g * fast_sigmoid(g) * uu; }
                u32x4 w; w.x = cvt_pk_bf16(o[0], o[1]); w.y = cvt_pk_bf16(o[2], o[3]); w.z = cvt_pk_bf16(o[4], o[5]); w.w = cvt_pk_bf16(o[6], o[7]);
                *(u32x4*)(rowp) = w; }
    }
};
struct EpiResid {
    static constexpr bool PERM = true, AFTER_DRAIN = false;
    bf16_t* Y; const float* gate; float* OUTF;
    __device__ __forceinline__ void operator()(const f32x4 (&acc)[2][2][4][2], const Unit& u, int wr, int wc, int fr, int fq) const {
        const int row0 = u.pm * BM + wr * 64 + fr, col0 = u.pn * BM + wc * 32 + 8 * fq;
        const int cond = u.pm < 16 ? 0 : 1 + ((u.pm - 16) >> 3);
        const float* gp = gate + (size_t)cond * 12288 + col0;
        f32x4 gv[2][2];
#pragma unroll
        for (int bj = 0; bj < 2; ++bj)
#pragma unroll
            for (int n = 0; n < 2; ++n) gv[bj][n] = *(const f32x4*)(gp + bj * HALF + 4 * n);
#pragma unroll
        for (int ai = 0; ai < 2; ++ai)
#pragma unroll
            for (int m = 0; m < 4; ++m) { const size_t off = (size_t)(row0 + ai * HALF + m * 16) * 2048 + col0;
#pragma unroll
                for (int bj = 0; bj < 2; ++bj) {
                    const u32x4 yv = *(const u32x4*)(Y + off + bj * HALF);
                    f32x4 o0, o1;
                    o0[0] = __uint_as_float(yv.x << 16); o0[1] = __uint_as_float(yv.x & 0xffff0000u); o0[2] = __uint_as_float(yv.y << 16); o0[3] = __uint_as_float(yv.y & 0xffff0000u);
                    o1[0] = __uint_as_float(yv.z << 16); o1[1] = __uint_as_float(yv.z & 0xffff0000u); o1[2] = __uint_as_float(yv.w << 16); o1[3] = __uint_as_float(yv.w & 0xffff0000u);
                    o0 = o0 + gv[bj][0] * acc[ai][bj][m][0]; o1 = o1 + gv[bj][1] * acc[ai][bj][m][1];
                    if (OUTF) { *(f32x4*)(OUTF + off + bj * HALF) = o0; *(f32x4*)(OUTF + off + bj * HALF + 4) = o1; }
                    else { u32x4 w; w.x = cvt_pk_bf16(o0[0], o0[1]); w.y = cvt_pk_bf16(o0[2], o0[3]); w.z = cvt_pk_bf16(o1[0], o1[1]); w.w = cvt_pk_bf16(o1[2], o1[3]); *(u32x4*)(Y + off + bj * HALF) = w; } } }
    }
};

struct EpiPartW {
    static constexpr bool PERM = true, AFTER_DRAIN = false;
    float* P; unsigned* flags;
    __device__ __forceinline__ void operator()(const f32x4 (&acc)[2][2][4][2], const Unit& u, int wr, int wc, int fr, int fq) const {
        const int unit = (u.pm - 64) * 8 + u.pn; int tid = threadIdx.x; asm volatile("" : "+v"(tid));
        float* base = P + ((size_t)unit * 32 * 512 + tid) * 4;
#pragma unroll
        for (int ai = 0; ai < 2; ++ai)
#pragma unroll
            for (int bj = 0; bj < 2; ++bj)
#pragma unroll
                for (int m = 0; m < 4; ++m)
#pragma unroll
                    for (int n = 0; n < 2; ++n) *(f32x4*)(base + (size_t)((((ai * 2 + bj) * 4 + m) * 2 + n) * 512) * 4) = acc[ai][bj][m][n];
        asm volatile("s_waitcnt vmcnt(0)" ::: "memory");
        __builtin_amdgcn_fence(__ATOMIC_RELEASE, "agent");
        asm volatile("s_waitcnt vmcnt(0)" ::: "memory");
        if ((tid & 63) == 0) (void)__hip_atomic_fetch_add(flags + unit * 16, 1u, __ATOMIC_RELAXED, __HIP_MEMORY_SCOPE_AGENT);
    }
};
struct EpiResidP {
    static constexpr bool PERM = true, AFTER_DRAIN = false;
    bf16_t* Y; const float* gate; float* OUTF; const float* P; unsigned* flags;
    __device__ __forceinline__ void operator()(const f32x4 (&acc)[2][2][4][2], const Unit& u, int wr, int wc, int fr, int fq) const {
        const int unit = (u.pm - 64) * 8 + u.pn; int tid = threadIdx.x; asm volatile("" : "+v"(tid));
        { unsigned sp = 0; while (__hip_atomic_load(flags + unit * 16, __ATOMIC_RELAXED, __HIP_MEMORY_SCOPE_AGENT) < 8u && ++sp < (1u << 20)) __builtin_amdgcn_s_sleep(2); }
        __builtin_amdgcn_fence(__ATOMIC_ACQUIRE, "agent");
        asm volatile("s_waitcnt vmcnt(0)" ::: "memory");
        const float* pb = P + ((size_t)unit * 32 * 512 + tid) * 4;
        const int row0 = u.pm * BM + wr * 64 + fr, col0 = u.pn * BM + wc * 32 + 8 * fq;
        const int cond = u.pm < 16 ? 0 : 1 + ((u.pm - 16) >> 3);
        const float* gp = gate + (size_t)cond * 12288 + col0;
        f32x4 gv[2][2];
#pragma unroll
        for (int bj = 0; bj < 2; ++bj)
#pragma unroll
            for (int n = 0; n < 2; ++n) gv[bj][n] = *(const f32x4*)(gp + bj * HALF + 4 * n);
#pragma unroll
        for (int ai = 0; ai < 2; ++ai)
#pragma unroll
            for (int m = 0; m < 4; ++m) { const size_t off = (size_t)(row0 + ai * HALF + m * 16) * 2048 + col0;
#pragma unroll
                for (int bj = 0; bj < 2; ++bj) {
                    const u32x4 yv = *(const u32x4*)(Y + off + bj * HALF);
                    const f32x4 p0 = *(const f32x4*)(pb + (size_t)((((ai * 2 + bj) * 4 + m) * 2 + 0) * 512) * 4), p1 = *(const f32x4*)(pb + (size_t)((((ai * 2 + bj) * 4 + m) * 2 + 1) * 512) * 4);
                    f32x4 o0, o1;
                    o0[0] = __uint_as_float(yv.x << 16); o0[1] = __uint_as_float(yv.x & 0xffff0000u); o0[2] = __uint_as_float(yv.y << 16); o0[3] = __uint_as_float(yv.y & 0xffff0000u);
                    o1[0] = __uint_as_float(yv.z << 16); o1[1] = __uint_as_float(yv.z & 0xffff0000u); o1[2] = __uint_as_float(yv.w << 16); o1[3] = __uint_as_float(yv.w & 0xffff0000u);
                    o0 = o0 + gv[bj][0] * (acc[ai][bj][m][0] + p0); o1 = o1 + gv[bj][1] * (acc[ai][bj][m][1] + p1);
                    if (OUTF) { *(f32x4*)(OUTF + off + bj * HALF) = o0; *(f32x4*)(OUTF + off + bj * HALF + 4) = o1; }
                    else { u32x4 w; w.x = cvt_pk_bf16(o0[0], o0[1]); w.y = cvt_pk_bf16(o0[2], o0[3]); w.z = cvt_pk_bf16(o1[0], o1[1]); w.w = cvt_pk_bf16(o1[2], o1[3]); *(u32x4*)(Y + off + bj * HALF) = w; } } }
    }
};

struct EpiDummy {
    static constexpr bool PERM = false, AFTER_DRAIN = false;
    float* Y;
    __device__ __forceinline__ void operator()(const f32x4 (&acc)[2][2][4][2], const Unit& u, int wr, int wc, int fr, int fq) const {
        const int row0 = u.pm * BM + wr * 64 + fr, col0 = u.pn * BM + wc * 32 + 4 * fq;
#pragma unroll
        for (int ai = 0; ai < 2; ++ai)
#pragma unroll
            for (int m = 0; m < 4; ++m) { float* rowp = Y + (size_t)(row0 + ai * HALF + m * 16) * 2048 + col0;
#pragma unroll
                for (int bj = 0; bj < 2; ++bj)
#pragma unroll
                    for (int n = 0; n < 2; ++n) *(f32x4*)(rowp + bj * HALF + n * 16) = acc[ai][bj][m][n]; }
    }
};
template <class Epi, class Sched, bool ALIGN_EPI = false, bool SP2 = false>
__device__ __forceinline__ void gemm_phase(PG8_LAS unsigned char* lds, const Gemm g, const Sched& S, const Epi& E) {
    int tid_ = threadIdx.x; asm volatile("" : "+v"(tid_)); const int tid = tid_, wid = __builtin_amdgcn_readfirstlane(tid >> 6), lane = tid & 63, wr = wid >> 2, wc = wid & 3, fr = lane & 15, fq = lane >> 4;
    const int K = g.K, nt = (g.kt ? g.kt : K) / BK;
    unsigned voffA[2], voffB[2];
#pragma unroll
    for (int i = 0; i < 2; ++i) { int R, C; stage_rc(tid * 16 + i * 8192, R, C); const int Rb = Epi::PERM ? ((R & ~31) + perm32(R & 31)) : R;
        voffA[i] = (unsigned)(R * K + C) * 2u; voffB[i] = (unsigned)(Rb * K + C) * 2u; }
    const size_t kstep = (size_t)(BK * 2);
    const size_t hstep = (size_t)HALF * K * 2;
    const size_t tstep = 2 * hstep;
    const unsigned ldsw = (unsigned)wid * 1024u;
    const int aoff = lds_byte(wr * 64 + fr, fq * 8), boff = lds_byte(wc * 32 + fr, fq * 8);
#define PG8_SA(b, h) (((b) * 2 + (h)) * HTB)
#define PG8_SB(b, h) ((4 + (b) * 2 + (h)) * HTB)
#define PG8_STAGE(bufoff, gbase, voff) do { _Pragma("unroll") for (int _i = 0; _i < 2; ++_i) \
        __builtin_amdgcn_global_load_lds((const unsigned*)((const char*)(gbase) + (voff)[_i]), (PG8_LAS unsigned*)(lds + (bufoff) + ldsw + _i * 8192), 16, 0, 0); } while (0)
#define PG8_LDA(dst, b, h) do { _Pragma("unroll") for (int m = 0; m < 4; ++m) _Pragma("unroll") for (int k = 0; k < 2; ++k) dst[m][k] = *(const PG8_LAS bf16x8*)(lds + PG8_SA(b, h) + aoff + m * 2048 + k * 1024); } while (0)
#define PG8_LDB(dst, b, h) do { _Pragma("unroll") for (int n = 0; n < 2; ++n) _Pragma("unroll") for (int k = 0; k < 2; ++k) dst[n][k] = *(const PG8_LAS bf16x8*)(lds + PG8_SB(b, h) + boff + n * 2048 + k * 1024); } while (0)
#define PG8_MMA(ai, bj, At, Bt) do { __builtin_amdgcn_s_setprio(1); _Pragma("unroll") for (int m = 0; m < 4; ++m) _Pragma("unroll") for (int n = 0; n < 2; ++n) _Pragma("unroll") for (int k = 0; k < 2; ++k) \
        acc[ai][bj][m][n] = __builtin_amdgcn_mfma_f32_16x16x32_bf16(Bt[n][k], At[m][k], acc[ai][bj][m][n], 0, 0, 0); __builtin_amdgcn_s_setprio(0); } while (0)
#define PG8_WAIT_V(n) asm volatile("s_waitcnt vmcnt(" #n ")" ::: "memory")
#define PG8_WAIT_L(n) asm volatile("s_waitcnt lgkmcnt(" #n ")" ::: "memory")
#define PG8_BAR __builtin_amdgcn_s_barrier()
#define PG8_SCHED __builtin_amdgcn_sched_barrier(0)
    Unit cur, nxt; int ui = 0;
    if (!S.next(0, cur)) return;
    PROF_DECL
    if (g.N == DBG_PROF_N) PROF_START(0);
    f32x4 acc[2][2][4][2];
#pragma unroll
    for (int a = 0; a < 2; ++a)
#pragma unroll
        for (int b = 0; b < 2; ++b)
#pragma unroll
            for (int m = 0; m < 4; ++m)
#pragma unroll
                for (int n = 0; n < 2; ++n) acc[a][b][m][n] = (f32x4){0.f, 0.f, 0.f, 0.f};
    bf16x8 At[4][2], B0[2][2], B1[2][2];
    const char* cA = (const char*)g.A + (size_t)cur.pm * tstep; const char* cB = (const char*)g.Bt + (size_t)cur.pn * tstep;
    S.a_ready(cur);
    if constexpr (SP2) {
        PG8_STAGE(PG8_SB(0, 0), cB, voffB); PG8_STAGE(PG8_SB(0, 1), cB + hstep, voffB); PG8_STAGE(PG8_SA(0, 0), cA, voffA); PG8_STAGE(PG8_SA(0, 1), cA + hstep, voffA);
        if (wr == 1) PG8_BAR;
        PG8_WAIT_V(2); PG8_BAR;
        PG8_STAGE(PG8_SB(1, 0), cB + kstep, voffB); PG8_STAGE(PG8_SA(1, 0), cA + kstep, voffA); PG8_STAGE(PG8_SB(1, 1), cB + hstep + kstep, voffB);
        PG8_WAIT_V(6); PG8_BAR;
    } else {
        PG8_STAGE(PG8_SB(0, 0), cB, voffB); PG8_STAGE(PG8_SA(0, 0), cA, voffA); PG8_STAGE(PG8_SB(0, 1), cB + hstep, voffB); PG8_STAGE(PG8_SA(0, 1), cA + hstep, voffA);
        if (wr == 1) PG8_BAR;
        PG8_WAIT_V(4); PG8_BAR;
        PG8_STAGE(PG8_SB(1, 0), cB + kstep, voffB); PG8_STAGE(PG8_SA(1, 0), cA + kstep, voffA); PG8_STAGE(PG8_SB(1, 1), cB + hstep + kstep, voffB);
        PG8_WAIT_V(6); PG8_BAR;
    }
    for (;;) {
        const bool has_next = S.next(ui + 1, nxt);
        const char* nA = has_next ? (const char*)g.A + (size_t)nxt.pm * tstep : cA; const char* nB = has_next ? (const char*)g.Bt + (size_t)nxt.pn * tstep : cB;
        for (int t = 0; t < nt; t += 2) {
            const bool last = (t == nt - 2);
            const char* a1 = cA + (size_t)(t + 1) * kstep;
            const char* a2 = last ? nA : cA + (size_t)(t + 2) * kstep; const char* b2 = last ? nB : cB + (size_t)(t + 2) * kstep;
            const char* a3 = a2 + kstep; const char* b3 = b2 + kstep;
            if (last && has_next) S.a_ready(nxt);
            if constexpr (SP2) {
            PG8_LDB(B0, 0, 0); PG8_LDB(B1, 0, 1); PG8_SCHED; PG8_LDA(At, 0, 0); PG8_STAGE(PG8_SA(1, 1), a1 + hstep, voffA);
            PG8_WAIT_V(8); PG8_WAIT_L(0); PG8_BAR; PG8_MMA(0, 0, At, B0); PG8_MMA(0, 1, At, B1); PG8_BAR; PG8_SCHED;
            PG8_LDA(At, 0, 1); PG8_STAGE(PG8_SB(0, 0), b2, voffB); PG8_STAGE(PG8_SB(0, 1), b2 + hstep, voffB); PG8_STAGE(PG8_SA(0, 0), a2, voffA);
            PG8_WAIT_V(8); PG8_WAIT_L(0); PG8_BAR; PG8_MMA(1, 0, At, B0); PG8_MMA(1, 1, At, B1); PG8_BAR; PG8_SCHED;
            PG8_LDB(B0, 1, 0); PG8_LDB(B1, 1, 1); PG8_SCHED; PG8_LDA(At, 1, 0); PG8_STAGE(PG8_SA(0, 1), a2 + hstep, voffA);
            PG8_WAIT_V(8); PG8_WAIT_L(0); PG8_BAR; PG8_MMA(0, 0, At, B0); PG8_MMA(0, 1, At, B1); PG8_BAR; PG8_SCHED;
            PG8_LDA(At, 1, 1); PG8_STAGE(PG8_SB(1, 0), b3, voffB); PG8_STAGE(PG8_SB(1, 1), b3 + hstep, voffB); PG8_STAGE(PG8_SA(1, 0), a3, voffA);
            PG8_WAIT_V(8); PG8_WAIT_L(0); PG8_BAR; PG8_MMA(1, 0, At, B0); PG8_MMA(1, 1, At, B1); PG8_BAR; PG8_SCHED;
            } else {
            PG8_LDB(B0, 0, 0); PG8_SCHED; PG8_LDA(At, 0, 0); PG8_STAGE(PG8_SA(1, 1), a1 + hstep, voffA);
            PG8_WAIT_L(8); PG8_BAR; PG8_WAIT_L(0); PG8_MMA(0, 0, At, B0); PG8_BAR; PG8_SCHED;
            PG8_LDB(B1, 0, 1); PG8_STAGE(PG8_SB(0, 0), b2, voffB);
            PG8_BAR; PG8_WAIT_L(0); PG8_MMA(0, 1, At, B1); PG8_BAR;
            PG8_LDA(At, 0, 1); PG8_STAGE(PG8_SA(0, 0), a2, voffA);
            PG8_BAR; PG8_WAIT_L(0); PG8_MMA(1, 0, At, B0); PG8_BAR; PG8_SCHED;
            PG8_STAGE(PG8_SB(0, 1), b2 + hstep, voffB);
            PG8_WAIT_V(6); PG8_BAR; PG8_MMA(1, 1, At, B1); PG8_BAR;
            PG8_LDB(B0, 1, 0); PG8_SCHED; PG8_LDA(At, 1, 0); PG8_STAGE(PG8_SA(0, 1), a2 + hstep, voffA);
            PG8_WAIT_L(8); PG8_BAR; PG8_WAIT_L(0); PG8_MMA(0, 0, At, B0); PG8_BAR; PG8_SCHED;
            PG8_LDB(B1, 1, 1); PG8_STAGE(PG8_SB(1, 0), b3, voffB);
            PG8_BAR; PG8_WAIT_L(0); PG8_MMA(0, 1, At, B1); PG8_BAR;
            PG8_LDA(At, 1, 1); PG8_STAGE(PG8_SA(1, 0), a3, voffA);
            PG8_BAR; PG8_WAIT_L(0); PG8_MMA(1, 0, At, B0); PG8_BAR; PG8_SCHED;
            PG8_STAGE(PG8_SB(1, 1), b3 + hstep, voffB);
            PG8_WAIT_V(6); PG8_BAR; PG8_MMA(1, 1, At, B1); PG8_BAR;
            }
        }
        if constexpr (ALIGN_EPI) { if (wr == 0) PG8_BAR; }
        if (g.N == DBG_PROF_N) PROF_START(1);
        if constexpr (!Epi::AFTER_DRAIN) { E(acc, cur, wr, wc, fr, fq); S.done(cur); }
        if (g.N == DBG_PROF_N) PROF_STOP(1, 10);
        if (!has_next) break;
#pragma unroll
        for (int a = 0; a < 2; ++a)
#pragma unroll
            for (int b = 0; b < 2; ++b)
#pragma unroll
                for (int m = 0; m < 4; ++m)
#pragma unroll
                    for (int n = 0; n < 2; ++n) acc[a][b][m][n] = (f32x4){0.f, 0.f, 0.f, 0.f};
        cur = nxt; cA = nA; cB = nB; ++ui;
        if constexpr (ALIGN_EPI) { if (wr == 1) PG8_BAR; }
    }
    if (g.N == DBG_PROF_N) PROF_STOP(0, 11);
    PG8_WAIT_V(0);
    if constexpr (!ALIGN_EPI) { if (wr == 0) PG8_BAR; }
    PG8_BAR;
    if constexpr (Epi::AFTER_DRAIN) { E.fused(acc, cur, wr, wc, fr, fq, lds, wid, lane); S.done(cur); }
#undef PG8_SA
#undef PG8_SB
#undef PG8_STAGE
#undef PG8_LDA
#undef PG8_LDB
#undef PG8_MMA
#undef PG8_WAIT_V
#undef PG8_WAIT_L
#undef PG8_BAR
#undef PG8_SCHED
}
}

#define GAS __attribute__((address_space(1)))
#define LAS __attribute__((address_space(3)))
typedef unsigned short bf16_t;
typedef short bf16x8 __attribute__((ext_vector_type(8)));
typedef short bf16x4 __attribute__((ext_vector_type(4)));
typedef float f32x4 __attribute__((ext_vector_type(4)));
typedef float f32x2 __attribute__((ext_vector_type(2)));
typedef unsigned u32x4 __attribute__((ext_vector_type(4)));
typedef unsigned u32x2 __attribute__((ext_vector_type(2)));
#define MFMA16(a, b, c) __builtin_amdgcn_mfma_f32_16x16x32_bf16((a), (b), (c), 0, 0, 0)

constexpr int D = 2048, T = 20480, TP = 4096, NT = 80;
constexpr float EPS = 1e-6f;
constexpr size_t MiB = 1u << 20;
constexpr size_t WS_CTL = 0, WS_ADA = 1 * MiB, WS_ZERO_BYTES = 3 * MiB;
constexpr size_t WS_ROPE = 3 * MiB, WS_LRUW = 4 * MiB, WS_CHS = 6 * MiB;
constexpr size_t WS_WEIN = 16 * MiB, WS_WEOUT = 56 * MiB, WS_WSIN = 72 * MiB, WS_WSOUT = 154 * MiB, WS_WFIN = 186 * MiB, WS_WFOUT = 362 * MiB;
constexpr size_t WS_H = 450 * MiB, WS_R1 = 530 * MiB, WS_R2 = 770 * MiB, WS_R3 = 930 * MiB, WS_R4 = 1090 * MiB, WS_R5 = 1210 * MiB, WS_LR = 1242 * MiB, WS_Y = 1402 * MiB, WS_END = 1482 * MiB;
constexpr size_t WS_U5 = WS_R1, WS_Q = WS_R2, WS_K = WS_R2 + 40 * MiB, WS_KC = WS_R2 + 80 * MiB, WS_VTP = WS_R2 + 84 * MiB, WS_VTS = WS_R2 + 92 * MiB, WS_MIXE = WS_R3;
constexpr size_t WS_XBC = WS_R1, WS_Z = WS_R2, WS_XT = WS_R3, WS_BN = WS_R4, WS_BT = WS_R4 + 40 * MiB, WS_CN = WS_R4 + 80 * MiB, WS_DTRAW = WS_R5;
constexpr size_t WS_SIN = WS_H, WS_MIXO = WS_R1 + 80 * MiB;
constexpr size_t WS_HID = WS_R1;
constexpr size_t OUT_K = 41943040, OUT_V = 50331648, OUT_LRU = 58720256, OUT_SSD = 58785792;
constexpr int LDS_BYTES = LDS_MISC + 1024;

struct Args { const float* in[34]; float* out; unsigned char* ws; int ph_lo, ph_hi; };

__device__ __forceinline__ float bf2f(unsigned short b) { return __uint_as_float(((unsigned)b) << 16); }
__device__ __forceinline__ float bflo(unsigned w) { return __uint_as_float(w << 16); }
__device__ __forceinline__ float bfhi(unsigned w) { return __uint_as_float(w & 0xffff0000u); }
typedef __bf16 bf16v2_t __attribute__((ext_vector_type(2)));
__device__ __forceinline__ unsigned pk2(float lo, float hi) { const f32x2 v = {lo, hi}; const bf16v2_t b = __builtin_convertvector(v, bf16v2_t); return __builtin_bit_cast(unsigned, b); }
__device__ __forceinline__ float fexp(float x) { return __builtin_amdgcn_exp2f(1.4426950408889634f * x); }
__device__ __forceinline__ float fsigmoid(float x) { return __builtin_amdgcn_rcpf(1.0f + __builtin_amdgcn_exp2f(-1.4426950408889634f * x)); }
__device__ __forceinline__ float fsilu(float x) { return x * fsigmoid(x); }
__device__ __forceinline__ float fsoftplus(float x) { return fmaxf(x, 0.f) + log1pf(fexp(-fabsf(x))); }
__device__ __forceinline__ float fgelu_tanh(float x) { const float u = 0.7978845608028654f * (x + 0.044715f * x * x * x); const float t = 1.f - 2.f * __builtin_amdgcn_rcpf(fexp(2.f * u) + 1.f); return 0.5f * x * (1.f + t); }
__device__ __forceinline__ float xor16_max(float v) { const unsigned x = __builtin_bit_cast(unsigned, v); const auto r = __builtin_amdgcn_permlane16_swap(x, x, false, false); return fmaxf(__builtin_bit_cast(float, (unsigned)r[0]), __builtin_bit_cast(float, (unsigned)r[1])); }
__device__ __forceinline__ float xor32_max(float v) { const unsigned x = __builtin_bit_cast(unsigned, v); const auto r = __builtin_amdgcn_permlane32_swap(x, x, false, false); return fmaxf(__builtin_bit_cast(float, (unsigned)r[0]), __builtin_bit_cast(float, (unsigned)r[1])); }
__device__ __forceinline__ float xor16_sum(float v) { const unsigned x = __builtin_bit_cast(unsigned, v); const auto r = __builtin_amdgcn_permlane16_swap(x, x, false, false); return __builtin_bit_cast(float, (unsigned)r[0]) + __builtin_bit_cast(float, (unsigned)r[1]); }
__device__ __forceinline__ float xor32_sum(float v) { const unsigned x = __builtin_bit_cast(unsigned, v); const auto r = __builtin_amdgcn_permlane32_swap(x, x, false, false); return __builtin_bit_cast(float, (unsigned)r[0]) + __builtin_bit_cast(float, (unsigned)r[1]); }
__device__ __forceinline__ float wave_sum(float v) {
    v += __builtin_bit_cast(float, __builtin_amdgcn_update_dpp(0, __builtin_bit_cast(int, v), 0xB1, 0xf, 0xf, false));
    v += __builtin_bit_cast(float, __builtin_amdgcn_update_dpp(0, __builtin_bit_cast(int, v), 0x4E, 0xf, 0xf, false));
    v += __builtin_bit_cast(float, __builtin_amdgcn_update_dpp(0, __builtin_bit_cast(int, v), 0x141, 0xf, 0xf, false));
    v += __builtin_bit_cast(float, __builtin_amdgcn_update_dpp(0, __builtin_bit_cast(int, v), 0x140, 0xf, 0xf, false));
    v = xor16_sum(v); v = xor32_sum(v);
    return v;
}
__device__ __forceinline__ void unpack8(const u32x4 v, float (&f)[8]) { f[0] = bflo(v.x); f[1] = bfhi(v.x); f[2] = bflo(v.y); f[3] = bfhi(v.y); f[4] = bflo(v.z); f[5] = bfhi(v.z); f[6] = bflo(v.w); f[7] = bfhi(v.w); }
__device__ __forceinline__ u32x4 pack8(const float (&f)[8]) { u32x4 w; w.x = pk2(f[0], f[1]); w.y = pk2(f[2], f[3]); w.z = pk2(f[4], f[5]); w.w = pk2(f[6], f[7]); return w; }
__device__ __forceinline__ bf16x8 as_bf16x8(u32x4 v) { return __builtin_bit_cast(bf16x8, v); }
__device__ __forceinline__ int cond_of_tok(int t) { return t < TP ? 0 : 1 + ((t - TP) >> 11); }
__device__ __forceinline__ int otid() { int t = threadIdx.x; asm volatile("" : "+v"(t)); return t; }
template <int N> __device__ __forceinline__ float dpp_row_shr(float v) { const int x = __builtin_bit_cast(int, v); return __builtin_bit_cast(float, __builtin_amdgcn_update_dpp(x, x, 0x110 + N, 0xf, 0xf, false)); }
template <int N> __device__ __forceinline__ float dpp_row_shl(float v) { const int x = __builtin_bit_cast(int, v); return __builtin_bit_cast(float, __builtin_amdgcn_update_dpp(x, x, 0x100 + N, 0xf, 0xf, false)); }
template <int N> __device__ __forceinline__ float dpp_row_shr_fill(float v, float fill) { return __builtin_bit_cast(float, __builtin_amdgcn_update_dpp(__builtin_bit_cast(int, fill), __builtin_bit_cast(int, v), 0x110 + N, 0xf, 0xf, false)); }
template <int N> __device__ __forceinline__ float dpp_row_shl_fill(float v, float fill) { return __builtin_bit_cast(float, __builtin_amdgcn_update_dpp(__builtin_bit_cast(int, fill), __builtin_bit_cast(int, v), 0x100 + N, 0xf, 0xf, false)); }
template <int CTRL, int RM = 0xf, int BM = 0xf> __device__ __forceinline__ float dpp_mov(float old, float src) { return __builtin_bit_cast(float, __builtin_amdgcn_update_dpp(__builtin_bit_cast(int, old), __builtin_bit_cast(int, src), CTRL, RM, BM, false)); }
__device__ __forceinline__ float quad_xor1(float x) { return dpp_mov<0xB1>(x, x); }
__device__ __forceinline__ float quad_xor2(float x) { return dpp_mov<0x4E>(x, x); }
__device__ __forceinline__ float row_bcast_hi(float x) { float t = dpp_mov<0xFF>(x, x); t = dpp_mov<0x104, 0xf, 0x4>(t, t); t = dpp_mov<0x108, 0xf, 0x3>(t, t); return t; }
__device__ __forceinline__ float row_bcast_lo(float x) { float t = dpp_mov<0x00>(x, x); t = dpp_mov<0x114, 0xf, 0x2>(t, t); t = dpp_mov<0x118, 0xf, 0xC>(t, t); return t; }
__device__ __forceinline__ float wave_scan_incl(float v) {
    v += dpp_mov<0x111>(0.f, v); v += dpp_mov<0x112>(0.f, v); v += dpp_mov<0x114>(0.f, v); v += dpp_mov<0x118>(0.f, v);
    v += dpp_mov<0x142, 0xA>(0.f, v); v += dpp_mov<0x143, 0xC>(0.f, v);
    return v;
}
#define WG_SYNC() asm volatile("s_waitcnt lgkmcnt(0)\n\ts_barrier" ::: "memory")
#ifndef DBG_TWICE
#define DBG_TWICE 0
#endif

#define XB_TMO      128
#define XB_XCNT(j)  (256  + 64 * (j))
#define XB_XSUB(j)  (1280 + 64 * (j))
#define XB_XGEN(j)  (2304 + 64 * (j))
#define XB_TOP      3328
#define XB_TOPGEN   3392
#define XCD_BAR_WORDS 3456
#define XB_SPIN_CAP (1u << 18)

__device__ __forceinline__ unsigned xb_ld(unsigned* p)              { return __hip_atomic_load(p, __ATOMIC_RELAXED, __HIP_MEMORY_SCOPE_AGENT); }
__device__ __forceinline__ unsigned xb_add(unsigned* p, unsigned v) { return __hip_atomic_fetch_add(p, v, __ATOMIC_RELAXED, __HIP_MEMORY_SCOPE_AGENT); }
__device__ __forceinline__ unsigned xb_xcc_id() { return (unsigned)__builtin_amdgcn_s_getreg((3 << 11) | 20) & 0xFu; }
#define XB_SPIN(cond, bar) do { unsigned _sp = 0; while (cond) { __builtin_amdgcn_s_sleep(1); \
    if ((++_sp & 255u) == 0u) { if (xb_ld(&(bar)[XB_TMO])) break; if (_sp > XB_SPIN_CAP) { atomicAdd(&(bar)[XB_TMO], 1u); break; } } } } while (0)

struct XcdBarrier {
    unsigned* bar; unsigned x;
    volatile LAS unsigned* st;
};

__device__ __forceinline__ XcdBarrier xcd_barrier_post(unsigned* bar, volatile LAS unsigned* st) {
    XcdBarrier b; b.bar = bar; b.x = xb_xcc_id(); b.st = st;
    if (threadIdx.x == 0) (void)xb_add(&bar[XB_XCNT(b.x)], 1u);
    return b;
}
__device__ __forceinline__ void xcd_barrier_complete(unsigned* bar, unsigned x, unsigned& nloc, unsigned& nx) {
    const unsigned G = gridDim.x * gridDim.y * gridDim.z;
    unsigned sum, cnt, mine, sp = 0u;
    for (;;) {
        sum = 0u; cnt = 0u; mine = 0u;
#pragma unroll
        for (unsigned j = 0; j < 16; ++j) { const unsigned c = xb_ld(&bar[XB_XCNT(j)]); sum += c; cnt += (c > 0u) ? 1u : 0u; mine = (j == x) ? c : mine; }
        if (sum == G) break;
        __builtin_amdgcn_s_sleep(1);
        if ((++sp & 255u) == 0u) { if (xb_ld(&bar[XB_TMO])) break; if (sp > XB_SPIN_CAP) { atomicAdd(&bar[XB_TMO], 1u); break; } }
    }
    nloc = mine > 0u ? mine : 1u; nx = cnt > 0u ? cnt : 1u;
}

__device__ __forceinline__ void xcd_barrier(const XcdBarrier& b) {
    asm volatile("s_waitcnt vmcnt(0)" ::: "memory");
    __syncthreads();
    if (threadIdx.x == 0) {
        unsigned* bar = b.bar;
        __builtin_amdgcn_s_waitcnt(0);
        unsigned nloc = b.st[0], nx = b.st[1];
        if (nloc == 0u) { xcd_barrier_complete(bar, b.x, nloc, nx); b.st[0] = nloc; b.st[1] = nx; }
        const unsigned old = xb_add(&bar[XB_XSUB(b.x)], 1u);
        const unsigned gen = old / nloc;
        if (old + 1u == (gen + 1u) * nloc) {
            __builtin_amdgcn_fence(__ATOMIC_RELEASE, "agent");
            asm volatile("s_waitcnt vmcnt(0)" ::: "memory");
            const unsigned og = xb_add(&bar[XB_TOP], 1u);
            const unsigned tg = og / nx;
            if (og + 1u == (tg + 1u) * nx) xb_add(&bar[XB_TOPGEN], 1u);
            else XB_SPIN(xb_ld(&bar[XB_TOPGEN]) == tg, bar);
            __builtin_amdgcn_fence(__ATOMIC_ACQUIRE, "agent");
            xb_add(&bar[XB_XGEN(b.x)], 1u);
            asm volatile("s_waitcnt vmcnt(0)" ::: "memory");
        } else {
            XB_SPIN(xb_ld(&bar[XB_XGEN(b.x)]) == gen, bar);
            __builtin_amdgcn_fence(__ATOMIC_ACQUIRE, "agent");
            asm volatile("s_waitcnt vmcnt(0)" ::: "memory");
        }
    }
    __syncthreads();
}

__device__ __forceinline__ void transpose_item(const float* W, int N, bf16_t* WT, int ldk, int k0, int n0, int drow0, LAS float* scr, int lane) {
#pragma unroll 8
    for (int i = 0; i < 32; ++i) { const int kk = 2 * i + (lane >> 5); scr[kk * 33 + (lane & 31)] = W[(size_t)(k0 + kk) * N + n0 + (lane & 31)]; }
    asm volatile("s_waitcnt lgkmcnt(0)" ::: "memory");
    const int c = lane & 7;
#pragma unroll
    for (int jj = 0; jj < 4; ++jj) { const int n = (lane >> 3) + 8 * jj; const LAS float* s = scr + (8 * c) * 33 + n;
        u32x4 o; o.x = pk2(s[0 * 33], s[1 * 33]); o.y = pk2(s[2 * 33], s[3 * 33]); o.z = pk2(s[4 * 33], s[5 * 33]); o.w = pk2(s[6 * 33], s[7 * 33]);
        *(u32x4*)(WT + (size_t)(drow0 + n) * ldk + k0 + 8 * c) = o; }
    asm volatile("s_waitcnt lgkmcnt(0)" ::: "memory");
}

__device__ __forceinline__ void phase_prologue(const Args& A, LAS unsigned char* lds) {
    const int tid = otid(), lane = tid & 63, wave = tid >> 6;
    unsigned char* ws = A.ws;
    {
        LAS float* s = (LAS float*)lds;
        for (int idx = tid; idx < 9 * 2048; idx += 512) { const int cnd = idx >> 11, k = idx & 2047; const float v = cnd == 0 ? A.in[7][k] : A.in[2][(cnd - 1) * 2048 + k]; s[k * 12 + cnd] = v * fsigmoid(v); }
        WG_SYNC();
        float* ADA = (float*)(ws + WS_ADA);
        LAS float* red = (LAS float*)(lds + 98304);
        for (int it = blockIdx.x; it < 4 * 192; it += gridDim.x) {
            const int layer = it / 192, cg = it - layer * 192, col = cg * 64 + lane;
            float acc[9];
#pragma unroll
            for (int c = 0; c < 9; ++c) acc[c] = 0.f;
            const float* w = A.in[8] + ((size_t)layer * 2048 + wave * 256) * 12288 + col;
#pragma unroll 8
            for (int k = 0; k < 256; ++k) {
                const float wv = w[(size_t)k * 12288];
                const LAS f32x4* sp = (const LAS f32x4*)(s + (wave * 256 + k) * 12);
                const f32x4 s0 = sp[0], s1 = sp[1], s2 = sp[2];
                acc[0] += s0[0] * wv; acc[1] += s0[1] * wv; acc[2] += s0[2] * wv; acc[3] += s0[3] * wv;
                acc[4] += s1[0] * wv; acc[5] += s1[1] * wv; acc[6] += s1[2] * wv; acc[7] += s1[3] * wv; acc[8] += s2[0] * wv;
            }
            WG_SYNC();
#pragma unroll
            for (int c = 0; c < 9; ++c) red[(wave * 9 + c) * 64 + lane] = acc[c];
            WG_SYNC();
            for (int idx = tid; idx < 9 * 64; idx += 512) { const int c = idx >> 6, l = idx & 63; float v = A.in[9][(size_t)layer * 12288 + cg * 64 + l];
#pragma unroll
                for (int wv_ = 0; wv_ < 8; ++wv_) v += red[(wv_ * 9 + c) * 64 + l];
                ADA[((size_t)layer * 9 + c) * 12288 + cg * 64 + l] = v; }
        }
        WG_SYNC();
    }
    {
        float* rope = (float*)(ws + WS_ROPE);
        for (int idx = blockIdx.x * 512 + tid; idx < 2048 * 64; idx += gridDim.x * 512) {
            const int pos = idx >> 6, d = idx & 63, qtr = d >> 4, i = d & 15;
            const float inv = __builtin_amdgcn_exp2f(-(float)i * (13.287712379549449f / 16.0f));
            const float p = (qtr < 2) ? (float)(pos >> 6) : (float)(pos & 63);
            const float rev = p * inv * 0.15915494309189535f;
            rope[idx] = __builtin_amdgcn_cosf(rev); rope[2048 * 64 + idx] = __builtin_amdgcn_sinf(rev);
        }
    }
    {
        LAS float* scr = (LAS float*)(lds + wave * 16384);
        const int gw = blockIdx.x * 8 + wave, NGW = gridDim.x * 8;
        constexpr int I_EIN = 32 * 160, I_EOUT = 32 * 64, I_SIN = 32 * 324, I_SOUT = 64 * 64, I_FIN = 32 * 352, I_FOUT = 88 * 64, I_LRU = 8;
        constexpr int N0 = 2 * I_EIN, N1 = N0 + 2 * I_EOUT, N2 = N1 + 2 * I_SIN, N3 = N2 + 2 * I_SOUT, N4 = N3 + 4 * I_FIN, N5 = N4 + 4 * I_FOUT, N6 = N5 + 64 * I_LRU;
        for (int it = gw; it < N6; it += NGW) {
            if (it < N0) { const int mtx = it / I_EIN, r = it - mtx * I_EIN, kb = r / 160, nb = r - kb * 160;
                transpose_item(A.in[18] + (size_t)mtx * 2048 * 5120, 5120, (bf16_t*)(ws + WS_WEIN) + (size_t)mtx * 5120 * 2048, 2048, kb * 64, nb * 32, nb * 32, scr, lane); }
            else if (it < N1) { const int q = it - N0, mtx = q / I_EOUT, r = q - mtx * I_EOUT, kb = r / 64, nb = r - kb * 64;
                transpose_item(A.in[19] + (size_t)mtx * 2048 * 2048, 2048, (bf16_t*)(ws + WS_WEOUT) + (size_t)mtx * 2048 * 2048, 2048, kb * 64, nb * 32, nb * 32, scr, lane); }
            else if (it < N2) { const int q = it - N1, mtx = q / I_SIN, r = q - mtx * I_SIN, kb = r / 324, nb = r - kb * 324;
                transpose_item(A.in[24] + (size_t)mtx * 2048 * 10368, 10368, (bf16_t*)(ws + WS_WSIN) + (size_t)mtx * 10496 * 2048, 2048, kb * 64, nb * 32, nb * 32, scr, lane); }
            else if (it < N3) { const int q = it - N2, mtx = q / I_SOUT, r = q - mtx * I_SOUT, kb = r / 64, nb = r - kb * 64;
                transpose_item(A.in[31] + (size_t)mtx * 4096 * 2048, 2048, (bf16_t*)(ws + WS_WSOUT) + (size_t)mtx * 2048 * 4096, 4096, kb * 64, nb * 32, nb * 32, scr, lane); }
            else if (it < N4) { const int q = it - N3, mtx = q / I_FIN, r = q - mtx * I_FIN, kb = r / 352, nb = r - kb * 352;
                const int n0 = nb * 32; const int drow = n0 < 5632 ? (n0 >> 7) * 256 + (n0 & 127) : ((n0 - 5632) >> 7) * 256 + 128 + ((n0 - 5632) & 127);
                transpose_item(A.in[32] + (size_t)mtx * 2048 * 11264, 11264, (bf16_t*)(ws + WS_WFIN) + (size_t)mtx * 11264 * 2048, 2048, kb * 64, n0, drow, scr, lane); }
            else if (it < N5) { const int q = it - N4, mtx = q / I_FOUT, r = q - mtx * I_FOUT, kb = r / 64, nb = r - kb * 64;
                transpose_item(A.in[33] + (size_t)mtx * 5632 * 2048, 2048, (bf16_t*)(ws + WS_WFOUT) + (size_t)mtx * 2048 * 5632, 5632, kb * 64, nb * 32, nb * 32, scr, lane); }
            else { const int q = it - N5, mtx = q >> 3, r = q & 7, kb = r >> 2, nb = r & 3;
                const int blk = mtx & 7, gate = (mtx >> 3) & 1, jd = mtx >> 4;
                const float* src = (gate ? A.in[15] : A.in[13]) + ((size_t)jd * 8 + blk) * 16384;
                transpose_item(src, 128, (bf16_t*)(ws + WS_LRUW) + (size_t)mtx * 16384, 128, kb * 64, nb * 32, nb * 32, scr, lane); }
        }
        for (int idx = blockIdx.x * 512 + tid; idx < 2 * 128 * 2048 / 8; idx += gridDim.x * 512) {
            const int mtx = idx / (128 * 256), r = idx - mtx * (128 * 256);
            *(u32x4*)((bf16_t*)(ws + WS_WSIN) + (size_t)mtx * 10496 * 2048 + (size_t)10368 * 2048 + (size_t)r * 8) = (u32x4){0u, 0u, 0u, 0u};
        }
    }
}

__device__ __forceinline__ void phase_modulate(const Args& A, int layer, int which, bool from_x, int row_lo = 0, int row_hi = T, int wg_first = 0, int wg_count = -1) {
    const int tid = otid(), lane = tid & 63, wave = tid >> 6;
    if (wg_count < 0) wg_count = (int)gridDim.x;
    if ((int)blockIdx.x < wg_first || (int)blockIdx.x >= wg_first + wg_count) return;
    const int gw = ((int)blockIdx.x - wg_first) * 8 + wave, NGW = wg_count * 8;
    const float* g = A.in[10] + ((size_t)layer * 2 + which) * 2048;
    const float* ADA = (const float*)(A.ws + WS_ADA);
    bf16_t* H = (bf16_t*)(A.ws + WS_H); bf16_t* Y = (bf16_t*)(A.ws + WS_Y);
    for (int row = row_lo + gw; row < row_hi; row += NGW) {
        const int cond = cond_of_tok(row);
        const float* shift = ADA + ((size_t)layer * 9 + cond) * 12288 + (which * 3 + 0) * 2048;
        const float* scale = shift + 2048;
        float v[4][8]; float ss = 0.f;
        if (from_x) {
            const float* xr = row < TP ? A.in[0] + (size_t)row * 2048 : A.in[1] + (size_t)(row - TP) * 2048;
#pragma unroll
            for (int jj = 0; jj < 4; ++jj) { const int c = 8 * (lane + 64 * jj); const f32x4 a = *(const f32x4*)(xr + c), b = *(const f32x4*)(xr + c + 4);
                const u32x4 w = {pk2(a[0], a[1]), pk2(a[2], a[3]), pk2(b[0], b[1]), pk2(b[2], b[3])};
                *(u32x4*)(Y + (size_t)row * 2048 + c) = w; unpack8(w, v[jj]); }
        } else {
#pragma unroll
            for (int jj = 0; jj < 4; ++jj) unpack8(*(const u32x4*)(Y + (size_t)row * 2048 + 8 * (lane + 64 * jj)), v[jj]);
        }
#pragma unroll
        for (int jj = 0; jj < 4; ++jj)
#pragma unroll
            for (int i = 0; i < 8; ++i) ss += v[jj][i] * v[jj][i];
        const float rstd = 1.0f / sqrtf(wave_sum(ss) * (1.f / 2048.f) + EPS);
#pragma unroll
        for (int jj = 0; jj < 4; ++jj) { const int c = 8 * (lane + 64 * jj);
            float o[8];
#pragma unroll
            for (int hf = 0; hf < 2; ++hf) { const f32x4 gg = *(const f32x4*)(g + c + 4 * hf), sc = *(const f32x4*)(scale + c + 4 * hf), sh = *(const f32x4*)(shift + c + 4 * hf);
#pragma unroll
                for (int i = 0; i < 4; ++i) o[4 * hf + i] = v[jj][4 * hf + i] * rstd * gg[i] * (sc[i] + 1.0f) + sh[i]; }
            *(u32x4*)(H + (size_t)row * 2048 + c) = pack8(o); }
    }
}

constexpr float QSCALE = 0.125f * 1.4426950408889634f;

template <bool F32SRC>
__device__ __forceinline__ void vt_tile(const void* src, size_t src_ld, bf16_t* dst, int Lk, LAS bf16_t* scr  , int lane) {
#pragma unroll 4
    for (int i = 0; i < 16; ++i) { const int p = lane + 64 * i, row = p >> 4, pc = p & 15;
        u32x4 v;
        if (F32SRC) { const float* s = (const float*)src + (size_t)row * src_ld + pc * 8; const f32x4 a = *(const f32x4*)s, b = *(const f32x4*)(s + 4);
            v.x = pk2(a[0], a[1]); v.y = pk2(a[2], a[3]); v.z = pk2(b[0], b[1]); v.w = pk2(b[2], b[3]); }
        else v = *(const u32x4*)((const bf16_t*)src + (size_t)row * src_ld + pc * 8);
        *(LAS u32x4*)(scr + row * 128 + pc * 8) = v; }
    asm volatile("s_waitcnt lgkmcnt(0)" ::: "memory");
#pragma unroll 4
    for (int i = 0; i < 16; ++i) { const int p = lane + 64 * i, dv = p & 127, tg = p >> 7;
        unsigned short e[8];
#pragma unroll
        for (int k = 0; k < 8; ++k) e[k] = scr[(8 * tg + k) * 128 + dv];
        u32x4 v; v.x = e[0] | ((unsigned)e[1] << 16); v.y = e[2] | ((unsigned)e[3] << 16); v.z = e[4] | ((unsigned)e[5] << 16); v.w = e[6] | ((unsigned)e[7] << 16);
        *(u32x4*)(dst + (size_t)dv * Lk + 8 * tg) = v; }
    asm volatile("s_waitcnt lgkmcnt(0)" ::: "memory");
}

__device__ __forceinline__ void phase_qkv_prep(const Args& A, LAS unsigned char* lds, int j, int u_lo = 0, int u_hi = 352, int wg_first = 0, int wg_count = -1) {
    const int tid = otid(), lane = tid & 63, wave = tid >> 6;
    unsigned char* ws = A.ws;
    const bf16_t* U5 = (const bf16_t*)(ws + WS_U5);
    bf16_t* Qb = (bf16_t*)(ws + WS_Q); bf16_t* Kb = (bf16_t*)(ws + WS_K); bf16_t* KC = (bf16_t*)(ws + WS_KC);
    bf16_t* VTP = (bf16_t*)(ws + WS_VTP); bf16_t* VTS = (bf16_t*)(ws + WS_VTS);
    const float* rope = (const float*)(ws + WS_ROPE);
    LAS bf16_t* scr = (LAS bf16_t*)(lds + wave * 16384);
    const int mq = (lane >> 2) & 1, aq = lane & 3;
    float qn[16], kn[16];
#pragma unroll
    for (int i = 0; i < 16; ++i) { qn[i] = A.in[20][((size_t)j * 2 + mq) * 64 + aq * 16 + i]; kn[i] = A.in[21][((size_t)j * 2 + mq) * 64 + aq * 16 + i]; }
    if (wg_count < 0) wg_count = (int)gridDim.x;
    if ((int)blockIdx.x < wg_first || (int)blockIdx.x >= wg_first + wg_count) return;
    for (int u = u_lo + (int)blockIdx.x - wg_first; u < u_hi; u += wg_count) {
        if (u < 320) {
            const int t0 = u * 64;
            const int sample = t0 >= TP, b = sample ? (t0 - TP) >> 11 : t0 >> 8, l0 = sample ? (t0 - TP) & 2047 : t0 & 255;
            for (int tt = 0; tt < 8; ++tt) {
                const int tok = wave * 8 + tt, t = t0 + tok, l = l0 + tok;
                float cs[16], sn[16];
                if (sample) {
#pragma unroll
                    for (int i = 0; i < 16; i += 4) { const f32x4 c4 = *(const f32x4*)(rope + (size_t)l * 64 + aq * 16 + i), s4 = *(const f32x4*)(rope + 2048 * 64 + (size_t)l * 64 + aq * 16 + i);
                        cs[i] = c4[0]; cs[i + 1] = c4[1]; cs[i + 2] = c4[2]; cs[i + 3] = c4[3]; sn[i] = s4[0]; sn[i + 1] = s4[1]; sn[i + 2] = s4[2]; sn[i + 3] = s4[3]; }
                }
#pragma unroll
                for (int qk = 0; qk < 2; ++qk) {
                    const bf16_t* src = U5 + (size_t)t * 5120 + (qk == 0 ? 2048 : 3072) + 16 * lane;
                    float x[16]; { float a[8], c[8]; unpack8(*(const u32x4*)src, a); unpack8(*(const u32x4*)(src + 8), c);
#pragma unroll
                        for (int i = 0; i < 8; ++i) { x[i] = a[i]; x[8 + i] = c[i]; } }
                    float ss = 0.f;
#pragma unroll
                    for (int i = 0; i < 16; ++i) ss += x[i] * x[i];
                    ss += quad_xor1(ss); ss += quad_xor2(ss);
                    const float rstd = 1.0f / sqrtf(ss * (1.f / 64.f) + EPS);
#pragma unroll
                    for (int i = 0; i < 16; ++i) x[i] = x[i] * rstd * (qk == 0 ? qn[i] : kn[i]);
                    if (qk == 1 && !sample) {
                        float* o = A.out + OUT_K + (((size_t)b * 2 + j) * 256 + l) * 1024 + 16 * lane;
#pragma unroll
                        for (int i = 0; i < 16; i += 4) *(f32x4*)(o + i) = (f32x4){x[i], x[i + 1], x[i + 2], x[i + 3]};
                    }
                    if (sample) {
#pragma unroll
                        for (int i = 0; i < 16; ++i) { const float partner = quad_xor1(x[i]); x[i] = (aq & 1) ? (x[i] * cs[i] + partner * sn[i]) : (x[i] * cs[i] - partner * sn[i]); }
                    }
                    if (qk == 0) {
#pragma unroll
                        for (int i = 0; i < 16; ++i) x[i] *= QSCALE;
                    }
                    bf16_t* dst = (qk == 0 ? Qb : Kb) + (size_t)t * 1024 + 16 * lane;
                    u32x4 w0, w1; w0.x = pk2(x[0], x[1]); w0.y = pk2(x[2], x[3]); w0.z = pk2(x[4], x[5]); w0.w = pk2(x[6], x[7]);
                    w1.x = pk2(x[8], x[9]); w1.y = pk2(x[10], x[11]); w1.z = pk2(x[12], x[13]); w1.w = pk2(x[14], x[15]);
                    *(u32x4*)dst = w0; *(u32x4*)(dst + 8) = w1;
                }
                if (!sample) {
                    const bf16_t* src = U5 + (size_t)t * 5120 + 4096 + 16 * lane;
                    float a[8], c[8]; unpack8(*(const u32x4*)src, a); unpack8(*(const u32x4*)(src + 8), c);
                    float* o = A.out + OUT_V + (((size_t)b * 2 + j) * 256 + l) * 1024 + 16 * lane;
                    *(f32x4*)(o) = (f32x4){a[0], a[1], a[2], a[3]}; *(f32x4*)(o + 4) = (f32x4){a[4], a[5], a[6], a[7]};
                    *(f32x4*)(o + 8) = (f32x4){c[0], c[1], c[2], c[3]}; *(f32x4*)(o + 12) = (f32x4){c[4], c[5], c[6], c[7]};
                }
            }
            {
                const int h = wave;
                bf16_t* dst = sample ? VTS + (((size_t)b * 8 + h) * 128) * 2304 + l0 : VTP + (((size_t)b * 8 + h) * 128) * 256 + l0;
                vt_tile<false>(U5 + (size_t)t0 * 5120 + 4096 + h * 128, 5120, dst, sample ? 2304 : 256, scr, lane);
            }
        } else {
            const int uu = u - 320, b = uu >> 2, k0 = (uu & 3) * 64;
            const float* ck = A.in[3] + (((size_t)b * 2 + j) * 256 + k0) * 1024;
            for (int idx = tid; idx < 64 * 1024 / 8; idx += 512) { const float* s = ck + (size_t)idx * 8; const f32x4 a = *(const f32x4*)s, c = *(const f32x4*)(s + 4);
                u32x4 v; v.x = pk2(a[0], a[1]); v.y = pk2(a[2], a[3]); v.z = pk2(c[0], c[1]); v.w = pk2(c[2], c[3]);
                *(u32x4*)(KC + ((size_t)b * 256 + k0) * 1024 + (size_t)idx * 8) = v; }
            const int h = wave;
            const float* cv = A.in[4] + (((size_t)b * 2 + j) * 256 + k0) * 1024 + h * 128;
            vt_tile<true>(cv, 1024, VTS + (((size_t)b * 8 + h) * 128) * 2304 + 2048 + k0, 2304, scr, lane);
        }
    }
}

__device__ __forceinline__ void lru_load_rows(const Args& A, int ci, int kblk, u32x4 (&rows)[7]) {
    const int tid = otid(), oct = tid & 15, tq = tid >> 4;
    const bf16_t* U5 = (const bf16_t*)(A.ws + WS_U5);
    const int t0 = ci * 128, sample = t0 >= TP, l0 = sample ? (t0 - TP) & 2047 : t0 & 255, L = sample ? 2048 : 256;
#pragma unroll
    for (int k = 0; k < 7; ++k) { const int ll = l0 + 4 * tq - 2 + k;
        rows[k] = (ll >= 0 && ll < L) ? *(const u32x4*)(U5 + (size_t)(t0 + 4 * tq - 2 + k) * 5120 + 1024 + kblk * 128 + oct * 8) : (u32x4){0u, 0u, 0u, 0u}; }
}
template <int PASS>
__device__ __forceinline__ void lru_unit(const Args& A, LAS unsigned char* lds, int j, int ci, int kblk, u32x4 (&rows)[7], int ci_next  ) {
    const int tid = otid(), lane = tid & 63, wave = tid >> 6, r = lane & 15, kq = lane >> 4;
    unsigned char* ws = A.ws;
    const bf16_t* U5 = (const bf16_t*)(ws + WS_U5);
    const bf16_t* LRUW = (const bf16_t*)(ws + WS_LRUW);
    f32x2* CHS = (f32x2*)(ws + WS_CHS);
    const int t0 = ci * 128;
    const int sample = t0 >= TP, b = sample ? (t0 - TP) >> 11 : t0 >> 8, l0 = sample ? (t0 - TP) & 2047 : t0 & 255, L = sample ? 2048 : 256;
    const int cis = l0 >> 7, nch = L >> 7, cbase = ci - cis;
    PROF_DECL
    PROF_START(0); PROF_START(1);
    LAS bf16_t* X = (LAS bf16_t*)lds;
    u32x4 wfr[4], wfi[4];
    {
        const bf16_t* Wr0 = LRUW + ((((size_t)j * 2 + 0) * 2 + 0) * 8 + kblk) * 16384 + (size_t)(wave * 16 + r) * 128 + 8 * kq;
        const bf16_t* Wi0 = LRUW + ((((size_t)j * 2 + 0) * 2 + 1) * 8 + kblk) * 16384 + (size_t)(wave * 16 + r) * 128 + 8 * kq;
#pragma unroll
        for (int ks = 0; ks < 4; ++ks) { wfr[ks] = *(const u32x4*)(Wr0 + 32 * ks); wfi[ks] = *(const u32x4*)(Wi0 + 32 * ks); }
    }
    f32x4 pbr[2], pbi[2], plam[2];
    { const int C0_ = kblk * 128 + wave * 16 + 4 * kq;
#pragma unroll
      for (int d = 0; d < 2; ++d) { pbr[d] = *(const f32x4*)(A.in[14] + ((size_t)j * 2 + d) * 1024 + C0_); pbi[d] = *(const f32x4*)(A.in[16] + ((size_t)j * 2 + d) * 1024 + C0_); plam[d] = *(const f32x4*)(A.in[17] + ((size_t)j * 2 + d) * 1024 + C0_); } }
    WG_SYNC();
    PROF_STOP(1, 46); PROF_START(1);
    {
        const int oct = tid & 15, tq = tid >> 4, ch0 = kblk * 128 + oct * 8;
        float cw[4][8], o[4][8];
#pragma unroll
        for (int tp = 0; tp < 4; ++tp) { const f32x4 a = *(const f32x4*)(A.in[11] + ((size_t)j * 4 + tp) * 1024 + ch0), c = *(const f32x4*)(A.in[11] + ((size_t)j * 4 + tp) * 1024 + ch0 + 4);
            cw[tp][0] = a[0]; cw[tp][1] = a[1]; cw[tp][2] = a[2]; cw[tp][3] = a[3]; cw[tp][4] = c[0]; cw[tp][5] = c[1]; cw[tp][6] = c[2]; cw[tp][7] = c[3]; }
        { const f32x4 a = *(const f32x4*)(A.in[12] + (size_t)j * 1024 + ch0), c = *(const f32x4*)(A.in[12] + (size_t)j * 1024 + ch0 + 4);
#pragma unroll
            for (int i = 0; i < 4; ++i) { o[i][0] = a[0]; o[i][1] = a[1]; o[i][2] = a[2]; o[i][3] = a[3]; o[i][4] = c[0]; o[i][5] = c[1]; o[i][6] = c[2]; o[i][7] = c[3]; } }
#pragma unroll
        for (int k = 0; k < 7; ++k) { float x[8]; unpack8(rows[k], x);
#pragma unroll
            for (int i = 0; i < 4; ++i) { const int tp = k - i;
                if (tp >= 0 && tp < 4) {
#pragma unroll
                    for (int c = 0; c < 8; ++c) o[i][c] = fmaf(x[c], cw[tp][c], o[i][c]); } } }
#pragma unroll
        for (int i = 0; i < 4; ++i) *(LAS u32x4*)(X + (4 * tq + i) * 136 + oct * 8) = pack8(o[i]);
        if (ci_next >= 0) lru_load_rows(A, ci_next, kblk, rows);
    }
    PROF_STOP(1, 47); PROF_START(1);
    WG_SYNC();
    PROF_STOP(1, 41);
    const int chl = wave * 16 + 4 * kq, C0 = kblk * 128 + chl;
    float hsum[8][4];
#pragma unroll
    for (int nt = 0; nt < 8; ++nt)
#pragma unroll
        for (int e = 0; e < 4; ++e) hsum[nt][e] = 0.f;
#pragma unroll
    for (int d = 0; d < 2; ++d) {
        f32x4 ar[8], ai[8];
#pragma unroll
        for (int nt = 0; nt < 8; ++nt) { ar[nt] = (f32x4){0.f, 0.f, 0.f, 0.f}; ai[nt] = (f32x4){0.f, 0.f, 0.f, 0.f}; }
        PROF_START(1);
#pragma unroll
        for (int ks = 0; ks < 4; ++ks) {
            const bf16x8 fr_ = as_bf16x8(wfr[ks]), fi_ = as_bf16x8(wfi[ks]);
#pragma unroll
            for (int nt = 0; nt < 8; ++nt) { const bf16x8 fb = *(const LAS bf16x8*)(X + (16 * nt + r) * 136 + 32 * ks + 8 * kq);
                ar[nt] = MFMA16(fr_, fb, ar[nt]); ai[nt] = MFMA16(fi_, fb, ai[nt]); }
        }
        if (d == 0) {
            const bf16_t* Wr1 = LRUW + ((((size_t)j * 2 + 1) * 2 + 0) * 8 + kblk) * 16384 + (size_t)(wave * 16 + r) * 128 + 8 * kq;
            const bf16_t* Wi1 = LRUW + ((((size_t)j * 2 + 1) * 2 + 1) * 8 + kblk) * 16384 + (size_t)(wave * 16 + r) * 128 + 8 * kq;
#pragma unroll
            for (int ks = 0; ks < 4; ++ks) { wfr[ks] = *(const u32x4*)(Wr1 + 32 * ks); wfi[ks] = *(const u32x4*)(Wi1 + 32 * ks); }
        }
        f32x4 csum[2];
        if (PASS == 2) {
            if (r < nch) { const f32x4* cp = (const f32x4*)(CHS + ((size_t)(cbase + r) * 2 + d) * 1024 + C0); csum[0] = cp[0]; csum[1] = cp[1]; }
            else { csum[0] = (f32x4){1.f, 0.f, 1.f, 0.f}; csum[1] = (f32x4){1.f, 0.f, 1.f, 0.f}; } }
        PROF_STOP(1, 42); PROF_START(1);
        float br[4], bi[4], sp[4];
#pragma unroll
        for (int e = 0; e < 4; ++e) { br[e] = -1.4426950408889634f * pbr[d][e]; bi[e] = -1.4426950408889634f * pbi[d][e]; sp[e] = -8.0f * fsoftplus(-plam[d][e]); }
#pragma unroll
        for (int nt = 0; nt < 8; ++nt) {
            const u32x2 xv = *(const LAS u32x2*)(X + (16 * nt + r) * 136 + chl);
            const float xc[4] = {bflo(xv.x), bfhi(xv.x), bflo(xv.y), bfhi(xv.y)};
#pragma unroll
            for (int e = 0; e < 4; ++e) {
                const float rr = __builtin_amdgcn_rcpf(1.0f + __builtin_amdgcn_exp2f(fmaf(ar[nt][e], -1.4426950408889634f, br[e])));
                const float gi = __builtin_amdgcn_rcpf(1.0f + __builtin_amdgcn_exp2f(fmaf(ai[nt][e], -1.4426950408889634f, bi[e])));
                const float la = rr * sp[e];
                const float av = __builtin_amdgcn_exp2f(1.4426950408889634f * la);
                const float t2 = 2.0f * la; const float om_s = -t2 * (1.0f + t2 * (0.5f + t2 * (0.16666667f + t2 * 0.041666668f))), om_d = 1.0f - av * av; const float wsel = t2 > -0.03f ? 1.0f : 0.0f; const float om = fmaf(wsel, om_s - om_d, om_d);
                const float bt = __builtin_amdgcn_sqrtf(om) * gi * xc[e];
                ar[nt][e] = av; ai[nt][e] = bt;
            }
            __builtin_amdgcn_sched_barrier(0);
        }
        PROF_STOP(1, 43); PROF_START(1);
#define LRU_SCAN4(SH) asm volatile("s_nop 4\n\t" \
            "v_fmac_f32_dpp %0, %0, %4 " SH ":1 row_mask:0xf bank_mask:0xf\n\tv_fmac_f32_dpp %1, %1, %5 " SH ":1 row_mask:0xf bank_mask:0xf\n\tv_fmac_f32_dpp %2, %2, %6 " SH ":1 row_mask:0xf bank_mask:0xf\n\tv_fmac_f32_dpp %3, %3, %7 " SH ":1 row_mask:0xf bank_mask:0xf\n\t" \
            "v_mul_f32_dpp %4, %4, %4 " SH ":1 row_mask:0xf bank_mask:0xf\n\tv_mul_f32_dpp %5, %5, %5 " SH ":1 row_mask:0xf bank_mask:0xf\n\tv_mul_f32_dpp %6, %6, %6 " SH ":1 row_mask:0xf bank_mask:0xf\n\tv_mul_f32_dpp %7, %7, %7 " SH ":1 row_mask:0xf bank_mask:0xf\n\t" \
            "v_fmac_f32_dpp %0, %0, %4 " SH ":2 row_mask:0xf bank_mask:0xf\n\tv_fmac_f32_dpp %1, %1, %5 " SH ":2 row_mask:0xf bank_mask:0xf\n\tv_fmac_f32_dpp %2, %2, %6 " SH ":2 row_mask:0xf bank_mask:0xf\n\tv_fmac_f32_dpp %3, %3, %7 " SH ":2 row_mask:0xf bank_mask:0xf\n\t" \
            "v_mul_f32_dpp %4, %4, %4 " SH ":2 row_mask:0xf bank_mask:0xf\n\tv_mul_f32_dpp %5, %5, %5 " SH ":2 row_mask:0xf bank_mask:0xf\n\tv_mul_f32_dpp %6, %6, %6 " SH ":2 row_mask:0xf bank_mask:0xf\n\tv_mul_f32_dpp %7, %7, %7 " SH ":2 row_mask:0xf bank_mask:0xf\n\t" \
            "v_fmac_f32_dpp %0, %0, %4 " SH ":4 row_mask:0xf bank_mask:0xf\n\tv_fmac_f32_dpp %1, %1, %5 " SH ":4 row_mask:0xf bank_mask:0xf\n\tv_fmac_f32_dpp %2, %2, %6 " SH ":4 row_mask:0xf bank_mask:0xf\n\tv_fmac_f32_dpp %3, %3, %7 " SH ":4 row_mask:0xf bank_mask:0xf\n\t" \
            "v_mul_f32_dpp %4, %4, %4 " SH ":4 row_mask:0xf bank_mask:0xf\n\tv_mul_f32_dpp %5, %5, %5 " SH ":4 row_mask:0xf bank_mask:0xf\n\tv_mul_f32_dpp %6, %6, %6 " SH ":4 row_mask:0xf bank_mask:0xf\n\tv_mul_f32_dpp %7, %7, %7 " SH ":4 row_mask:0xf bank_mask:0xf\n\t" \
            "v_fmac_f32_dpp %0, %0, %4 " SH ":8 row_mask:0xf bank_mask:0xf\n\tv_fmac_f32_dpp %1, %1, %5 " SH ":8 row_mask:0xf bank_mask:0xf\n\tv_fmac_f32_dpp %2, %2, %6 " SH ":8 row_mask:0xf bank_mask:0xf\n\tv_fmac_f32_dpp %3, %3, %7 " SH ":8 row_mask:0xf bank_mask:0xf\n\t" \
            "v_mul_f32_dpp %4, %4, %4 " SH ":8 row_mask:0xf bank_mask:0xf\n\tv_mul_f32_dpp %5, %5, %5 " SH ":8 row_mask:0xf bank_mask:0xf\n\tv_mul_f32_dpp %6, %6, %6 " SH ":8 row_mask:0xf bank_mask:0xf\n\tv_mul_f32_dpp %7, %7, %7 " SH ":8 row_mask:0xf bank_mask:0xf\n\ts_nop 1" \
            : "+v"(B0_), "+v"(B1_), "+v"(B2_), "+v"(B3_), "+v"(A0_), "+v"(A1_), "+v"(A2_), "+v"(A3_))
#pragma unroll
        for (int nt = 0; nt < 8; ++nt) {
            float A0_ = ar[nt][0], A1_ = ar[nt][1], A2_ = ar[nt][2], A3_ = ar[nt][3], B0_ = ai[nt][0], B1_ = ai[nt][1], B2_ = ai[nt][2], B3_ = ai[nt][3];
            if (d == 0) LRU_SCAN4("row_shr"); else LRU_SCAN4("row_shl");
            ar[nt] = (f32x4){A0_, A1_, A2_, A3_}; ai[nt] = (f32x4){B0_, B1_, B2_, B3_};
        }
        PROF_STOP(1, 44); PROF_START(1);
        if (PASS == 1) {
            unsigned pkv[8][4];
#pragma unroll
            for (int e = 0; e < 4; ++e) {
                float P = 1.f, E = 0.f;
#pragma unroll
                for (int q = 0; q < 8; ++q) { const int nt = d == 0 ? q : 7 - q; const int sl = d == 0 ? 15 : 0;
                    pkv[nt][e] = pk2(ar[nt][e] * P, ar[nt][e] * E + ai[nt][e]);
                    const float At = d == 0 ? row_bcast_hi(ar[nt][e]) : row_bcast_lo(ar[nt][e]), Bt = d == 0 ? row_bcast_hi(ai[nt][e]) : row_bcast_lo(ai[nt][e]);
                    E = At * E + Bt; P = P * At; }
                if (r == 0) CHS[((size_t)ci * 2 + d) * 1024 + C0 + e] = (f32x2){P, E};
            }
            unsigned* LR = (unsigned*)(ws + WS_LR);
#pragma unroll
            for (int nt = 0; nt < 8; ++nt) *(u32x4*)(LR + ((size_t)(t0 + 16 * nt + r) * 2 + d) * 1024 + C0) = (u32x4){pkv[nt][0], pkv[nt][1], pkv[nt][2], pkv[nt][3]};
            PROF_STOP(1, 45);
        } else {
            float cA[4], cB[4];
            {
                float A0_ = csum[0][0], B0_ = csum[0][1], A1_ = csum[0][2], B1_ = csum[0][3], A2_ = csum[1][0], B2_ = csum[1][1], A3_ = csum[1][2], B3_ = csum[1][3];
                if (d == 0) LRU_SCAN4("row_shr"); else LRU_SCAN4("row_shl");
                cA[0] = A0_; cA[1] = A1_; cA[2] = A2_; cA[3] = A3_; cB[0] = B0_; cB[1] = B1_; cB[2] = B2_; cB[3] = B3_;
            }
#pragma unroll
            for (int e = 0; e < 4; ++e) {
                float h = sample ? A.in[5][(((size_t)b * 2 + j) * 2 + d) * 1024 + C0 + e] : 0.f;
                {
                    const int src = d == 0 ? cis - 1 : cis + 1;
                    const float Ac = __shfl(cA[e], src & 15, 16), Bc = __shfl(cB[e], src & 15, 16);
                    if (d == 0 ? (cis > 0) : (cis + 1 < nch)) h = Ac * h + Bc;
                }
#pragma unroll
                for (int q = 0; q < 8; ++q) { const int nt = d == 0 ? q : 7 - q; const int sl = d == 0 ? 15 : 0;
                    const float hv = ar[nt][e] * h + ai[nt][e];
                    hsum[nt][e] += hv;
                    h = d == 0 ? row_bcast_hi(hv) : row_bcast_lo(hv); }
                if (!sample && r == 0) {
                    if (d == 0 && cis == nch - 1) A.out[OUT_LRU + (((size_t)b * 2 + j) * 2 + 0) * 1024 + C0 + e] = h;
                    if (d == 1 && cis == 0)       A.out[OUT_LRU + (((size_t)b * 2 + j) * 2 + 1) * 1024 + C0 + e] = h;
                }
            }
        }
    }
    PROF_STOP(0, 40);
    if (PASS == 2) {
        bf16_t* MIX = (bf16_t*)(ws + WS_MIXE);
#pragma unroll
        for (int nt = 0; nt < 8; ++nt) { const int t = t0 + 16 * nt + r;
            const u32x2 gv = *(const u32x2*)(U5 + (size_t)t * 5120 + C0);
            const float g[4] = {bflo(gv.x), bfhi(gv.x), bflo(gv.y), bfhi(gv.y)};
            u32x2 o; o.x = pk2(hsum[nt][0] * fgelu_tanh(g[0]), hsum[nt][1] * fgelu_tanh(g[1])); o.y = pk2(hsum[nt][2] * fgelu_tanh(g[2]), hsum[nt][3] * fgelu_tanh(g[3]));
            *(u32x2*)(MIX + (size_t)t * 2048 + C0) = o; }
    }
}

__device__ __forceinline__ void lru_finish(const Args& A, int j, int ci, int cg) {
    const int tid = otid(), lane = tid & 63, r = lane & 15, kq = lane >> 4;
    unsigned char* ws = A.ws;
    const bf16_t* U5 = (const bf16_t*)(ws + WS_U5);
    const f32x2* CHS = (const f32x2*)(ws + WS_CHS);
    const unsigned* LR = (const unsigned*)(ws + WS_LR);
    bf16_t* MIX = (bf16_t*)(ws + WS_MIXE);
    const int t0 = ci * 128;
    const int sample = t0 >= TP, b = sample ? (t0 - TP) >> 11 : t0 >> 8, l0 = sample ? (t0 - TP) & 2047 : t0 & 255, L = sample ? 2048 : 256;
    const int cis = l0 >> 7, nch = L >> 7, cbase = ci - cis;
    const int C0 = cg * 16 + 4 * kq;
    float carry[2][4];
#pragma unroll
    for (int d = 0; d < 2; ++d) {
        f32x4 c0, c1;
        if (r < nch) { const f32x4* cp = (const f32x4*)(CHS + ((size_t)(cbase + r) * 2 + d) * 1024 + C0); c0 = cp[0]; c1 = cp[1]; }
        else { c0 = (f32x4){1.f, 0.f, 1.f, 0.f}; c1 = c0; }
        float A0_ = c0[0], B0_ = c0[1], A1_ = c0[2], B1_ = c0[3], A2_ = c1[0], B2_ = c1[1], A3_ = c1[2], B3_ = c1[3];
        if (d == 0) LRU_SCAN4("row_shr"); else LRU_SCAN4("row_shl");
        const float cA[4] = {A0_, A1_, A2_, A3_}, cB[4] = {B0_, B1_, B2_, B3_};
        const int src = d == 0 ? cis - 1 : cis + 1;
        f32x4 h0 = (f32x4){0.f, 0.f, 0.f, 0.f};
        if (sample) h0 = *(const f32x4*)(A.in[5] + (((size_t)b * 2 + j) * 2 + d) * 1024 + C0);
#pragma unroll
        for (int e = 0; e < 4; ++e) { const float Ac = __shfl(cA[e], src & 15, 16), Bc = __shfl(cB[e], src & 15, 16);
            carry[d][e] = (d == 0 ? (cis > 0) : (cis + 1 < nch)) ? Ac * h0[e] + Bc : h0[e]; }
    }
#pragma unroll
    for (int nt = 0; nt < 8; ++nt) { const size_t t = (size_t)t0 + 16 * nt + r;
        const u32x4 pf_ = *(const u32x4*)(LR + (t * 2 + 0) * 1024 + C0), pb_ = *(const u32x4*)(LR + (t * 2 + 1) * 1024 + C0);
        const u32x2 gv = *(const u32x2*)(U5 + t * 5120 + C0);
        const unsigned pfw[4] = {pf_.x, pf_.y, pf_.z, pf_.w}, pbw[4] = {pb_.x, pb_.y, pb_.z, pb_.w};
        const float g[4] = {bflo(gv.x), bfhi(gv.x), bflo(gv.y), bfhi(gv.y)};
        float hf[4], hb[4], o[4];
#pragma unroll
        for (int e = 0; e < 4; ++e) { hf[e] = bflo(pfw[e]) * carry[0][e] + bfhi(pfw[e]); hb[e] = bflo(pbw[e]) * carry[1][e] + bfhi(pbw[e]); o[e] = (hf[e] + hb[e]) * fgelu_tanh(g[e]); }
        u32x2 w; w.x = pk2(o[0], o[1]); w.y = pk2(o[2], o[3]);
        *(u32x2*)(MIX + t * 2048 + C0) = w;
        if (!sample) {
            if (nt == 7 && r == 15 && cis == nch - 1) *(f32x4*)(A.out + OUT_LRU + (((size_t)b * 2 + j) * 2 + 0) * 1024 + C0) = (f32x4){hf[0], hf[1], hf[2], hf[3]};
            if (nt == 0 && r == 0 && cis == 0)        *(f32x4*)(A.out + OUT_LRU + (((size_t)b * 2 + j) * 2 + 1) * 1024 + C0) = (f32x4){hb[0], hb[1], hb[2], hb[3]};
        }
    }
}

__device__ __forceinline__ void attn_prefetch(const Args& A, int sample, int b, int h, int qb, bf16x8 (&qf)[2][2], u32x4 (&pk_)[2], u32x4 (&pv_)[2]) {
    const int tid = otid(), lane = tid & 63, wave = tid >> 6, r = lane & 15, kq = lane >> 4;
    unsigned char* ws = A.ws;
    const bf16_t* Qb = (const bf16_t*)(ws + WS_Q); const bf16_t* Kb = (const bf16_t*)(ws + WS_K);
    const int Lk = sample ? 2304 : 256;
    const int tbase = sample ? TP + b * 2048 : b * 256;
    const bf16_t* VT = sample ? (const bf16_t*)(ws + WS_VTS) + (((size_t)b * 8 + h) * 128) * 2304 : (const bf16_t*)(ws + WS_VTP) + (((size_t)b * 8 + h) * 128) * 256;
    const int m = wave >> 2, qs = (wave & 3) * 32, q0 = tbase + qb * 128 + qs;
#pragma unroll
    for (int i_ = 0; i_ < 2; ++i_) { const int p_ = tid + 512 * i_;
        pk_[i_] = *(const u32x4*)(Kb + (size_t)(tbase + (p_ >> 4)) * 1024 + h * 128 + (p_ & 15) * 8);
        pv_[i_] = *(const u32x4*)(VT + (size_t)(p_ >> 3) * Lk + (p_ & 7) * 8); }
#pragma unroll
    for (int qt = 0; qt < 2; ++qt)
#pragma unroll
        for (int ks = 0; ks < 2; ++ks) qf[qt][ks] = as_bf16x8(*(const u32x4*)(Qb + (size_t)(q0 + 16 * qt + r) * 1024 + h * 128 + m * 64 + 32 * ks + 8 * kq));
}
__device__ __forceinline__ void attn_unit(const Args& A, LAS unsigned char* lds, int j, int sample, int b, int h, int qb, float lam, float lam_init,
                                          int nsample, int nb, int nh, int nqb, bf16x8 (&qf)[2][2], u32x4 (&pk_)[2], u32x4 (&pv_)[2]) {
    const int tid = otid(), lane = tid & 63, wave = tid >> 6, r = lane & 15, kq = lane >> 4;
    unsigned char* ws = A.ws;
    const bf16_t* Qb = (const bf16_t*)(ws + WS_Q); const bf16_t* Kb = (const bf16_t*)(ws + WS_K); const bf16_t* KC = (const bf16_t*)(ws + WS_KC);
    PROF_DECL
    PROF_START(0);
    const int L = sample ? 2048 : 256, Lk = sample ? 2304 : 256;
    const int tbase = sample ? TP + b * 2048 : b * 256;
    const bf16_t* VT = sample ? (const bf16_t*)(ws + WS_VTS) + (((size_t)b * 8 + h) * 128) * 2304 : (const bf16_t*)(ws + WS_VTP) + (((size_t)b * 8 + h) * 128) * 256;
    const int m = wave >> 2, qs = (wave & 3) * 32, q0 = tbase + qb * 128 + qs;
    constexpr int KT_BYTES = 64 * 136 * 2, VT_BYTES = 128 * 72 * 2;
    f32x4 o[8][2];
#pragma unroll
    for (int dt = 0; dt < 8; ++dt) { o[dt][0] = (f32x4){0.f, 0.f, 0.f, 0.f}; o[dt][1] = (f32x4){0.f, 0.f, 0.f, 0.f}; }
    float mrun[2] = {-1e30f, -1e30f}, lrun[2] = {0.f, 0.f};
    const int nkt = Lk >> 6;
#define ATT_LOAD(kt_) do { const int key0_ = (kt_) * 64; \
        _Pragma("unroll") for (int i_ = 0; i_ < 2; ++i_) { const int p_ = tid + 512 * i_; \
            { const int row_ = p_ >> 4, pc_ = p_ & 15, key_ = key0_ + row_; \
              const bf16_t* s_ = key_ < L ? Kb + (size_t)(tbase + key_) * 1024 + h * 128 + pc_ * 8 : KC + ((size_t)b * 256 + (key_ - 2048)) * 1024 + h * 128 + pc_ * 8; \
              pk_[i_] = *(const u32x4*)s_; } \
            { const int row_ = p_ >> 3, pc_ = p_ & 7; pv_[i_] = *(const u32x4*)(VT + (size_t)row_ * Lk + key0_ + pc_ * 8); } } } while (0)
#define ATT_STORE(buf_) do { LAS unsigned char* kb_ = lds + (buf_) * KT_BYTES; LAS unsigned char* vb_ = lds + 2 * KT_BYTES + (buf_) * VT_BYTES; \
        _Pragma("unroll") for (int i_ = 0; i_ < 2; ++i_) { const int p_ = tid + 512 * i_; \
            *(LAS u32x4*)(kb_ + ((p_ >> 4) * 136 + (p_ & 15) * 8) * 2) = pk_[i_]; \
            *(LAS u32x4*)(vb_ + ((p_ >> 3) * 72 + (p_ & 7) * 8) * 2) = pv_[i_]; } } while (0)
    WG_SYNC();
    ATT_STORE(0);
    WG_SYNC();
    for (int kt = 0; kt < nkt; ++kt) {
        PROF_START(1);
        if (kt + 1 < nkt) ATT_LOAD(kt + 1);
        const LAS bf16_t* Kl = (const LAS bf16_t*)(lds + (kt & 1) * KT_BYTES);
        const LAS bf16_t* Vl = (const LAS bf16_t*)(lds + 2 * KT_BYTES + (kt & 1) * VT_BYTES);
        f32x4 s[4][2];
        {
            bf16x8 kf[4][2];
#pragma unroll
            for (int ks = 0; ks < 2; ++ks)
#pragma unroll
                for (int t = 0; t < 4; ++t) kf[t][ks] = *(const LAS bf16x8*)(Kl + (16 * t + r) * 136 + m * 64 + 32 * ks + 8 * kq);
            __builtin_amdgcn_sched_barrier(0);
            __builtin_amdgcn_s_setprio(1);
#pragma unroll
            for (int t = 0; t < 4; ++t) { s[t][0] = MFMA16(kf[t][0], qf[0][0], ((f32x4){0.f, 0.f, 0.f, 0.f})); s[t][1] = MFMA16(kf[t][0], qf[1][0], ((f32x4){0.f, 0.f, 0.f, 0.f})); }
#pragma unroll
            for (int t = 0; t < 4; ++t) { s[t][0] = MFMA16(kf[t][1], qf[0][1], s[t][0]); s[t][1] = MFMA16(kf[t][1], qf[1][1], s[t][1]); }
            __builtin_amdgcn_s_setprio(0);
        }
        u32x2 vlo[2][4], vhi[2][4];
#define ATT_VLOAD(buf_, b_) do { _Pragma("unroll") for (int i_ = 0; i_ < 4; ++i_) { const int dt_ = ((b_) & 1) * 4 + i_, blk_ = (b_) >> 1; \
            vlo[buf_][i_] = *(const LAS u32x2*)(Vl + (16 * dt_ + r) * 72 + 32 * blk_ + 4 * kq); vhi[buf_][i_] = *(const LAS u32x2*)(Vl + (16 * dt_ + r) * 72 + 32 * blk_ + 16 + 4 * kq); } } while (0)
        ATT_VLOAD(0, 0);
        __builtin_amdgcn_sched_barrier(0);
        PROF_STOP(1, 32); PROF_START(1);
        bf16x8 pf[2][2];
#pragma unroll
        for (int qt = 0; qt < 2; ++qt) {
            float mx = s[0][qt][0];
#pragma unroll
            for (int t = 0; t < 4; ++t)
#pragma unroll
                for (int e = 0; e < 4; ++e) mx = fmaxf(mx, s[t][qt][e]);
            mx = xor16_max(mx); mx = xor32_max(mx);
            const float mnew = fmaxf(mrun[qt], mx), alpha = __builtin_amdgcn_exp2f(mrun[qt] - mnew);
            mrun[qt] = mnew;
            float ps = 0.f;
#pragma unroll
            for (int t = 0; t < 4; ++t)
#pragma unroll
                for (int e = 0; e < 4; ++e) { const float p = __builtin_amdgcn_exp2f(s[t][qt][e] - mnew); s[t][qt][e] = p; ps += p; }
            lrun[qt] = lrun[qt] * alpha + ps;
#pragma unroll
            for (int dt = 0; dt < 8; ++dt) o[dt][qt] = o[dt][qt] * alpha;
#pragma unroll
            for (int blk = 0; blk < 2; ++blk) { u32x4 w; w.x = pk2(s[2 * blk][qt][0], s[2 * blk][qt][1]); w.y = pk2(s[2 * blk][qt][2], s[2 * blk][qt][3]);
                w.z = pk2(s[2 * blk + 1][qt][0], s[2 * blk + 1][qt][1]); w.w = pk2(s[2 * blk + 1][qt][2], s[2 * blk + 1][qt][3]); pf[blk][qt] = as_bf16x8(w); }
        }
        __builtin_amdgcn_sched_barrier(0);
        PROF_STOP(1, 33); PROF_START(1);
#pragma unroll
        for (int b = 0; b < 4; ++b) {
            if (b < 3) ATT_VLOAD((b + 1) & 1, b + 1);
            __builtin_amdgcn_s_setprio(1);
#pragma unroll
            for (int i = 0; i < 4; ++i) { const int dt = (b & 1) * 4 + i, blk = b >> 1;
                const bf16x8 va = as_bf16x8((u32x4){vlo[b & 1][i].x, vlo[b & 1][i].y, vhi[b & 1][i].x, vhi[b & 1][i].y});
                o[dt][0] = MFMA16(va, pf[blk][0], o[dt][0]); o[dt][1] = MFMA16(va, pf[blk][1], o[dt][1]); }
            __builtin_amdgcn_s_setprio(0);
            __builtin_amdgcn_sched_barrier(0);
        }
#undef ATT_VLOAD
        PROF_STOP(1, 34); PROF_START(1);
        if (kt + 1 < nkt) ATT_STORE((kt + 1) & 1);
        WG_SYNC();
        PROF_STOP(1, 35);
    }
#undef ATT_LOAD
#undef ATT_STORE
    if (nsample >= 0) attn_prefetch(A, nsample, nb, nh, nqb, qf, pk_, pv_);
    __builtin_amdgcn_sched_barrier(0);
    PROF_START(1);
#pragma unroll
    for (int qt = 0; qt < 2; ++qt) { float l = lrun[qt]; l = xor16_sum(l); l = xor32_sum(l); const float inv = 1.0f / l;
#pragma unroll
        for (int dt = 0; dt < 8; ++dt) o[dt][qt] = o[dt][qt] * inv; }
    LAS f32x4* ex = (LAS f32x4*)lds;
    f32x4 gsub[8];
    { const float* subln_ = A.in[23] + (size_t)j * 128;
#pragma unroll
      for (int dt = 0; dt < 8; ++dt) gsub[dt] = *(const f32x4*)(subln_ + 16 * dt + 4 * kq); }
    if (m == 1) {
#pragma unroll
        for (int dt = 0; dt < 8; ++dt) { ex[((wave & 3) * 16 + dt * 2 + 0) * 64 + lane] = o[dt][0]; ex[((wave & 3) * 16 + dt * 2 + 1) * 64 + lane] = o[dt][1]; }
    }
    WG_SYNC();
    if (m == 0) {
        bf16_t* MIX = (bf16_t*)(ws + WS_MIXE);
        float ss[2] = {0.f, 0.f};
#pragma unroll
        for (int dt = 0; dt < 8; ++dt)
#pragma unroll
            for (int qt = 0; qt < 2; ++qt) { const f32x4 o1 = ex[((wave & 3) * 16 + dt * 2 + qt) * 64 + lane]; o[dt][qt] = o[dt][qt] - o1 * lam;
                ss[qt] += (o[dt][qt][0] * o[dt][qt][0] + o[dt][qt][1] * o[dt][qt][1]) + (o[dt][qt][2] * o[dt][qt][2] + o[dt][qt][3] * o[dt][qt][3]); }
#pragma unroll
        for (int qt = 0; qt < 2; ++qt) { float v = ss[qt]; v = xor16_sum(v); v = xor32_sum(v); const float rstd = (1.0f - lam_init) / sqrtf(v * (1.f / 128.f) + EPS);
#pragma unroll
            for (int dt = 0; dt < 8; ++dt) { const f32x4 g = gsub[dt]; const f32x4 v4 = o[dt][qt] * rstd * g;
                u32x2 w; w.x = pk2(v4[0], v4[1]); w.y = pk2(v4[2], v4[3]);
                *(u32x2*)(MIX + (size_t)(q0 + 16 * qt + r) * 2048 + 1024 + h * 128 + 16 * dt + 4 * kq) = w; } }
    }
    PROF_STOP(1, 36); PROF_STOP(0, 30);
}

__device__ __forceinline__ void phase_even_mix1(const Args& A, LAS unsigned char* lds, int j, int qkv_lo) {
    phase_qkv_prep(A, lds, j, qkv_lo, 352);
    for (int rep_ = 0; rep_ < ((DBG_TWICE & 4096) ? 2 : 1); ++rep_)
    { u32x4 rows[7]; const int u0 = blockIdx.x; if (u0 < 1280) lru_load_rows(A, u0 >> 3, u0 & 7, rows);
      for (int u = u0; u < 1280; u += gridDim.x) { const int un = u + (int)gridDim.x; lru_unit<1>(A, lds, j, u >> 3, u & 7, rows, (un < 1280 && (un & 7) == (u & 7)) ? (un >> 3) : -1);
          if (un < 1280 && (un & 7) != (u & 7)) lru_load_rows(A, un >> 3, un & 7, rows); } }
}
__device__ __forceinline__ void phase_even_mix2(const Args& A, LAS unsigned char* lds, int j, int layer) {
    float lam;
    { const float* dl = A.in[22] + (size_t)j * 256; float s0 = 0.f, s1 = 0.f;
      for (int i = 0; i < 64; ++i) { s0 += dl[i] * dl[64 + i]; s1 += dl[128 + i] * dl[192 + i]; }
      float lam_init = layer == 0 ? 0.2f : 0.47071302f;
      lam = expf(s0) - expf(s1) + lam_init;
      lam_init = __builtin_bit_cast(float, __builtin_amdgcn_readfirstlane(__builtin_bit_cast(int, lam_init))); lam = __builtin_bit_cast(float, __builtin_amdgcn_readfirstlane(__builtin_bit_cast(int, lam)));
      const int G_ = (int)gridDim.x, vcu_ = (G_ % 8 == 0) ? ((int)blockIdx.x % 8) * (G_ / 8) + (int)blockIdx.x / 8 : (int)blockIdx.x;
      for (int rep_ = 0; rep_ < ((DBG_TWICE & 8192) ? 2 : 1); ++rep_)
      { bf16x8 qf[2][2]; u32x4 pk_[2], pv_[2];
#define ATT_DECODE(u_, s_, b_, h_, q_) do { if ((u_) < 1024) { s_ = 1; b_ = (u_) >> 7; h_ = ((u_) >> 4) & 7; q_ = (u_) & 15; } else { const int v_ = (u_) - 1024; s_ = 0; b_ = v_ >> 4; h_ = (v_ >> 1) & 7; q_ = v_ & 1; } } while (0)
        if (vcu_ < 1280) { int s0_, b0_, h0_, q0_; ATT_DECODE(vcu_, s0_, b0_, h0_, q0_); attn_prefetch(A, s0_, b0_, h0_, q0_, qf, pk_, pv_); }
        for (int u = vcu_; u < 1024 + 256; u += gridDim.x) {
            const int un = u + (int)gridDim.x;
            int sc, bc, hc, qc, sn = -1, bn = 0, hn = 0, qn = 0;
            ATT_DECODE(u, sc, bc, hc, qc);
            if (un < 1280) ATT_DECODE(un, sn, bn, hn, qn);
            attn_unit(A, lds, j, sc, bc, hc, qc, lam, lam_init, sn, bn, hn, qn, qf, pk_, pv_);
        }
#undef ATT_DECODE
      }
    }
    { const int gw = blockIdx.x * 8 + (otid() >> 6), NGW = gridDim.x * 8;
      for (int task = gw; task < 160 * 64; task += NGW) lru_finish(A, j, task >> 6, task & 63); }
}

__device__ __forceinline__ void phase_ssd_prep(const Args& A, LAS unsigned char* lds, int j) {
    const int tid = otid(), lane = tid & 63, wave = tid >> 6;
    unsigned char* ws = A.ws;
    const bf16_t* XBC = (const bf16_t*)(ws + WS_XBC);
    bf16_t* XT = (bf16_t*)(ws + WS_XT); bf16_t* BN = (bf16_t*)(ws + WS_BN); bf16_t* BT = (bf16_t*)(ws + WS_BT); bf16_t* CN = (bf16_t*)(ws + WS_CN);
    const int gw = blockIdx.x * 8 + wave, NGW = gridDim.x * 8;
    const int oct = lane & 7, tg = lane >> 3;
    for (int task = gw; task < 320 * 96; task += NGW) {
        const int slab = task / 96, cgp = task - slab * 96, t0 = slab * 64;
        const int sample = t0 >= TP, l0 = sample ? (t0 - TP) & 2047 : t0 & 255, L = sample ? 2048 : 256;
        const int ch = cgp * 64 + oct * 8;
        float cw[4][8], o[8][8];
#pragma unroll
        for (int tp = 0; tp < 4; ++tp) { const f32x4 a = *(const f32x4*)(A.in[25] + ((size_t)j * 4 + tp) * 6144 + ch), c = *(const f32x4*)(A.in[25] + ((size_t)j * 4 + tp) * 6144 + ch + 4);
            cw[tp][0] = a[0]; cw[tp][1] = a[1]; cw[tp][2] = a[2]; cw[tp][3] = a[3]; cw[tp][4] = c[0]; cw[tp][5] = c[1]; cw[tp][6] = c[2]; cw[tp][7] = c[3]; }
        { const f32x4 a = *(const f32x4*)(A.in[26] + (size_t)j * 6144 + ch), c = *(const f32x4*)(A.in[26] + (size_t)j * 6144 + ch + 4);
#pragma unroll
            for (int i = 0; i < 8; ++i) { o[i][0] = a[0]; o[i][1] = a[1]; o[i][2] = a[2]; o[i][3] = a[3]; o[i][4] = c[0]; o[i][5] = c[1]; o[i][6] = c[2]; o[i][7] = c[3]; } }
        u32x4 rows[11];
#pragma unroll
        for (int k = 0; k < 11; ++k) { const int ll = l0 + tg * 8 - 2 + k;
            rows[k] = (ll >= 0 && ll < L) ? *(const u32x4*)(XBC + (size_t)(t0 + tg * 8 - 2 + k) * 6144 + ch) : (u32x4){0u, 0u, 0u, 0u}; }
#pragma unroll
        for (int k = 0; k < 11; ++k) { float xr[8]; unpack8(rows[k], xr);
#pragma unroll
            for (int i = 0; i < 8; ++i) { const int tp = k - i;
                if (tp >= 0 && tp < 4) {
#pragma unroll
                    for (int c = 0; c < 8; ++c) o[i][c] = fmaf(cw[tp][c], xr[c], o[i][c]); } } }
#pragma unroll
        for (int i = 0; i < 8; ++i)
#pragma unroll
            for (int c = 0; c < 8; ++c) o[i][c] = fsilu(o[i][c]);
        const int tile = t0 >> 8, so = (t0 & 255) + tg * 8;
        if (ch >= 4096) {
            bf16_t* base = ch < 5120 ? BN + (ch - 4096) : CN + (ch - 5120);
#pragma unroll
            for (int i = 0; i < 8; ++i) *(u32x4*)(base + (size_t)(t0 + tg * 8 + i) * 1024) = pack8(o[i]);
        }
        if (ch < 5120) {
#pragma unroll
            for (int c = 0; c < 8; ++c) {
                u32x4 v; v.x = pk2(o[0][c], o[1][c]); v.y = pk2(o[2][c], o[3][c]); v.z = pk2(o[4][c], o[5][c]); v.w = pk2(o[6][c], o[7][c]);
                bf16_t* dst;
                if (ch < 4096) { const int cg = ch + c; dst = XT + (((size_t)tile * 64 + (cg >> 6)) * 64 + (cg & 63)) * 256 + so; }
                else { const int cg = ch - 4096 + c; dst = BT + (((size_t)tile * 8 + (cg >> 7)) * 128 + (cg & 127)) * 256 + so; }
                *(u32x4*)dst = v; }
        }
    }
}

template <int NV>
__device__ __forceinline__ void scan256(float (&v)[NV], LAS float* wtot, int lane, int wave_in_grp, float (&tot)[NV]) {
#pragma unroll
    for (int k = 0; k < NV; ++k) v[k] = wave_scan_incl(v[k]);
    if (lane == 63) {
#pragma unroll
        for (int k = 0; k < NV; ++k) wtot[wave_in_grp * NV + k] = v[k];
    }
    WG_SYNC();
#pragma unroll
    for (int k = 0; k < NV; ++k) { float pre = 0.f, all = 0.f;
#pragma unroll
        for (int w = 0; w < 4; ++w) { const float x = wtot[w * NV + k]; all += x; if (w < wave_in_grp) pre += x; }
        v[k] += pre; tot[k] = all; }
}

__device__ __forceinline__ void phase_ssd_state(const Args& A, LAS unsigned char* lds, int j) {
    const int tid = otid(), lane = tid & 63, wave = tid >> 6, r = lane & 15, kq = lane >> 4;
    unsigned char* ws = A.ws;
    const bf16_t* XT = (const bf16_t*)(ws + WS_XT); const bf16_t* BT = (const bf16_t*)(ws + WS_BT);
    const float* DTRAW = (const float*)(ws + WS_DTRAW);
    bf16_t* SIN = (bf16_t*)(ws + WS_SIN);
    LAS bf16_t* Bl = (LAS bf16_t*)lds;
    LAS bf16_t* Xl = (LAS bf16_t*)(lds + 67584);
    LAS float* Wl = (LAS float*)(lds + 67584 + 33792);
    LAS float* TOT = Wl + 1024;
    LAS float* WT_ = TOT + 16;
    const int pt = wave & 3, nh = wave >> 2;
    const int G_ = (int)gridDim.x, vcu_ = (G_ % 8 == 0) ? ((int)blockIdx.x % 8) * (G_ / 8) + (int)blockIdx.x / 8 : (int)blockIdx.x;
    PROF_DECL
    for (int u = vcu_; u < 256 + 512; u += gridDim.x) {
        PROF_START(0);
        const int sample = u < 256, v = sample ? u : u - 256;
        const int b = v >> 5, g = (v >> 2) & 7, dir = (v >> 1) & 1, half = v & 1;
        const int tile0 = sample ? 16 + b * 8 : b, ntile = sample ? 8 : 1;
        const int h0 = g * 8 + half * 4;
        f32x4 acc[4][4];
#pragma unroll
        for (int hh = 0; hh < 4; ++hh)
#pragma unroll
            for (int nt = 0; nt < 4; ++nt) {
                if (sample) {
#pragma unroll
                    for (int e = 0; e < 4; ++e) acc[hh][nt][e] = A.in[6][((((size_t)b * 2 + j) * 2 + dir) * 64 + h0 + hh) * 8192 + (size_t)(16 * pt + 4 * kq + e) * 128 + 16 * (nh * 4 + nt) + r];
                } else acc[hh][nt] = (f32x4){0.f, 0.f, 0.f, 0.f};
            }
        float adec[4], dtb[4];
#pragma unroll
        for (int hh = 0; hh < 4; ++hh) { adec[hh] = -expf(A.in[28][((size_t)j * 2 + dir) * 64 + h0 + hh]); dtb[hh] = A.in[27][((size_t)j * 2 + dir) * 64 + h0 + hh]; }
        u32x4 pbt[8];
        { const int tf = tile0 + (dir == 0 ? 0 : ntile - 1);
#pragma unroll
          for (int i = 0; i < 8; ++i) { const int p = tid + 512 * i, row = p >> 5, pc = p & 31; pbt[i] = *(const u32x4*)(BT + (((size_t)tf * 8 + g) * 128 + row) * 256 + pc * 8); } }
        for (int st = 0; st < ntile; ++st) {
            const int c = dir == 0 ? st : ntile - 1 - st, tile = tile0 + c;
            WG_SYNC();
            PROF_START(1);
            if (sample) {
                LAS bf16_t* St = (LAS bf16_t*)lds;
#pragma unroll
                for (int hh = 0; hh < 4; ++hh)
#pragma unroll
                    for (int nt = 0; nt < 4; ++nt)
#pragma unroll
                        for (int e = 0; e < 4; ++e)
                            St[(hh * 64 + 16 * pt + 4 * kq + e) * 136 + 16 * (nh * 4 + nt) + r] = (bf16_t)(pk2(acc[hh][nt][e], 0.f) & 0xffffu);
                WG_SYNC();
#pragma unroll
                for (int i = 0; i < 8; ++i) { const int p = tid + 512 * i, hh = p >> 10, row = (p >> 4) & 63, pc = p & 15;
                    *(u32x4*)(SIN + ((((size_t)(tile - 16) * 2 + dir) * 64 + h0 + hh) * 64 + row) * 128 + pc * 8) = *(const LAS u32x4*)(St + (hh * 64 + row) * 136 + pc * 8); }
                if (st == ntile - 1) break;
                WG_SYNC();
            }
            PROF_STOP(1, 21); PROF_START(1);
            {
                float val[4], dtv[4], tot[4];
                if (tid < 256) {
#pragma unroll
                    for (int hh = 0; hh < 4; ++hh) { dtv[hh] = fsoftplus(DTRAW[(size_t)(tile * 256 + tid) * 128 + dir * 64 + h0 + hh] + dtb[hh]); val[hh] = adec[hh] * dtv[hh]; }
                } else {
#pragma unroll
                    for (int hh = 0; hh < 4; ++hh) { dtv[hh] = 0.f; val[hh] = 0.f; }
                }
                float adt[4];
#pragma unroll
                for (int hh = 0; hh < 4; ++hh) adt[hh] = val[hh];
                scan256<4>(val, WT_ + (tid < 256 ? 0 : 16), lane, wave & 3, tot);
                if (tid < 256) {
#pragma unroll
                    for (int hh = 0; hh < 4; ++hh) { const float w = dir == 0 ? fexp(tot[hh] - val[hh]) * dtv[hh] : fexp(val[hh] - adt[hh]) * dtv[hh]; Wl[hh * 256 + tid] = w; }
                    if (tid == 0) {
#pragma unroll
                        for (int hh = 0; hh < 4; ++hh) TOT[hh] = tot[hh];
                    }
                }
            }
            PROF_STOP(1, 22); PROF_START(1);
#pragma unroll
            for (int i = 0; i < 8; ++i) { const int p = tid + 512 * i, row = p >> 5, pc = p & 31; *(LAS u32x4*)(Bl + row * 264 + pc * 8) = pbt[i]; }
            { const int stn = st + 1, lastupd = sample ? ntile - 1 : ntile;
              if (stn < lastupd) { const int tn = tile0 + (dir == 0 ? stn : ntile - 1 - stn);
#pragma unroll
                  for (int i = 0; i < 8; ++i) { const int p = tid + 512 * i, row = p >> 5, pc = p & 31; pbt[i] = *(const u32x4*)(BT + (((size_t)tn * 8 + g) * 128 + row) * 256 + pc * 8); } } }
            PROF_STOP(1, 23);
            u32x4 px[4];
#pragma unroll
            for (int i = 0; i < 4; ++i) { const int p = tid + 512 * i, row = p >> 5, pc = p & 31; px[i] = *(const u32x4*)(XT + (((size_t)tile * 64 + h0) * 64 + row) * 256 + pc * 8); }
#pragma unroll
            for (int hh = 0; hh < 4; ++hh) {
                PROF_START(1);
                WG_SYNC();
#pragma unroll
                for (int i = 0; i < 4; ++i) { const int p = tid + 512 * i, row = p >> 5, pc = p & 31;
                    float x[8]; unpack8(px[i], x);
                    if (hh < 3) px[i] = *(const u32x4*)(XT + (((size_t)tile * 64 + h0 + hh + 1) * 64 + row) * 256 + pc * 8);
                    const f32x4 w0 = *(const LAS f32x4*)(Wl + hh * 256 + pc * 8), w1 = *(const LAS f32x4*)(Wl + hh * 256 + pc * 8 + 4);
                    x[0] *= w0[0]; x[1] *= w0[1]; x[2] *= w0[2]; x[3] *= w0[3]; x[4] *= w1[0]; x[5] *= w1[1]; x[6] *= w1[2]; x[7] *= w1[3];
                    *(LAS u32x4*)(Xl + row * 264 + pc * 8) = pack8(x); }
                WG_SYNC();
                PROF_STOP(1, 24); PROF_START(1);
                const float dec = fexp(TOT[hh]);
#pragma unroll
                for (int nt = 0; nt < 4; ++nt) acc[hh][nt] = acc[hh][nt] * dec;
#pragma unroll
                for (int ks = 0; ks < 8; ++ks) { const bf16x8 fa = *(const LAS bf16x8*)(Xl + (16 * pt + r) * 264 + 32 * ks + 8 * kq);
#pragma unroll
                    for (int nt = 0; nt < 4; ++nt) { const bf16x8 fb = *(const LAS bf16x8*)(Bl + (16 * (nh * 4 + nt) + r) * 264 + 32 * ks + 8 * kq);
                        acc[hh][nt] = MFMA16(fa, fb, acc[hh][nt]); } }
                PROF_STOP(1, 25);
            }
        }
        PROF_STOP(0, 20);
        if (!sample) {
#pragma unroll
            for (int hh = 0; hh < 4; ++hh)
#pragma unroll
                for (int nt = 0; nt < 4; ++nt)
#pragma unroll
                    for (int e = 0; e < 4; ++e)
                        A.out[OUT_SSD + ((((size_t)b * 2 + j) * 2 + dir) * 64 + h0 + hh) * 8192 + (size_t)(16 * pt + 4 * kq + e) * 128 + 16 * (nh * 4 + nt) + r] = acc[hh][nt][e];
        }
    }
}

__device__ __forceinline__ void phase_ssd_out(const Args& A, LAS unsigned char* lds, int j) {
    const int tid = otid(), lane = tid & 63, wave = tid >> 6, r = lane & 15, kq = lane >> 4;
    unsigned char* ws = A.ws;
    const bf16_t* XT = (const bf16_t*)(ws + WS_XT); const bf16_t* BN = (const bf16_t*)(ws + WS_BN); const bf16_t* CN = (const bf16_t*)(ws + WS_CN);
    const bf16_t* Z = (const bf16_t*)(ws + WS_Z); const float* DTRAW = (const float*)(ws + WS_DTRAW); const bf16_t* SIN = (const bf16_t*)(ws + WS_SIN);
    bf16_t* MIX = (bf16_t*)(ws + WS_MIXO);
    LAS float* PF = (LAS float*)lds;
    LAS float* DTF = PF + 2048;
    LAS float* EB = DTF + 2048;
    LAS float* DTB = EB + 2048;
    LAS float* COLF = DTB + 2048;
    LAS float* COLB = COLF + 2048;
    LAS float* TOTB = (LAS float*)(lds + LDS_MISC + 256);
    LAS float* WT_ = (LAS float*)(lds + LDS_MISC + 320);
    LAS bf16_t* Bl = (LAS bf16_t*)(lds + 49152);
    LAS bf16_t* Xl = (LAS bf16_t*)(lds + 49152);
    LAS bf16_t* Sl = (LAS bf16_t*)(lds + 49152 + 33792);
    PROF_DECL
    for (int u = blockIdx.x; u < 160 * 8; u += gridDim.x) {
        PROF_START(0);
        const int rt = u >> 3, g = u & 7, tile = rt >> 1, half = rt & 1;
        const int sample = tile >= 16;
        const int l_loc = half * 128 + wave * 16 + r;
        const size_t tk = (size_t)tile * 256 + l_loc;
        WG_SYNC();
        PROF_START(1);
        {
            const int dir = tid >> 8, s = tid & 255;
            float val[8], dtv[8], tot[8], adt[8];
#pragma unroll
            for (int h8 = 0; h8 < 8; ++h8) { const int h = g * 8 + h8;
                dtv[h8] = fsoftplus(DTRAW[((size_t)tile * 256 + s) * 128 + dir * 64 + h] + A.in[27][((size_t)j * 2 + dir) * 64 + h]);
                val[h8] = -expf(A.in[28][((size_t)j * 2 + dir) * 64 + h]) * dtv[h8]; adt[h8] = val[h8]; }
            scan256<8>(val, WT_ + dir * 32, lane, wave & 3, tot);
            if (dir == 0) {
#pragma unroll
                for (int h8 = 0; h8 < 8; ++h8) { PF[h8 * 256 + s] = val[h8]; DTF[h8 * 256 + s] = dtv[h8];
                    const float pend = __shfl(val[h8], 15, 16); COLF[h8 * 256 + s] = fexp(pend - val[h8]) * dtv[h8]; }
            } else {
#pragma unroll
                for (int h8 = 0; h8 < 8; ++h8) { const float eb = val[h8] - adt[h8]; EB[h8 * 256 + s] = eb; DTB[h8 * 256 + s] = dtv[h8];
                    const float eb0 = __shfl(eb, 0, 16); COLB[h8 * 256 + s] = fexp(eb - eb0) * dtv[h8]; }
                if (s == 0) {
#pragma unroll
                    for (int h8 = 0; h8 < 8; ++h8) TOTB[h8] = tot[h8];
                }
            }
        }
        PROF_STOP(1, 1); PROF_START(1);
#pragma unroll
        for (int i = 0; i < 8; ++i) { const int p = tid + 512 * i, row = p >> 4, pc = p & 15;
            *(LAS u32x4*)(Bl + row * 136 + pc * 8) = *(const u32x4*)(BN + ((size_t)tile * 256 + row) * 1024 + g * 128 + pc * 8); }
        bf16x8 cf[4];
#pragma unroll
        for (int ks = 0; ks < 4; ++ks) cf[ks] = as_bf16x8(*(const u32x4*)(CN + tk * 1024 + g * 128 + 32 * ks + 8 * kq));
        WG_SYNC();
        f32x4 gt[16];
#pragma unroll
        for (int t = 0; t < 16; ++t) gt[t] = (f32x4){0.f, 0.f, 0.f, 0.f};
#pragma unroll
        for (int ks = 0; ks < 4; ++ks)
#pragma unroll
            for (int t = 0; t < 16; ++t) { const bf16x8 fa = *(const LAS bf16x8*)(Bl + (16 * t + r) * 136 + 32 * ks + 8 * kq); gt[t] = MFMA16(fa, cf[ks], gt[t]); }
        PROF_STOP(1, 2); PROF_START(1);
        float ssq = 0.f;
        u32x4 pfx[4], pfs[4];
#define SSDO_PREFETCH(HH) do { const int tidp = otid(); \
            _Pragma("unroll") for (int i = 0; i < 4; ++i) { const int p = tidp + 512 * i; \
                pfx[i] = *(const u32x4*)(XT + (((size_t)tile * 64 + g * 8 + (HH)) * 64 + (p >> 5)) * 256 + (p & 31) * 8); \
                if (sample) pfs[i] = *(const u32x4*)(SIN + ((((size_t)(tile - 16) * 2 + (p >> 10)) * 64 + g * 8 + (HH)) * 64 + ((p >> 4) & 63)) * 128 + (p & 15) * 8); } } while (0)
        SSDO_PREFETCH(0);
#pragma unroll 1
        for (int h8 = 0; h8 < 8; ++h8) {
            const int h = g * 8 + h8;
            const int tid = otid(), lane = tid & 63, wave = __builtin_amdgcn_readfirstlane(tid >> 6), r = lane & 15, kq = lane >> 4;
            const int l_loc = half * 128 + wave * 16 + r; const size_t tk = (size_t)tile * 256 + l_loc; const int tdiag = half * 8 + wave;
            PROF_START(2);
            WG_SYNC();
#pragma unroll
            for (int i = 0; i < 4; ++i) { const int p = tid + 512 * i, row = p >> 5, pc = p & 31;
                *(LAS u32x4*)(Xl + row * 264 + pc * 8) = pfx[i]; }
            if (sample) {
#pragma unroll
                for (int i = 0; i < 4; ++i) { const int p = tid + 512 * i, dirn = p >> 10, row = (p >> 4) & 63, pc = p & 15;
                    *(LAS u32x4*)(Sl + (dirn * 64 + row) * 136 + pc * 8) = pfs[i]; }
            }
            if (h8 < 7) SSDO_PREFETCH(h8 + 1);
            WG_SYNC();
            PROF_STOP(2, 4); PROF_START(2);
            const float pf_l = PF[h8 * 256 + l_loc], eb_l = EB[h8 * 256 + l_loc];
            u32x2 zpre[4];
#pragma unroll
            for (int p4 = 0; p4 < 4; ++p4) zpre[p4] = *(const u32x2*)(Z + tk * 4096 + h * 64 + 16 * p4 + 4 * kq);
            const float dsk = A.in[29][(size_t)j * 64 + h];
            f32x4 y[4];
#pragma unroll
            for (int p4 = 0; p4 < 4; ++p4) y[p4] = (f32x4){0.f, 0.f, 0.f, 0.f};
#pragma unroll
            for (int blk = 0; blk < 8; ++blk) {
                f32x4 cv[2]; float rs[2];
#pragma unroll
                for (int hf_ = 0; hf_ < 2; ++hf_) { const int t_ = 2 * blk + hf_; const bool fw_ = t_ < tdiag;
                    cv[hf_] = *(const LAS f32x4*)((fw_ ? COLF : COLB) + h8 * 256 + 16 * t_ + 4 * kq); rs[hf_] = fw_ ? PF[h8 * 256 + 16 * t_ + 15] : EB[h8 * 256 + 16 * t_]; }
                u32x2 xlo[4], xhi[4];
                __builtin_amdgcn_sched_barrier(0);
                float mv[8];
#pragma unroll
                for (int hf = 0; hf < 2; ++hf) {
                    const int t = 2 * blk + hf, sb = 16 * t + 4 * kq;
                    if (t != tdiag) {
                        const float row = fexp(t < tdiag ? pf_l - rs[hf] : rs[hf] - eb_l);
#pragma unroll
                        for (int e = 0; e < 4; ++e) mv[hf * 4 + e] = gt[t][e] * (row * cv[hf][e]);
                    } else {
                        const f32x4 ps = *(const LAS f32x4*)(PF + h8 * 256 + sb), df = *(const LAS f32x4*)(DTF + h8 * 256 + sb);
                        const f32x4 es = *(const LAS f32x4*)(EB + h8 * 256 + sb), db = *(const LAS f32x4*)(DTB + h8 * 256 + sb);
#pragma unroll
                        for (int e = 0; e < 4; ++e) { const int s = sb + e; float w = 0.f;
                            if (s <= l_loc) w += fexp(fminf(pf_l - ps[e], 0.f)) * df[e];
                            if (s >= l_loc) w += fexp(fminf(es[e] - eb_l, 0.f)) * db[e];
                            mv[hf * 4 + e] = gt[t][e] * w;
                            if (s == l_loc) mv[hf * 4 + e] += dsk; }
                    }
                }
                const bf16x8 mf = as_bf16x8(pack8(mv));
#pragma unroll
                for (int p4 = 0; p4 < 4; ++p4) { xlo[p4] = *(const LAS u32x2*)(Xl + (16 * p4 + r) * 264 + 32 * blk + 4 * kq); xhi[p4] = *(const LAS u32x2*)(Xl + (16 * p4 + r) * 264 + 32 * blk + 16 + 4 * kq); }
#pragma unroll
                for (int p4 = 0; p4 < 4; ++p4)
                    y[p4] = MFMA16(as_bf16x8((u32x4){xlo[p4].x, xlo[p4].y, xhi[p4].x, xhi[p4].y}), mf, y[p4]);
                __builtin_amdgcn_sched_barrier(0);
            }

            PROF_STOP(2, 5); PROF_START(2);
            if (sample) {
#pragma unroll
                for (int dirn = 0; dirn < 2; ++dirn) {
                    f32x4 tmp[4];
#pragma unroll
                    for (int p4 = 0; p4 < 4; ++p4) tmp[p4] = (f32x4){0.f, 0.f, 0.f, 0.f};
#pragma unroll
                    for (int ks = 0; ks < 4; ++ks)
#pragma unroll
                        for (int p4 = 0; p4 < 4; ++p4) { const bf16x8 sa = *(const LAS bf16x8*)(Sl + (dirn * 64 + 16 * p4 + r) * 136 + 32 * ks + 8 * kq); tmp[p4] = MFMA16(sa, cf[ks], tmp[p4]); }
                    const float ev = dirn == 0 ? fexp(pf_l) : fexp(TOTB[h8] - eb_l);
#pragma unroll
                    for (int p4 = 0; p4 < 4; ++p4) y[p4] = y[p4] + tmp[p4] * ev;
                }
            }
            PROF_STOP(2, 6); PROF_START(2);
#pragma unroll
            for (int p4 = 0; p4 < 4; ++p4) { const int p0 = 16 * p4 + 4 * kq;
                const u32x2 zv = zpre[p4];
                const float zz[4] = {bflo(zv.x), bfhi(zv.x), bflo(zv.y), bfhi(zv.y)};
                float yv[4];
#pragma unroll
                for (int e = 0; e < 4; ++e) { yv[e] = y[p4][e] * zz[e]; ssq += yv[e] * yv[e]; }
                u32x2 w; w.x = pk2(yv[0], yv[1]); w.y = pk2(yv[2], yv[3]);
                *(u32x2*)(MIX + tk * 4096 + h * 64 + p0) = w; }
            PROF_STOP(2, 7);
        }
        PROF_STOP(1, 3); PROF_START(1);
        ssq = xor16_sum(ssq); ssq = xor32_sum(ssq);
        const float rstd = 1.0f / sqrtf(ssq * (1.f / 512.f) + EPS);
        asm volatile("s_waitcnt vmcnt(0)" ::: "memory");
        {
            const int tid2 = otid(), kq2 = (tid2 & 63) >> 4; const size_t tk2 = (size_t)tile * 256 + half * 128 + (tid2 >> 6) * 16 + (tid2 & 15);
#pragma unroll 1
            for (int qb = 0; qb < 32; qb += 32) {
            unsigned long long raw[32];
#pragma unroll
            for (int q = 0; q < 32; ++q) raw[q] = __hip_atomic_load((unsigned long long*)(MIX + tk2 * 4096 + (g * 8 + ((qb + q) >> 2)) * 64 + 16 * (q & 3) + 4 * kq2), __ATOMIC_RELAXED, __HIP_MEMORY_SCOPE_AGENT);
#pragma unroll
            for (int q = 0; q < 32; ++q) { const int cix = (g * 8 + ((qb + q) >> 2)) * 64 + 16 * (q & 3) + 4 * kq2;
                const unsigned lo = (unsigned)raw[q], hi = (unsigned)(raw[q] >> 32);
                const f32x4 nw = *(const f32x4*)(A.in[30] + (size_t)j * 4096 + cix);
                u32x2 w; w.x = pk2(bflo(lo) * rstd * nw[0], bfhi(lo) * rstd * nw[1]); w.y = pk2(bflo(hi) * rstd * nw[2], bfhi(hi) * rstd * nw[3]);
                *(u32x2*)(MIX + tk2 * 4096 + cix) = w; }
            }
        }
        PROF_STOP(1, 8); PROF_STOP(0, 0);
    }
#undef SSDO_PREFETCH
}

constexpr int N_PHASE_IDS = 2 + 9 * 4;
#ifndef DBG_TWICE
#define DBG_TWICE 0
#endif
#ifndef MK_ONE_LAUNCH
#define MK_ONE_LAUNCH 1
#endif

__device__ __forceinline__ void sub_barrier(unsigned* bar, unsigned* cnt, unsigned n, bool wait = true) {
    asm volatile("s_waitcnt vmcnt(0)" ::: "memory");
    __syncthreads();
    if (threadIdx.x == 0) {
        __builtin_amdgcn_fence(__ATOMIC_RELEASE, "agent");
        asm volatile("s_waitcnt vmcnt(0)" ::: "memory");
        (void)xb_add(cnt, 1u);
        if (wait) {
            XB_SPIN(xb_ld(cnt) < n, bar);
            __builtin_amdgcn_fence(__ATOMIC_ACQUIRE, "agent");
            asm volatile("s_waitcnt vmcnt(0)" ::: "memory");
        }
    }
    __syncthreads();
}

__global__ void __launch_bounds__(512, 2) fwd_kernel(Args args) {
    extern __shared__ __attribute__((aligned(16))) unsigned char shm[];
    LAS unsigned char* lds = (LAS unsigned char*)shm;
    const int tid = threadIdx.x;
    unsigned char* ws = args.ws;
    if (tid < 4) ((LAS unsigned*)(lds + LDS_MISC))[tid] = 0u;
#if DBG_PROF
    if (tid < 96) ((LAS unsigned*)(lds + LDS_MISC + 640))[tid] = 0u;
#endif
    __syncthreads();
    XcdBarrier bar = xcd_barrier_post((unsigned*)(ws + WS_CTL), (volatile LAS unsigned*)(lds + LDS_MISC));
    const int lo = args.ph_lo, hi = args.ph_hi;
    bool need_bar = false;
#define PHASE(id) if (lo <= (id) && (id) < hi && ((need_bar ? (xcd_barrier(bar), ((DBG_TWICE & 131072) ? (xcd_barrier(bar), 0) : 0), 0) : 0), need_bar = true, true))
#define REP(bit) for (int rep_ = 0; rep_ < ((DBG_TWICE & (bit)) ? 2 : 1); ++rep_) if (((rep_ ? (xcd_barrier(bar), 0) : 0), true))
    const float* ADA = (const float*)(ws + WS_ADA);
    bf16_t* H = (bf16_t*)(ws + WS_H);
    const int G = (int)gridDim.x, bx = (int)blockIdx.x;

    PHASE(0) { REP(1) phase_prologue(args, lds); }
    PHASE(1) { REP(2) phase_modulate(args, 0, 0, true); }
    for (int layer = 0; layer < 4; ++layer) {
        const int pb = 2 + 9 * layer, j = layer >> 1, even = (layer & 1) == 0;
        if (even) {
            PHASE(pb + 0) { pg8::Gemm g{H, (const bf16_t*)(ws + WS_WEIN) + (size_t)j * 5120 * 2048, T, 5120, 2048};
                pg8::EpiStore E{(bf16_t*)(ws + WS_U5), 5120};
                if (G == 256) {
                    { const int c0 = layer > 0 ? 4 : 0;
                      pg8::Gemm g1{H, g.Bt + (size_t)c0 * 256 * 2048, T, 5120 - c0 * 256, 2048}; pg8::EpiStore E1{(bf16_t*)(ws + WS_U5) + c0 * 256, 5120};
                      pg8::StaticOrder S; S.init(16384, 5120 - c0 * 256, G, bx); pg8::gemm_phase<pg8::EpiStore, pg8::StaticOrder, true, true>(lds, g1, S, E1); }
                    xcd_barrier(bar);
                    { pg8::TailOrderE S{G, bx}; pg8::gemm_phase<pg8::EpiStore, pg8::TailOrderE, true, true>(lds, g, S, E); }
                    phase_qkv_prep(args, lds, j, 0, 192, 64, 192);
                } else { pg8::StaticOrder S; S.init(T, 5120, G, bx); pg8::gemm_phase<pg8::EpiStore, pg8::StaticOrder, true, true>(lds, g, S, E); } }
            PHASE(pb + 1) { REP(8) phase_even_mix1(args, lds, j, G == 256 ? 192 : 0); }
            PHASE(pb + 2) { REP(16) phase_even_mix2(args, lds, j, layer); }
        } else {
            PHASE(pb + 0) REP(32) { pg8::Gemm g{H, (const bf16_t*)(ws + WS_WSIN) + (size_t)j * 10496 * 2048, T, 10496, 2048};
                pg8::EpiOdd1 E{(bf16_t*)(ws + WS_Z), (bf16_t*)(ws + WS_XBC), (float*)(ws + WS_DTRAW)};
                if (G == 256) { pg8::O1RestOrder S{G, bx}; pg8::gemm_phase<pg8::EpiOdd1, pg8::O1RestOrder, true, true>(lds, g, S, E); }
                else { pg8::StaticOrder S; S.init(T, 10496, G, bx); pg8::gemm_phase<pg8::EpiOdd1, pg8::StaticOrder, true, true>(lds, g, S, E); } }
            PHASE(pb + 1) { REP(64) phase_ssd_prep(args, lds, j); }
            PHASE(pb + 2) { REP(128) phase_ssd_state(args, lds, j); }
            PHASE(pb + 3) { REP(256) phase_ssd_out(args, lds, j); }
        }
        PHASE(pb + 4) {
            const bf16_t* Am = even ? (const bf16_t*)(ws + WS_MIXE) : (const bf16_t*)(ws + WS_MIXO);
            const bf16_t* Bm = even ? (const bf16_t*)(ws + WS_WEOUT) + (size_t)j * 2048 * 2048 : (const bf16_t*)(ws + WS_WSOUT) + (size_t)j * 2048 * 4096;
            pg8::Gemm g{Am, Bm, T, 2048, even ? 2048 : 4096};
            pg8::EpiResid E{(bf16_t*)(ws + WS_Y), ADA + (size_t)layer * 9 * 12288 + 2 * 2048, nullptr};
            if (G == 256) {
                { pg8::StaticOrder S; S.init(16384, 2048, G, bx); pg8::gemm_phase<pg8::EpiResid, pg8::StaticOrder, true, true>(lds, g, S, E); }
                sub_barrier((unsigned*)(ws + WS_CTL), (unsigned*)(ws + WS_CTL) + 8192 + 512 + 64 * (2 * layer), 256u, bx >= 128);
                if (bx < 128) { pg8::TailOrder S{bx}; pg8::gemm_phase<pg8::EpiResid, pg8::TailOrder, true, true>(lds, g, S, E); }
                else phase_modulate(args, layer, 1, false, 0, 16384, 128, 128);
                xcd_barrier(bar);
                phase_modulate(args, layer, 1, false, 16384, T);
            } else { pg8::StaticOrder S; S.init(T, 2048, G, bx); pg8::gemm_phase<pg8::EpiResid, pg8::StaticOrder, true, true>(lds, g, S, E);
                xcd_barrier(bar); phase_modulate(args, layer, 1, false); } }
#if (DBG_TWICE & 32768)
        PHASE(pb + 4) {
            const bf16_t* Am = even ? (const bf16_t*)(ws + WS_MIXE) : (const bf16_t*)(ws + WS_MIXO);
            const bf16_t* Bm = even ? (const bf16_t*)(ws + WS_WEOUT) + (size_t)j * 2048 * 2048 : (const bf16_t*)(ws + WS_WSOUT) + (size_t)j * 2048 * 4096;
            pg8::Gemm g{Am, Bm, T, 2048, even ? 2048 : 4096}; pg8::StaticOrder S; S.init(T, 2048, G, bx);
            pg8::EpiDummy E{(float*)(ws + 1242 * MiB)};
            pg8::gemm_phase<pg8::EpiDummy, pg8::StaticOrder, true, true>(lds, g, S, E); }
#endif
        PHASE(pb + 6) REP(1024) { pg8::Gemm g{H, (const bf16_t*)(ws + WS_WFIN) + (size_t)layer * 11264 * 2048, T, 11264, 2048}; pg8::StaticOrder S; S.init(T, 11264, G, bx);
            pg8::EpiSwiGLU E{(bf16_t*)(ws + WS_HID), 5632};
            pg8::gemm_phase<pg8::EpiSwiGLU, pg8::StaticOrder, true, true>(lds, g, S, E); }
        PHASE(pb + 7) { pg8::Gemm g{(const bf16_t*)(ws + WS_HID), (const bf16_t*)(ws + WS_WFOUT) + (size_t)layer * 2048 * 5632, T, 2048, 5632};
            pg8::EpiResid E{(bf16_t*)(ws + WS_Y), ADA + (size_t)layer * 9 * 12288 + 5 * 2048, layer == 3 ? args.out : nullptr};
            if (G == 256 && layer < 3) {
                { pg8::StaticOrder S; S.init(16384, 2048, G, bx); pg8::gemm_phase<pg8::EpiResid, pg8::StaticOrder, true, true>(lds, g, S, E); }
                sub_barrier((unsigned*)(ws + WS_CTL), (unsigned*)(ws + WS_CTL) + 8192 + 512 + 64 * (2 * layer + 1), 256u, bx >= 128);
                if (bx < 128) { pg8::TailOrder S{bx}; pg8::gemm_phase<pg8::EpiResid, pg8::TailOrder, true, true>(lds, g, S, E); }
                else { phase_modulate(args, layer + 1, 0, false, 0, 16384, 128, 128);
                    if (even) {
                        sub_barrier((unsigned*)(ws + WS_CTL), (unsigned*)(ws + WS_CTL) + 8192 + 64 * layer, 128u);
                        pg8::Gemm g2{H, (const bf16_t*)(ws + WS_WSIN) + (size_t)j * 10496 * 2048, T, 10496, 2048};
                        pg8::EpiOdd1 E2{(bf16_t*)(ws + WS_Z), (bf16_t*)(ws + WS_XBC), (float*)(ws + WS_DTRAW)};
                        pg8::EarlyO1Order S2{bx}; pg8::gemm_phase<pg8::EpiOdd1, pg8::EarlyO1Order, true, true>(lds, g2, S2, E2); }
                    else {
                        sub_barrier((unsigned*)(ws + WS_CTL), (unsigned*)(ws + WS_CTL) + 8192 + 64 * layer, 128u);
                        pg8::Gemm g2{H, (const bf16_t*)(ws + WS_WEIN) + (size_t)(j + 1) * 5120 * 2048, T, 5120, 2048};
                        pg8::EpiStore E2{(bf16_t*)(ws + WS_U5), 5120};
                        pg8::EarlyO1Order S2{bx}; pg8::gemm_phase<pg8::EpiStore, pg8::EarlyO1Order, true, true>(lds, g2, S2, E2); } }
                xcd_barrier(bar);
                phase_modulate(args, layer + 1, 0, false, 16384, T);
            } else if (G == 256) {
                { pg8::StaticOrder S; S.init(16384, 2048, G, bx); pg8::gemm_phase<pg8::EpiResid, pg8::StaticOrder, true, true>(lds, g, S, E); }
                float* Ppart = (float*)(ws + WS_R2); unsigned* pflags = (unsigned*)(ws + WS_CTL) + 8192 + 1024;
                pg8::TailOrder S{bx & 127};
                if (bx >= 128) { pg8::Gemm gh{g.A + 2816, g.Bt + 2816, T, 2048, 5632, 2816}; pg8::EpiPartW Ew{Ppart, pflags}; pg8::gemm_phase<pg8::EpiPartW, pg8::TailOrder, true, true>(lds, gh, S, Ew); }
                else { pg8::Gemm gh{g.A, g.Bt, T, 2048, 5632, 2816}; pg8::EpiResidP Er{E.Y, E.gate, E.OUTF, Ppart, pflags}; pg8::gemm_phase<pg8::EpiResidP, pg8::TailOrder, true, true>(lds, gh, S, Er); }
            } else { pg8::StaticOrder S; S.init(T, 2048, G, bx); pg8::gemm_phase<pg8::EpiResid, pg8::StaticOrder, true, true>(lds, g, S, E);
                if (layer < 3) { xcd_barrier(bar); phase_modulate(args, layer + 1, 0, false); } } }
#if (DBG_TWICE & 16384)
        PHASE(pb + 7) {
            pg8::Gemm g{(const bf16_t*)(ws + WS_HID), (const bf16_t*)(ws + WS_WFOUT) + (size_t)layer * 2048 * 5632, T, 2048, 5632}; pg8::StaticOrder S; S.init((DBG_TWICE & 65536) ? 16384 : T, 2048, G, bx);
            pg8::EpiDummy E{(float*)(ws + 1242 * MiB)};
            pg8::gemm_phase<pg8::EpiDummy, pg8::StaticOrder, true, true>(lds, g, S, E); }
#endif
    }
#if DBG_PROF
    {
        if (bx == 0 && tid == 0) { LAS long long* pa_ = (LAS long long*)(lds + LDS_MISC + 640); const float ratio = (float)pa_[DBG_PROF / 100] / (float)pa_[DBG_PROF % 100];
            __hip_atomic_store((float*)(ws + WS_CTL + 60000), ratio, __ATOMIC_RELAXED, __HIP_MEMORY_SCOPE_AGENT); }
        xcd_barrier(bar);
        const float ratio = __hip_atomic_load((float*)(ws + WS_CTL + 60000), __ATOMIC_RELAXED, __HIP_MEMORY_SCOPE_AGENT);
        for (int i = bx * 512 + tid; i < 65536; i += G * 512) args.out[OUT_LRU + i] *= (1.0f + ratio);
    }
#endif
#undef PHASE
}

extern "C" void kernel_launch(void* const* d_in, const int* in_sizes, int n_in, void* d_out, int out_size, void* d_ws, size_t ws_size, hipStream_t stream) {
    static int grid = 0;
    if (grid == 0) {
        if (n_in != 34 || out_size != 92340224 || ws_size < WS_END) { fprintf(stderr, "kernel_launch: unexpected shapes (n_in %d, out %d, ws %zu); nothing launched\n", n_in, out_size, ws_size); grid = -1; return; }
        int dev = 0, cus = 0, per_cu = 0;
        if (hipGetDevice(&dev) != hipSuccess || hipDeviceGetAttribute(&cus, hipDeviceAttributeMultiprocessorCount, dev) != hipSuccess) { grid = -1; return; }
        if (hipFuncSetAttribute((const void*)fwd_kernel, hipFuncAttributeMaxDynamicSharedMemorySize, LDS_BYTES) != hipSuccess) { fprintf(stderr, "kernel_launch: hipFuncSetAttribute failed\n"); grid = -1; return; }
        if (hipOccupancyMaxActiveBlocksPerMultiprocessor(&per_cu, (const void*)fwd_kernel, 512, LDS_BYTES) != hipSuccess || per_cu < 1)
            fprintf(stderr, "kernel_launch: occupancy query reports %d workgroups per CU\n", per_cu);
        (void)hipGetLastError();
        grid = cus;
    }
    if (grid < 0) return;
    (void)hipMemsetAsync(d_ws, 0, 65536, stream);
    Args a{};
    for (int i = 0; i < 34; ++i) a.in[i] = (const float*)d_in[i];
    a.out = (float*)d_out; a.ws = (unsigned char*)d_ws;
#if MK_ONE_LAUNCH
    a.ph_lo = 0; a.ph_hi = N_PHASE_IDS;
    hipLaunchKernelGGL(fwd_kernel, dim3(grid), dim3(512), LDS_BYTES, stream, a);
#else
    for (int p = 0; p < N_PHASE_IDS; ++p) {
        if (p >= 2) { const int L = (p - 2) / 9, k = (p - 2) % 9; const bool even = (L & 1) == 0; if ((even && k == 3) || (L == 3 && k == 8)) continue; }
        a.ph_lo = p; a.ph_hi = p + 1;
        hipLaunchKernelGGL(fwd_kernel, dim3(grid), dim3(512), LDS_BYTES, stream, a);
    }
#endif
}
```

```cpp
#include <hip/hip_runtime.h>
#include <cstdio>
#include <cstdint>
#define PROF_LAS __attribute__((address_space(3)))
constexpr int LDS_MISC = 131072;
#ifndef DBG_PROF
#define DBG_PROF 0
#endif
#if DBG_PROF
#define PROF_DECL const bool prof_on = (blockIdx.x == 0 && __builtin_amdgcn_readfirstlane((int)threadIdx.x >> 6) == 0); long long prof_t[3] = {0, 0, 0};
#define PROF_START(lvl) do { if (prof_on) prof_t[lvl] = clock64(); } while (0)
#define PROF_STOP(lvl, k) do { if (prof_on) { const long long d_ = clock64() - prof_t[lvl]; if ((threadIdx.x & 63) == 0) { PROF_LAS long long* pa_ = (PROF_LAS long long*)(lds + LDS_MISC + 640); pa_[k] += d_; } } } while (0)
#else
#define PROF_DECL
#define PROF_START(lvl) do {} while (0)
#define PROF_STOP(lvl, k) do {} while (0)
#endif
#ifndef DBG_PROF_N
#define DBG_PROF_N 11264
#endif
namespace pg8 {
#define PG8_LAS __attribute__((address_space(3)))
typedef unsigned short bf16_t;
typedef short bf16x8 __attribute__((ext_vector_type(8)));
typedef float f32x4 __attribute__((ext_vector_type(4)));
typedef unsigned u32x4 __attribute__((ext_vector_type(4)));
constexpr int BM = 256, BK = 64, HALF = 128, HTB = HALF * BK * 2  , STAGE_BYTES = 8 * HTB, NXCD = 8, WGM = 8;

__host__ __device__ __forceinline__ int lds_byte(int r, int c) { const int st = (r >> 4) * 2 + (c >> 5), rr = r & 15, cc = c & 31, ob = rr * 64 + cc * 2; return st * 1024 + (ob ^ (((ob >> 9) & 1) << 5)); }
__host__ __device__ __forceinline__ void stage_rc(int b, int& R, int& C) { const int st = b / 1024, sb = b % 1024, swz = sb ^ (((sb >> 9) & 1) << 5); R = (st >> 1) * 16 + swz / 64; C = (st & 1) * 32 + (swz % 64) / 2; }
__host__ __device__ __forceinline__ int perm32(int rho) { const int n = rho >> 4, i = rho & 15; return 8 * (i >> 2) + 4 * n + (i & 3); }

struct Unit { int pm, pn; };
struct Gemm { const bf16_t* A; const bf16_t* Bt; int M, N, K; int kt; };

struct StaticOrder {
    int nM, nN, nwg, G, c;
    __host__ __device__ void init(int M, int N, int G_, int c_) { nM = M / BM; nN = N / BM; nwg = nM * nN; G = G_; c = c_; }
    __host__ __device__ bool next(int i, Unit& u) const {
        const long L = (long)i * G + c; if (L >= nwg) return false;
        int wgid = (int)L; { const int q = nwg / NXCD, r = nwg % NXCD, xcd = wgid % NXCD, off = wgid / NXCD; wgid = (xcd < r ? xcd * (q + 1) : r * (q + 1) + (xcd - r) * q) + off; }
        const int nig = WGM * nN, gid = wgid / nig, fm = gid * WGM, gsz = (nM - fm) < WGM ? (nM - fm) : WGM;
        u.pm = fm + ((wgid % nig) % gsz); u.pn = (wgid % nig) / gsz; return true;
    }
    __device__ __forceinline__ void a_ready(const Unit&) const {}
    __device__ __forceinline__ void done(const Unit&) const {}
};

struct TailOrder {
    int c;
    __host__ __device__ bool next(int i, Unit& u) const { if (i > 0 || c >= 128) return false; u.pm = 64 + (c >> 3); u.pn = c & 7; return true; }
    __device__ __forceinline__ void a_ready(const Unit&) const {}
    __device__ __forceinline__ void done(const Unit&) const {}
};

struct EarlyO1Order {
    int c;
    __host__ __device__ bool next(int i, Unit& u) const { if (i >= 2 || c < 128) return false; const int x = (c - 128) * 2 + i; u.pm = x >> 2; u.pn = x & 3; return true; }
    __device__ __forceinline__ void a_ready(const Unit&) const {}
    __device__ __forceinline__ void done(const Unit&) const {}
};
struct O1RestOrder {
    int G, c;
    __host__ __device__ bool next(int i, Unit& u) const {
        const int L = i * G + c; if (L >= 3024) return false;
        const int wgid = (L % NXCD) * (3024 / NXCD) + L / NXCD;
        if (wgid < 2368) { const int gid = wgid / 296, rem = wgid % 296; u.pm = gid * 8 + (rem & 7); u.pn = 4 + (rem >> 3); }
        else { const int w2 = wgid - 2368, gid = w2 / 328, rem = w2 % 328; u.pm = 64 + gid * 8 + (rem & 7); u.pn = rem >> 3; }
        return true;
    }
    __device__ __forceinline__ void a_ready(const Unit&) const {}
    __device__ __forceinline__ void done(const Unit&) const {}
};

struct TailOrderE {
    int G, c;
    __host__ __device__ bool next(int i, Unit& u) const { const int L = i * G + c; if (L >= 320) return false; u.pm = 64 + L / 20; u.pn = L % 20; return true; }
    __device__ __forceinline__ void a_ready(const Unit&) const {}
    __device__ __forceinline__ void done(const Unit&) const {}
};

typedef __bf16 bf16v2 __attribute__((ext_vector_type(2)));
typedef float f32v2 __attribute__((ext_vector_type(2)));
__device__ __forceinline__ unsigned cvt_pk_bf16(float lo, float hi) { const f32v2 v = {lo, hi}; const bf16v2 b = __builtin_convertvector(v, bf16v2); return __builtin_bit_cast(unsigned, b); }
__device__ __forceinline__ float fast_sigmoid(float x) { return __builtin_amdgcn_rcpf(1.0f + __builtin_amdgcn_exp2f(-1.4426950408889634f * x)); }

struct EpiStore {
    static constexpr bool PERM = true, AFTER_DRAIN = false;
    bf16_t* O; int ldc;
    __device__ __forceinline__ void operator()(const f32x4 (&acc)[2][2][4][2], const Unit& u, int wr, int wc, int fr, int fq) const {
        const int row0 = u.pm * BM + wr * 64 + fr, col0 = u.pn * BM + wc * 32 + 8 * fq;
#pragma unroll
        for (int ai = 0; ai < 2; ++ai)
#pragma unroll
            for (int m = 0; m < 4; ++m) { bf16_t* rowp = O + (size_t)(row0 + ai * HALF + m * 16) * ldc + col0;
#pragma unroll
                for (int bj = 0; bj < 2; ++bj) { const f32x4 v0 = acc[ai][bj][m][0], v1 = acc[ai][bj][m][1];
                    u32x4 w; w.x = cvt_pk_bf16(v0[0], v0[1]); w.y = cvt_pk_bf16(v0[2], v0[3]); w.z = cvt_pk_bf16(v1[0], v1[1]); w.w = cvt_pk_bf16(v1[2], v1[3]);
                    *(u32x4*)(rowp + bj * HALF) = w; } }
    }
};
struct EpiOdd1 {
    static constexpr bool PERM = true, AFTER_DRAIN = false;
    bf16_t* Z; bf16_t* XBC; float* DTRAW;
    __device__ __forceinline__ void operator()(const f32x4 (&acc)[2][2][4][2], const Unit& u, int wr, int wc, int fr, int fq) const {
        const int row0 = u.pm * BM + wr * 64 + fr;
        if (u.pn >= 40) {
#pragma unroll
            for (int ai = 0; ai < 2; ++ai)
#pragma unroll
                for (int m = 0; m < 4; ++m) { float* rp = DTRAW + (size_t)(row0 + ai * HALF + m * 16) * 128 + wc * 32 + 8 * fq;
                    *(f32x4*)(rp) = acc[ai][0][m][0]; *(f32x4*)(rp + 4) = acc[ai][0][m][1]; }
            return;
        }
        bf16_t* base; int ldc, colt;
        const bool zt = u.pn < 16;
        if (zt) { base = Z; ldc = 4096; colt = u.pn * BM; } else { base = XBC; ldc = 6144; colt = (u.pn - 16) * BM; }
        const int col0 = colt + wc * 32 + 8 * fq;
#pragma unroll
        for (int ai = 0; ai < 2; ++ai)
#pragma unroll
            for (int m = 0; m < 4; ++m) { bf16_t* rowp = base + (size_t)(row0 + ai * HALF + m * 16) * ldc + col0;
#pragma unroll
                for (int bj = 0; bj < 2; ++bj) { f32x4 v0 = acc[ai][bj][m][0], v1 = acc[ai][bj][m][1];
                    if (zt) {
#pragma unroll
                        for (int q = 0; q < 4; ++q) { v0[q] = v0[q] * fast_sigmoid(v0[q]); v1[q] = v1[q] * fast_sigmoid(v1[q]); } }
                    u32x4 w; w.x = cvt_pk_bf16(v0[0], v0[1]); w.y = cvt_pk_bf16(v0[2], v0[3]); w.z = cvt_pk_bf16(v1[0], v1[1]); w.w = cvt_pk_bf16(v1[2], v1[3]);
                    *(u32x4*)(rowp + bj * HALF) = w; } }
    }
};
struct EpiSwiGLU {
    static constexpr bool PERM = true, AFTER_DRAIN = false;
    bf16_t* O; int ldc;
    __device__ __forceinline__ void operator()(const f32x4 (&acc)[2][2][4][2], const Unit& u, int wr, int wc, int fr, int fq) const {
        const int row0 = u.pm * BM + wr * 64 + fr, col0 = u.pn * HALF + wc * 32 + 8 * fq;
#pragma unroll
        for (int ai = 0; ai < 2; ++ai)
#pragma unroll
            for (int m = 0; m < 4; ++m) { bf16_t* rowp = O + (size_t)(row0 + ai * HALF + m * 16) * ldc + col0;
                float o[8];
#pragma unroll
                for (int n = 0; n < 2; ++n)
#pragma unroll
                    for (int j = 0; j < 4; ++j) { const float g = acc[ai][0][m][n][j], uu = acc[ai][1][m][n][j]; o[n * 4 + j] = g * fast_sigmoid(g) * uu; }
                u32x4 w; w.x = cvt_pk_bf16(o[0], o[1]); w.y = cvt_pk_bf16(o[2], o[3]); w.z = cvt_pk_bf16(o[4], o[5]); w.w = cvt_pk_bf16(o[6], o[7]);
                *(u32x4*)(rowp) = w; }
    }
};
struct EpiResid {
    static constexpr bool PERM = true, AFTER_DRAIN = false;
    bf16_t* Y; const float* gate; float* OUTF;
    __device__ __forceinline__ void operator()(const f32x4 (&acc)[2][2][4][2], const Unit& u, int wr, int wc, int fr, int fq) const {
        const int row0 = u.pm * BM + wr * 64 + fr, col0 = u.pn * BM + wc * 32 + 8 * fq;
        const int cond = u.pm < 16 ? 0 : 1 + ((u.pm - 16) >> 3);
        const float* gp = gate + (size_t)cond * 12288 + col0;
        f32x4 gv[2][2];
#pragma unroll
        for (int bj = 0; bj < 2; ++bj)
#pragma unroll
            for (int n = 0; n < 2; ++n) gv[bj][n] = *(const f32x4*)(gp + bj * HALF + 4 * n);
#pragma unroll
        for (int ai = 0; ai < 2; ++ai)
#pragma unroll
            for (int m = 0; m < 4; ++m) { const size_t off = (size_t)(row0 + ai * HALF + m * 16) * 2048 + col0;
#pragma unroll
                for (int bj = 0; bj < 2; ++bj) {
                    const u32x4 yv = *(const u32x4*)(Y + off + bj * HALF);
                    f32x4 o0, o1;
                    o0[0] = __uint_as_float(yv.x << 16); o0[1] = __uint_as_float(yv.x & 0xffff0000u); o0[2] = __uint_as_float(yv.y << 16); o0[3] = __uint_as_float(yv.y & 0xffff0000u);
                    o1[0] = __uint_as_float(yv.z << 16); o1[1] = __uint_as_float(yv.z & 0xffff0000u); o1[2] = __uint_as_float(yv.w << 16); o1[3] = __uint_as_float(yv.w & 0xffff0000u);
                    o0 = o0 + gv[bj][0] * acc[ai][bj][m][0]; o1 = o1 + gv[bj][1] * acc[ai][bj][m][1];
                    if (OUTF) { *(f32x4*)(OUTF + off + bj * HALF) = o0; *(f32x4*)(OUTF + off + bj * HALF + 4) = o1; }
                    else { u32x4 w; w.x = cvt_pk_bf16(o0[0], o0[1]); w.y = cvt_pk_bf16(o0[2], o0[3]); w.z = cvt_pk_bf16(o1[0], o1[1]); w.w = cvt_pk_bf16(o1[2], o1[3]); *(u32x4*)(Y + off + bj * HALF) = w; } } }
    }
};

struct EpiPartW {
    static constexpr bool PERM = true, AFTER_DRAIN = false;
    float* P; unsigned* flags;
    __device__ __forceinline__ void operator()(const f32x4 (&acc)[2][2][4][2], const Unit& u, int wr, int wc, int fr, int fq) const {
        const int unit = (u.pm - 64) * 8 + u.pn; int tid = threadIdx.x; asm volatile("" : "+v"(tid));
        float* base = P + ((size_t)unit * 32 * 512 + tid) * 4;
#pragma unroll
        for (int ai = 0; ai < 2; ++ai)
#pragma unroll
            for (int bj = 0; bj < 2; ++bj)
#pragma unroll
                for (int m = 0; m < 4; ++m)
#pragma unroll
                    for (int n = 0; n < 2; ++n) *(f32x4*)(base + (size_t)((((ai * 2 + bj) * 4 + m) * 2 + n) * 512) * 4) = acc[ai][bj][m][n];
        asm volatile("s_waitcnt vmcnt(0)" ::: "memory");
        __builtin_amdgcn_fence(__ATOMIC_RELEASE, "agent");
        asm volatile("s_waitcnt vmcnt(0)" ::: "memory");
        if ((tid & 63) == 0) (void)__hip_atomic_fetch_add(flags + unit * 16, 1u, __ATOMIC_RELAXED, __HIP_MEMORY_SCOPE_AGENT);
    }
};
struct EpiResidP {
    static constexpr bool PERM = true, AFTER_DRAIN = false;
    bf16_t* Y; const float* gate; float* OUTF; const float* P; unsigned* flags;
    __device__ __forceinline__ void operator()(const f32x4 (&acc)[2][2][4][2], const Unit& u, int wr, int wc, int fr, int fq) const {
        const int unit = (u.pm - 64) * 8 + u.pn; int tid = threadIdx.x; asm volatile("" : "+v"(tid));
        { unsigned sp = 0; while (__hip_atomic_load(flags + unit * 16, __ATOMIC_RELAXED, __HIP_MEMORY_SCOPE_AGENT) < 8u && ++sp < (1u << 20)) __builtin_amdgcn_s_sleep(2); }
        __builtin_amdgcn_fence(__ATOMIC_ACQUIRE, "agent");
        asm volatile("s_waitcnt vmcnt(0)" ::: "memory");
        const float* pb = P + ((size_t)unit * 32 * 512 + tid) * 4;
        const int row0 = u.pm * BM + wr * 64 + fr, col0 = u.pn * BM + wc * 32 + 8 * fq;
        const int cond = u.pm < 16 ? 0 : 1 + ((u.pm - 16) >> 3);
        const float* gp = gate + (size_t)cond * 12288 + col0;
        f32x4 gv[2][2];
#pragma unroll
        for (int bj = 0; bj < 2; ++bj)
#pragma unroll
            for (int n = 0; n < 2; ++n) gv[bj][n] = *(const f32x4*)(gp + bj * HALF + 4 * n);
#pragma unroll
        for (int ai = 0; ai < 2; ++ai)
#pragma unroll
            for (int m = 0; m < 4; ++m) { const size_t off = (size_t)(row0 + ai * HALF + m * 16) * 2048 + col0;
#pragma unroll
                for (int bj = 0; bj < 2; ++bj) {
                    const u32x4 yv = *(const u32x4*)(Y + off + bj * HALF);
                    const f32x4 p0 = *(const f32x4*)(pb + (size_t)((((ai * 2 + bj) * 4 + m) * 2 + 0) * 512) * 4), p1 = *(const f32x4*)(pb + (size_t)((((ai * 2 + bj) * 4 + m) * 2 + 1) * 512) * 4);
                    f32x4 o0, o1;
                    o0[0] = __uint_as_float(yv.x << 16); o0[1] = __uint_as_float(yv.x & 0xffff0000u); o0[2] = __uint_as_float(yv.y << 16); o0[3] = __uint_as_float(yv.y & 0xffff0000u);
                    o1[0] = __uint_as_float(yv.z << 16); o1[1] = __uint_as_float(yv.z & 0xffff0000u); o1[2] = __uint_as_float(yv.w << 16); o1[3] = __uint_as_float(yv.w & 0xffff0000u);
                    o0 = o0 + gv[bj][0] * (acc[ai][bj][m][0] + p0); o1 = o1 + gv[bj][1] * (acc[ai][bj][m][1] + p1);
                    if (OUTF) { *(f32x4*)(OUTF + off + bj * HALF) = o0; *(f32x4*)(OUTF + off + bj * HALF + 4) = o1; }
                    else { u32x4 w; w.x = cvt_pk_bf16(o0[0], o0[1]); w.y = cvt_pk_bf16(o0[2], o0[3]); w.z = cvt_pk_bf16(o1[0], o1[1]); w.w = cvt_pk_bf16(o1[2], o1[3]); *(u32x4*)(Y + off + bj * HALF) = w; } } }
    }
};

struct EpiDummy {
    static constexpr bool PERM = false, AFTER_DRAIN = false;
    float* Y;
    __device__ __forceinline__ void operator()(const f32x4 (&acc)[2][2][4][2], const Unit& u, int wr, int wc, int fr, int fq) const {
        const int row0 = u.pm * BM + wr * 64 + fr, col0 = u.pn * BM + wc * 32 + 4 * fq;
#pragma unroll
        for (int ai = 0; ai < 2; ++ai)
#pragma unroll
            for (int m = 0; m < 4; ++m) { float* rowp = Y + (size_t)(row0 + ai * HALF + m * 16) * 2048 + col0;
#pragma unroll
                for (int bj = 0; bj < 2; ++bj)
#pragma unroll
                    for (int n = 0; n < 2; ++n) *(f32x4*)(rowp + bj * HALF + n * 16) = acc[ai][bj][m][n]; }
    }
};
template <class Epi, class Sched, bool ALIGN_EPI = false, bool SP2 = false>
__device__ __forceinline__ void gemm_phase(PG8_LAS unsigned char* lds, const Gemm g, const Sched& S, const Epi& E) {
    int tid_ = threadIdx.x; asm volatile("" : "+v"(tid_)); const int tid = tid_, wid = __builtin_amdgcn_readfirstlane(tid >> 6), lane = tid & 63, wr = wid >> 2, wc = wid & 3, fr = lane & 15, fq = lane >> 4;
    const int K = g.K, nt = (g.kt ? g.kt : K) / BK;
    unsigned voffA[2], voffB[2];
#pragma unroll
    for (int i = 0; i < 2; ++i) { int R, C; stage_rc(tid * 16 + i * 8192, R, C); const int Rb = Epi::PERM ? ((R & ~31) + perm32(R & 31)) : R;
        voffA[i] = (unsigned)(R * K + C) * 2u; voffB[i] = (unsigned)(Rb * K + C) * 2u; }
    const size_t kstep = (size_t)(BK * 2);
    const size_t hstep = (size_t)HALF * K * 2;
    const size_t tstep = 2 * hstep;
    const unsigned ldsw = (unsigned)wid * 1024u;
    const int aoff = lds_byte(wr * 64 + fr, fq * 8), boff = lds_byte(wc * 32 + fr, fq * 8);
#define PG8_SA(b, h) (((b) * 2 + (h)) * HTB)
#define PG8_SB(b, h) ((4 + (b) * 2 + (h)) * HTB)
#define PG8_STAGE(bufoff, gbase, voff) do { _Pragma("unroll") for (int _i = 0; _i < 2; ++_i) \
        __builtin_amdgcn_global_load_lds((const unsigned*)((const char*)(gbase) + (voff)[_i]), (PG8_LAS unsigned*)(lds + (bufoff) + ldsw + _i * 8192), 16, 0, 0); } while (0)
#define PG8_LDA(dst, b, h) do { _Pragma("unroll") for (int m = 0; m < 4; ++m) _Pragma("unroll") for (int k = 0; k < 2; ++k) dst[m][k] = *(const PG8_LAS bf16x8*)(lds + PG8_SA(b, h) + aoff + m * 2048 + k * 1024); } while (0)
#define PG8_LDB(dst, b, h) do { _Pragma("unroll") for (int n = 0; n < 2; ++n) _Pragma("unroll") for (int k = 0; k < 2; ++k) dst[n][k] = *(const PG8_LAS bf16x8*)(lds + PG8_SB(b, h) + boff + n * 2048 + k * 1024); } while (0)
#define PG8_MMA(ai, bj, At, Bt) do { __builtin_amdgcn_s_setprio(1); _Pragma("unroll") for (int m = 0; m < 4; ++m) _Pragma("unroll") for (int n = 0; n < 2; ++n) _Pragma("unroll") for (int k = 0; k < 2; ++k) \
        acc[ai][bj][m][n] = __builtin_amdgcn_mfma_f32_16x16x32_bf16(Bt[n][k], At[m][k], acc[ai][bj][m][n], 0, 0, 0); __builtin_amdgcn_s_setprio(0); } while (0)
#define PG8_WAIT_V(n) asm volatile("s_waitcnt vmcnt(" #n ")" ::: "memory")
#define PG8_WAIT_L(n) asm volatile("s_waitcnt lgkmcnt(" #n ")" ::: "memory")
#define PG8_BAR __builtin_amdgcn_s_barrier()
#define PG8_SCHED __builtin_amdgcn_sched_barrier(0)
    Unit cur, nxt; int ui = 0;
    if (!S.next(0, cur)) return;
    PROF_DECL
    if (g.N == DBG_PROF_N) PROF_START(0);
    f32x4 acc[2][2][4][2];
#pragma unroll
    for (int a = 0; a < 2; ++a)
#pragma unroll
        for (int b = 0; b < 2; ++b)
#pragma unroll
            for (int m = 0; m < 4; ++m)
#pragma unroll
                for (int n = 0; n < 2; ++n) acc[a][b][m][n] = (f32x4){0.f, 0.f, 0.f, 0.f};
    bf16x8 At[4][2], B0[2][2], B1[2][2];
    const char* cA = (const char*)g.A + (size_t)cur.pm * tstep; const char* cB = (const char*)g.Bt + (size_t)cur.pn * tstep;
    S.a_ready(cur);
    if constexpr (SP2) {
        PG8_STAGE(PG8_SB(0, 0), cB, voffB); PG8_STAGE(PG8_SB(0, 1), cB + hstep, voffB); PG8_STAGE(PG8_SA(0, 0), cA, voffA); PG8_STAGE(PG8_SA(0, 1), cA + hstep, voffA);
        if (wr == 1) PG8_BAR;
        PG8_WAIT_V(2); PG8_BAR;
        PG8_STAGE(PG8_SB(1, 0), cB + kstep, voffB); PG8_STAGE(PG8_SA(1, 0), cA + kstep, voffA); PG8_STAGE(PG8_SB(1, 1), cB + hstep + kstep, voffB);
        PG8_WAIT_V(6); PG8_BAR;
    } else {
        PG8_STAGE(PG8_SB(0, 0), cB, voffB); PG8_STAGE(PG8_SA(0, 0), cA, voffA); PG8_STAGE(PG8_SB(0, 1), cB + hstep, voffB); PG8_STAGE(PG8_SA(0, 1), cA + hstep, voffA);
        if (wr == 1) PG8_BAR;
        PG8_WAIT_V(4); PG8_BAR;
        PG8_STAGE(PG8_SB(1, 0), cB + kstep, voffB); PG8_STAGE(PG8_SA(1, 0), cA + kstep, voffA); PG8_STAGE(PG8_SB(1, 1), cB + hstep + kstep, voffB);
        PG8_WAIT_V(6); PG8_BAR;
    }
    for (;;) {
        const bool has_next = S.next(ui + 1, nxt);
        const char* nA = has_next ? (const char*)g.A + (size_t)nxt.pm * tstep : cA; const char* nB = has_next ? (const char*)g.Bt + (size_t)nxt.pn * tstep : cB;
        for (int t = 0; t < nt; t += 2) {
            const bool last = (t == nt - 2);
            const char* a1 = cA + (size_t)(t + 1) * kstep;
            const char* a2 = last ? nA : cA + (size_t)(t + 2) * kstep; const char* b2 = last ? nB : cB + (size_t)(t + 2) * kstep;
            const char* a3 = a2 + kstep; const char* b3 = b2 + kstep;
            if (last && has_next) S.a_ready(nxt);
            if constexpr (SP2) {
            PG8_LDB(B0, 0, 0); PG8_LDB(B1, 0, 1); PG8_SCHED; PG8_LDA(At, 0, 0); PG8_STAGE(PG8_SA(1, 1), a1 + hstep, voffA);
            PG8_WAIT_V(8); PG8_WAIT_L(0); PG8_BAR; PG8_MMA(0, 0, At, B0); PG8_MMA(0, 1, At, B1); PG8_BAR; PG8_SCHED;
            PG8_LDA(At, 0, 1); PG8_STAGE(PG8_SB(0, 0), b2, voffB); PG8_STAGE(PG8_SB(0, 1), b2 + hstep, voffB); PG8_STAGE(PG8_SA(0, 0), a2, voffA);
            PG8_WAIT_V(8); PG8_WAIT_L(0); PG8_BAR; PG8_MMA(1, 0, At, B0); PG8_MMA(1, 1, At, B1); PG8_BAR; PG8_SCHED;
            PG8_LDB(B0, 1, 0); PG8_LDB(B1, 1, 1); PG8_SCHED; PG8_LDA(At, 1, 0); PG8_STAGE(PG8_SA(0, 1), a2 + hstep, voffA);
            PG8_WAIT_V(8); PG8_WAIT_L(0); PG8_BAR; PG8_MMA(0, 0, At, B0); PG8_MMA(0, 1, At, B1); PG8_BAR; PG8_SCHED;
            PG8_LDA(At, 1, 1); PG8_STAGE(PG8_SB(1, 0), b3, voffB); PG8_STAGE(PG8_SB(1, 1), b3 + hstep, voffB); PG8_STAGE(PG8_SA(1, 0), a3, voffA);
            PG8_WAIT_V(8); PG8_WAIT_L(0); PG8_BAR; PG8_MMA(1, 0, At, B0); PG8_MMA(1, 1, At, B1); PG8_BAR; PG8_SCHED;
            } else {
            PG8_LDB(B0, 0, 0); PG8_SCHED; PG8_LDA(At, 0, 0); PG8_STAGE(PG8_SA(1, 1), a1 + hstep, voffA);
            PG8_WAIT_L(8); PG8_BAR; PG8_WAIT_L(0); PG8_MMA(0, 0, At, B0); PG8_BAR; PG8_SCHED;
            PG8_LDB(B1, 0, 1); PG8_STAGE(PG8_SB(0, 0), b2, voffB);
            PG8_BAR; PG8_WAIT_L(0); PG8_MMA(0, 1, At, B1); PG8_BAR;
            PG8_LDA(At, 0, 1); PG8_STAGE(PG8_SA(0, 0), a2, voffA);
            PG8_BAR; PG8_WAIT_L(0); PG8_MMA(1, 0, At, B0); PG8_BAR; PG8_SCHED;
            PG8_STAGE(PG8_SB(0, 1), b2 + hstep, voffB);
            PG8_WAIT_V(6); PG8_BAR; PG8_MMA(1, 1, At, B1); PG8_BAR;
            PG8_LDB(B0, 1, 0); PG8_SCHED; PG8_LDA(At, 1, 0); PG8_STAGE(PG8_SA(0, 1), a2 + hstep, voffA);
            PG8_WAIT_L(8); PG8_BAR; PG8_WAIT_L(0); PG8_MMA(0, 0, At, B0); PG8_BAR; PG8_SCHED;
            PG8_LDB(B1, 1, 1); PG8_STAGE(PG8_SB(1, 0), b3, voffB);
            PG8_BAR; PG8_WAIT_L(0); PG8_MMA(0, 1, At, B1); PG8_BAR;
            PG8_LDA(At, 1, 1); PG8_STAGE(PG8_SA(1, 0), a3, voffA);
            PG8_BAR; PG8_WAIT_L(0); PG8_MMA(1, 0, At, B0); PG8_BAR; PG8_SCHED;
            PG8_STAGE(PG8_SB(1, 1), b3 + hstep, voffB);
            PG8_WAIT_V(6); PG8_BAR; PG8_MMA(1, 1, At, B1); PG8_BAR;
            }
        }
        if constexpr (ALIGN_EPI) { if (wr == 0) PG8_BAR; }
        if (g.N == DBG_PROF_N) PROF_START(1);
        if constexpr (!Epi::AFTER_DRAIN) { E(acc, cur, wr, wc, fr, fq); S.done(cur); }
        if (g.N == DBG_PROF_N) PROF_STOP(1, 10);
        if (!has_next) break;
#pragma unroll
        for (int a = 0; a < 2; ++a)
#pragma unroll
            for (int b = 0; b < 2; ++b)
#pragma unroll
                for (int m = 0; m < 4; ++m)
#pragma unroll
                    for (int n = 0; n < 2; ++n) acc[a][b][m][n] = (f32x4){0.f, 0.f, 0.f, 0.f};
        cur = nxt; cA = nA; cB = nB; ++ui;
        if constexpr (ALIGN_EPI) { if (wr == 1) PG8_BAR; }
    }
    if (g.N == DBG_PROF_N) PROF_STOP(0, 11);
    PG8_WAIT_V(0);
    if constexpr (!ALIGN_EPI) { if (wr == 0) PG8_BAR; }
    PG8_BAR;
    if constexpr (Epi::AFTER_DRAIN) { E.fused(acc, cur, wr, wc, fr, fq, lds, wid, lane); S.done(cur); }
#undef PG8_SA
#undef PG8_SB
#undef PG8_STAGE
#undef PG8_LDA
#undef PG8_LDB
#undef PG8_MMA
#undef PG8_WAIT_V
#undef PG8_WAIT_L
#undef PG8_BAR
#undef PG8_SCHED
}
}

#define GAS __attribute__((address_space(1)))
#define LAS __attribute__((address_space(3)))
typedef unsigned short bf16_t;
typedef short bf16x8 __attribute__((ext_vector_type(8)));
typedef short bf16x4 __attribute__((ext_vector_type(4)));
typedef float f32x4 __attribute__((ext_vector_type(4)));
typedef float f32x2 __attribute__((ext_vector_type(2)));
typedef unsigned u32x4 __attribute__((ext_vector_type(4)));
typedef unsigned u32x2 __attribute__((ext_vector_type(2)));
#define MFMA16(a, b, c) __builtin_amdgcn_mfma_f32_16x16x32_bf16((a), (b), (c), 0, 0, 0)

constexpr int D = 2048, T = 20480, TP = 4096, NT = 80;
constexpr float EPS = 1e-6f;
constexpr size_t MiB = 1u << 20;
constexpr size_t WS_CTL = 0, WS_ADA = 1 * MiB, WS_ZERO_BYTES = 3 * MiB;
constexpr size_t WS_ROPE = 3 * MiB, WS_LRUW = 4 * MiB, WS_CHS = 6 * MiB;
constexpr size_t WS_WEIN = 16 * MiB, WS_WEOUT = 56 * MiB, WS_WSIN = 72 * MiB, WS_WSOUT = 154 * MiB, WS_WFIN = 186 * MiB, WS_WFOUT = 362 * MiB;
constexpr size_t WS_H = 450 * MiB, WS_R1 = 530 * MiB, WS_R2 = 770 * MiB, WS_R3 = 930 * MiB, WS_R4 = 1090 * MiB, WS_R5 = 1210 * MiB, WS_LR = 1242 * MiB, WS_Y = 1402 * MiB, WS_END = 1482 * MiB;
constexpr size_t WS_U5 = WS_R1, WS_Q = WS_R2, WS_K = WS_R2 + 40 * MiB, WS_KC = WS_R2 + 80 * MiB, WS_VTP = WS_R2 + 84 * MiB, WS_VTS = WS_R2 + 92 * MiB, WS_MIXE = WS_R3;
constexpr size_t WS_XBC = WS_R1, WS_Z = WS_R2, WS_XT = WS_R3, WS_BN = WS_R4, WS_BT = WS_R4 + 40 * MiB, WS_CN = WS_R4 + 80 * MiB, WS_DTRAW = WS_R5;
constexpr size_t WS_SIN = WS_H, WS_MIXO = WS_R1 + 80 * MiB;
constexpr size_t WS_HID = WS_R1;
constexpr size_t OUT_K = 41943040, OUT_V = 50331648, OUT_LRU = 58720256, OUT_SSD = 58785792;
constexpr int LDS_BYTES = LDS_MISC + 1024;

struct Args { const float* in[34]; float* out; unsigned char* ws; int ph_lo, ph_hi; };

__device__ __forceinline__ float bf2f(unsigned short b) { return __uint_as_float(((unsigned)b) << 16); }
__device__ __forceinline__ float bflo(unsigned w) { return __uint_as_float(w << 16); }
__device__ __forceinline__ float bfhi(unsigned w) { return __uint_as_float(w & 0xffff0000u); }
typedef __bf16 bf16v2_t __attribute__((ext_vector_type(2)));
__device__ __forceinline__ unsigned pk2(float lo, float hi) { const f32x2 v = {lo, hi}; const bf16v2_t b = __builtin_convertvector(v, bf16v2_t); return __builtin_bit_cast(unsigned, b); }
__device__ __forceinline__ float fexp(float x) { return __builtin_amdgcn_exp2f(1.4426950408889634f * x); }
__device__ __forceinline__ float fsigmoid(float x) { return __builtin_amdgcn_rcpf(1.0f + __builtin_amdgcn_exp2f(-1.4426950408889634f * x)); }
__device__ __forceinline__ float fsilu(float x) { return x * fsigmoid(x); }
__device__ __forceinline__ float fsoftplus(float x) { return fmaxf(x, 0.f) + log1pf(fexp(-fabsf(x))); }
__device__ __forceinline__ float fgelu_tanh(float x) { const float u = 0.7978845608028654f * (x + 0.044715f * x * x * x); const float t = 1.f - 2.f * __builtin_amdgcn_rcpf(fexp(2.f * u) + 1.f); return 0.5f * x * (1.f + t); }
__device__ __forceinline__ float xor16_max(float v) { const unsigned x = __builtin_bit_cast(unsigned, v); const auto r = __builtin_amdgcn_permlane16_swap(x, x, false, false); return fmaxf(__builtin_bit_cast(float, (unsigned)r[0]), __builtin_bit_cast(float, (unsigned)r[1])); }
__device__ __forceinline__ float xor32_max(float v) { const unsigned x = __builtin_bit_cast(unsigned, v); const auto r = __builtin_amdgcn_permlane32_swap(x, x, false, false); return fmaxf(__builtin_bit_cast(float, (unsigned)r[0]), __builtin_bit_cast(float, (unsigned)r[1])); }
__device__ __forceinline__ float xor16_sum(float v) { const unsigned x = __builtin_bit_cast(unsigned, v); const auto r = __builtin_amdgcn_permlane16_swap(x, x, false, false); return __builtin_bit_cast(float, (unsigned)r[0]) + __builtin_bit_cast(float, (unsigned)r[1]); }
__device__ __forceinline__ float xor32_sum(float v) { const unsigned x = __builtin_bit_cast(unsigned, v); const auto r = __builtin_amdgcn_permlane32_swap(x, x, false, false); return __builtin_bit_cast(float, (unsigned)r[0]) + __builtin_bit_cast(float, (unsigned)r[1]); }
__device__ __forceinline__ float wave_sum(float v) {
    v += __builtin_bit_cast(float, __builtin_amdgcn_update_dpp(0, __builtin_bit_cast(int, v), 0xB1, 0xf, 0xf, false));
    v += __builtin_bit_cast(float, __builtin_amdgcn_update_dpp(0, __builtin_bit_cast(int, v), 0x4E, 0xf, 0xf, false));
    v += __builtin_bit_cast(float, __builtin_amdgcn_update_dpp(0, __builtin_bit_cast(int, v), 0x141, 0xf, 0xf, false));
    v += __builtin_bit_cast(float, __builtin_amdgcn_update_dpp(0, __builtin_bit_cast(int, v), 0x140, 0xf, 0xf, false));
    v = xor16_sum(v); v = xor32_sum(v);
    return v;
}
__device__ __forceinline__ void unpack8(const u32x4 v, float (&f)[8]) { f[0] = bflo(v.x); f[1] = bfhi(v.x); f[2] = bflo(v.y); f[3] = bfhi(v.y); f[4] = bflo(v.z); f[5] = bfhi(v.z); f[6] = bflo(v.w); f[7] = bfhi(v.w); }
__device__ __forceinline__ u32x4 pack8(const float (&f)[8]) { u32x4 w; w.x = pk2(f[0], f[1]); w.y = pk2(f[2], f[3]); w.z = pk2(f[4], f[5]); w.w = pk2(f[6], f[7]); return w; }
__device__ __forceinline__ bf16x8 as_bf16x8(u32x4 v) { return __builtin_bit_cast(bf16x8, v); }
__device__ __forceinline__ int cond_of_tok(int t) { return t < TP ? 0 : 1 + ((t - TP) >> 11); }
__device__ __forceinline__ int otid() { int t = threadIdx.x; asm volatile("" : "+v"(t)); return t; }
template <int N> __device__ __forceinline__ float dpp_row_shr(float v) { const int x = __builtin_bit_cast(int, v); return __builtin_bit_cast(float, __builtin_amdgcn_update_dpp(x, x, 0x110 + N, 0xf, 0xf, false)); }
template <int N> __device__ __forceinline__ float dpp_row_shl(float v) { const int x = __builtin_bit_cast(int, v); return __builtin_bit_cast(float, __builtin_amdgcn_update_dpp(x, x, 0x100 + N, 0xf, 0xf, false)); }
template <int N> __device__ __forceinline__ float dpp_row_shr_fill(float v, float fill) { return __builtin_bit_cast(float, __builtin_amdgcn_update_dpp(__builtin_bit_cast(int, fill), __builtin_bit_cast(int, v), 0x110 + N, 0xf, 0xf, false)); }
template <int N> __device__ __forceinline__ float dpp_row_shl_fill(float v, float fill) { return __builtin_bit_cast(float, __builtin_amdgcn_update_dpp(__builtin_bit_cast(int, fill), __builtin_bit_cast(int, v), 0x100 + N, 0xf, 0xf, false)); }
template <int CTRL, int RM = 0xf, int BM = 0xf> __device__ __forceinline__ float dpp_mov(float old, float src) { return __builtin_bit_cast(float, __builtin_amdgcn_update_dpp(__builtin_bit_cast(int, old), __builtin_bit_cast(int, src), CTRL, RM, BM, false)); }
__device__ __forceinline__ float quad_xor1(float x) { return dpp_mov<0xB1>(x, x); }
__device__ __forceinline__ float quad_xor2(float x) { return dpp_mov<0x4E>(x, x); }
__device__ __forceinline__ float row_bcast_hi(float x) { float t = dpp_mov<0xFF>(x, x); t = dpp_mov<0x104, 0xf, 0x4>(t, t); t = dpp_mov<0x108, 0xf, 0x3>(t, t); return t; }
__device__ __forceinline__ float row_bcast_lo(float x) { float t = dpp_mov<0x00>(x, x); t = dpp_mov<0x114, 0xf, 0x2>(t, t); t = dpp_mov<0x118, 0xf, 0xC>(t, t); return t; }
__device__ __forceinline__ float wave_scan_incl(float v) {
    v += dpp_mov<0x111>(0.f, v); v += dpp_mov<0x112>(0.f, v); v += dpp_mov<0x114>(0.f, v); v += dpp_mov<0x118>(0.f, v);
    v += dpp_mov<0x142, 0xA>(0.f, v); v += dpp_mov<0x143, 0xC>(0.f, v);
    return v;
}
#define WG_SYNC() asm volatile("s_waitcnt lgkmcnt(0)\n\ts_barrier" ::: "memory")
#ifndef DBG_TWICE
#define DBG_TWICE 0
#endif

#define XB_TMO      128
#define XB_XCNT(j)  (256  + 64 * (j))
#define XB_XSUB(j)  (1280 + 64 * (j))
#define XB_XGEN(j)  (2304 + 64 * (j))
#define XB_TOP      3328
#define XB_TOPGEN   3392
#define XCD_BAR_WORDS 3456
#define XB_SPIN_CAP (1u << 18)

__device__ __forceinline__ unsigned xb_ld(unsigned* p)              { return __hip_atomic_load(p, __ATOMIC_RELAXED, __HIP_MEMORY_SCOPE_AGENT); }
__device__ __forceinline__ unsigned xb_add(unsigned* p, unsigned v) { return __hip_atomic_fetch_add(p, v, __ATOMIC_RELAXED, __HIP_MEMORY_SCOPE_AGENT); }
__device__ __forceinline__ unsigned xb_xcc_id() { return (unsigned)__builtin_amdgcn_s_getreg((3 << 11) | 20) & 0xFu; }
#define XB_SPIN(cond, bar) do { unsigned _sp = 0; while (cond) { __builtin_amdgcn_s_sleep(1); \
    if ((++_sp & 255u) == 0u) { if (xb_ld(&(bar)[XB_TMO])) break; if (_sp > XB_SPIN_CAP) { atomicAdd(&(bar)[XB_TMO], 1u); break; } } } } while (0)

struct XcdBarrier {
    unsigned* bar; unsigned x;
    volatile LAS unsigned* st;
};

__device__ __forceinline__ XcdBarrier xcd_barrier_post(unsigned* bar, volatile LAS unsigned* st) {
    XcdBarrier b; b.bar = bar; b.x = xb_xcc_id(); b.st = st;
    if (threadIdx.x == 0) (void)xb_add(&bar[XB_XCNT(b.x)], 1u);
    return b;
}
__device__ __forceinline__ void xcd_barrier_complete(unsigned* bar, unsigned x, unsigned& nloc, unsigned& nx) {
    const unsigned G = gridDim.x * gridDim.y * gridDim.z;
    unsigned sum, cnt, mine, sp = 0u;
    for (;;) {
        sum = 0u; cnt = 0u; mine = 0u;
#pragma unroll
        for (unsigned j = 0; j < 16; ++j) { const unsigned c = xb_ld(&bar[XB_XCNT(j)]); sum += c; cnt += (c > 0u) ? 1u : 0u; mine = (j == x) ? c : mine; }
        if (sum == G) break;
        __builtin_amdgcn_s_sleep(1);
        if ((++sp & 255u) == 0u) { if (xb_ld(&bar[XB_TMO])) break; if (sp > XB_SPIN_CAP) { atomicAdd(&bar[XB_TMO], 1u); break; } }
    }
    nloc = mine > 0u ? mine : 1u; nx = cnt > 0u ? cnt : 1u;
}

__device__ __forceinline__ void xcd_barrier(const XcdBarrier& b) {
    asm volatile("s_waitcnt vmcnt(0)" ::: "memory");
    __syncthreads();
    if (threadIdx.x == 0) {
        unsigned* bar = b.bar;
        __builtin_amdgcn_s_waitcnt(0);
        unsigned nloc = b.st[0], nx = b.st[1];
        if (nloc == 0u) { xcd_barrier_complete(bar, b.x, nloc, nx); b.st[0] = nloc; b.st[1] = nx; }
        const unsigned old = xb_add(&bar[XB_XSUB(b.x)], 1u);
        const unsigned gen = old / nloc;
        if (old + 1u == (gen + 1u) * nloc) {
            __builtin_amdgcn_fence(__ATOMIC_RELEASE, "agent");
            asm volatile("s_waitcnt vmcnt(0)" ::: "memory");
            const unsigned og = xb_add(&bar[XB_TOP], 1u);
            const unsigned tg = og / nx;
            if (og + 1u == (tg + 1u) * nx) xb_add(&bar[XB_TOPGEN], 1u);
            else XB_SPIN(xb_ld(&bar[XB_TOPGEN]) == tg, bar);
            __builtin_amdgcn_fence(__ATOMIC_ACQUIRE, "agent");
            xb_add(&bar[XB_XGEN(b.x)], 1u);
            asm volatile("s_waitcnt vmcnt(0)" ::: "memory");
        } else {
            XB_SPIN(xb_ld(&bar[XB_XGEN(b.x)]) == gen, bar);
            __builtin_amdgcn_fence(__ATOMIC_ACQUIRE, "agent");
            asm volatile("s_waitcnt vmcnt(0)" ::: "memory");
        }
    }
    __syncthreads();
}

__device__ __forceinline__ void transpose_item(const float* W, int N, bf16_t* WT, int ldk, int k0, int n0, int drow0, LAS float* scr, int lane) {
#pragma unroll 8
    for (int i = 0; i < 32; ++i) { const int kk = 2 * i + (lane >> 5); scr[kk * 33 + (lane & 31)] = W[(size_t)(k0 + kk) * N + n0 + (lane & 31)]; }
    asm volatile("s_waitcnt lgkmcnt(0)" ::: "memory");
    const int c = lane & 7;
#pragma unroll
    for (int jj = 0; jj < 4; ++jj) { const int n = (lane >> 3) + 8 * jj; const LAS float* s = scr + (8 * c) * 33 + n;
        u32x4 o; o.x = pk2(s[0 * 33], s[1 * 33]); o.y = pk2(s[2 * 33], s[3 * 33]); o.z = pk2(s[4 * 33], s[5 * 33]); o.w = pk2(s[6 * 33], s[7 * 33]);
        *(u32x4*)(WT + (size_t)(drow0 + n) * ldk + k0 + 8 * c) = o; }
    asm volatile("s_waitcnt lgkmcnt(0)" ::: "memory");
}

__device__ __forceinline__ void phase_prologue(const Args& A, LAS unsigned char* lds) {
    const int tid = otid(), lane = tid & 63, wave = tid >> 6;
    unsigned char* ws = A.ws;
    {
        LAS float* s = (LAS float*)lds;
        for (int idx = tid; idx < 9 * 2048; idx += 512) { const int cnd = idx >> 11, k = idx & 2047; const float v = cnd == 0 ? A.in[7][k] : A.in[2][(cnd - 1) * 2048 + k]; s[k * 12 + cnd] = v * fsigmoid(v); }
        WG_SYNC();
        float* ADA = (float*)(ws + WS_ADA);
        LAS float* red = (LAS float*)(lds + 98304);
        for (int it = blockIdx.x; it < 4 * 192; it += gridDim.x) {
            const int layer = it / 192, cg = it - layer * 192, col = cg * 64 + lane;
            float acc[9];
#pragma unroll
            for (int c = 0; c < 9; ++c) acc[c] = 0.f;
            const float* w = A.in[8] + ((size_t)layer * 2048 + wave * 256) * 12288 + col;
#pragma unroll 8
            for (int k = 0; k < 256; ++k) {
                const float wv = w[(size_t)k * 12288];
                const LAS f32x4* sp = (const LAS f32x4*)(s + (wave * 256 + k) * 12);
                const f32x4 s0 = sp[0], s1 = sp[1], s2 = sp[2];
                acc[0] += s0[0] * wv; acc[1] += s0[1] * wv; acc[2] += s0[2] * wv; acc[3] += s0[3] * wv;
                acc[4] += s1[0] * wv; acc[5] += s1[1] * wv; acc[6] += s1[2] * wv; acc[7] += s1[3] * wv; acc[8] += s2[0] * wv;
            }
            WG_SYNC();
#pragma unroll
            for (int c = 0; c < 9; ++c) red[(wave * 9 + c) * 64 + lane] = acc[c];
            WG_SYNC();
            for (int idx = tid; idx < 9 * 64; idx += 512) { const int c = idx >> 6, l = idx & 63; float v = A.in[9][(size_t)layer * 12288 + cg * 64 + l];
#pragma unroll
                for (int wv_ = 0; wv_ < 8; ++wv_) v += red[(wv_ * 9 + c) * 64 + l];
                ADA[((size_t)layer * 9 + c) * 12288 + cg * 64 + l] = v; }
        }
        WG_SYNC();
    }
    {
        float* rope = (float*)(ws + WS_ROPE);
        for (int idx = blockIdx.x * 512 + tid; idx < 2048 * 64; idx += gridDim.x * 512) {
            const int pos = idx >> 6, d = idx & 63, qtr = d >> 4, i = d & 15;
            const float inv = __builtin_amdgcn_exp2f(-(float)i * (13.287712379549449f / 16.0f));
            const float p = (qtr < 2) ? (float)(pos >> 6) : (float)(pos & 63);
            const float rev = p * inv * 0.15915494309189535f;
            rope[idx] = __builtin_amdgcn_cosf(rev); rope[2048 * 64 + idx] = __builtin_amdgcn_sinf(rev);
        }
    }
    {
        LAS float* scr = (LAS float*)(lds + wave * 16384);
        const int gw = blockIdx.x * 8 + wave, NGW = gridDim.x * 8;
        constexpr int I_EIN = 32 * 160, I_EOUT = 32 * 64, I_SIN = 32 * 324, I_SOUT = 64 * 64, I_FIN = 32 * 352, I_FOUT = 88 * 64, I_LRU = 8;
        constexpr int N0 = 2 * I_EIN, N1 = N0 + 2 * I_EOUT, N2 = N1 + 2 * I_SIN, N3 = N2 + 2 * I_SOUT, N4 = N3 + 4 * I_FIN, N5 = N4 + 4 * I_FOUT, N6 = N5 + 64 * I_LRU;
        for (int it = gw; it < N6; it += NGW) {
            if (it < N0) { const int mtx = it / I_EIN, r = it - mtx * I_EIN, kb = r / 160, nb = r - kb * 160;
                transpose_item(A.in[18] + (size_t)mtx * 2048 * 5120, 5120, (bf16_t*)(ws + WS_WEIN) + (size_t)mtx * 5120 * 2048, 2048, kb * 64, nb * 32, nb * 32, scr, lane); }
            else if (it < N1) { const int q = it - N0, mtx = q / I_EOUT, r = q - mtx * I_EOUT, kb = r / 64, nb = r - kb * 64;
                transpose_item(A.in[19] + (size_t)mtx * 2048 * 2048, 2048, (bf16_t*)(ws + WS_WEOUT) + (size_t)mtx * 2048 * 2048, 2048, kb * 64, nb * 32, nb * 32, scr, lane); }
            else if (it < N2) { const int q = it - N1, mtx = q / I_SIN, r = q - mtx * I_SIN, kb = r / 324, nb = r - kb * 324;
                transpose_item(A.in[24] + (size_t)mtx * 2048 * 10368, 10368, (bf16_t*)(ws + WS_WSIN) + (size_t)mtx * 10496 * 2048, 2048, kb * 64, nb * 32, nb * 32, scr, lane); }
            else if (it < N3) { const int q = it - N2, mtx = q / I_SOUT, r = q - mtx * I_SOUT, kb = r / 64, nb = r - kb * 64;
                transpose_item(A.in[31] + (size_t)mtx * 4096 * 2048, 2048, (bf16_t*)(ws + WS_WSOUT) + (size_t)mtx * 2048 * 4096, 4096, kb * 64, nb * 32, nb * 32, scr, lane); }
            else if (it < N4) { const int q = it - N3, mtx = q / I_FIN, r = q - mtx * I_FIN, kb = r / 352, nb = r - kb * 352;
                const int n0 = nb * 32; const int drow = n0 < 5632 ? (n0 >> 7) * 256 + (n0 & 127) : ((n0 - 5632) >> 7) * 256 + 128 + ((n0 - 5632) & 127);
                transpose_item(A.in[32] + (size_t)mtx * 2048 * 11264, 11264, (bf16_t*)(ws + WS_WFIN) + (size_t)mtx * 11264 * 2048, 2048, kb * 64, n0, drow, scr, lane); }
            else if (it < N5) { const int q = it - N4, mtx = q / I_FOUT, r = q - mtx * I_FOUT, kb = r / 64, nb = r - kb * 64;
                transpose_item(A.in[33] + (size_t)mtx * 5632 * 2048, 2048, (bf16_t*)(ws + WS_WFOUT) + (size_t)mtx * 2048 * 5632, 5632, kb * 64, nb * 32, nb * 32, scr, lane); }
            else { const int q = it - N5, mtx = q >> 3, r = q & 7, kb = r >> 2, nb = r & 3;
                const int blk = mtx & 7, gate = (mtx >> 3) & 1, jd = mtx >> 4;
                const float* src = (gate ? A.in[15] : A.in[13]) + ((size_t)jd * 8 + blk) * 16384;
                transpose_item(src, 128, (bf16_t*)(ws + WS_LRUW) + (size_t)mtx * 16384, 128, kb * 64, nb * 32, nb * 32, scr, lane); }
        }
        for (int idx = blockIdx.x * 512 + tid; idx < 2 * 128 * 2048 / 8; idx += gridDim.x * 512) {
            const int mtx = idx / (128 * 256), r = idx - mtx * (128 * 256);
            *(u32x4*)((bf16_t*)(ws + WS_WSIN) + (size_t)mtx * 10496 * 2048 + (size_t)10368 * 2048 + (size_t)r * 8) = (u32x4){0u, 0u, 0u, 0u};
        }
    }
}

__device__ __forceinline__ void phase_modulate(const Args& A, int layer, int which, bool from_x, int row_lo = 0, int row_hi = T, int wg_first = 0, int wg_count = -1) {
    const int tid = otid(), lane = tid & 63, wave = tid >> 6;
    if (wg_count < 0) wg_count = (int)gridDim.x;
    if ((int)blockIdx.x < wg_first || (int)blockIdx.x >= wg_first + wg_count) return;
    const int gw = ((int)blockIdx.x - wg_first) * 8 + wave, NGW = wg_count * 8;
    const float* g = A.in[10] + ((size_t)layer * 2 + which) * 2048;
    const float* ADA = (const float*)(A.ws + WS_ADA);
    bf16_t* H = (bf16_t*)(A.ws + WS_H); bf16_t* Y = (bf16_t*)(A.ws + WS_Y);
    for (int row = row_lo + gw; row < row_hi; row += NGW) {
        const int cond = cond_of_tok(row);
        const float* shift = ADA + ((size_t)layer * 9 + cond) * 12288 + (which * 3 + 0) * 2048;
        const float* scale = shift + 2048;
        float v[4][8]; float ss = 0.f;
        if (from_x) {
            const float* xr = row < TP ? A.in[0] + (size_t)row * 2048 : A.in[1] + (size_t)(row - TP) * 2048;
#pragma unroll
            for (int jj = 0; jj < 4; ++jj) { const int c = 8 * (lane + 64 * jj); const f32x4 a = *(const f32x4*)(xr + c), b = *(const f32x4*)(xr + c + 4);
                const u32x4 w = {pk2(a[0], a[1]), pk2(a[2], a[3]), pk2(b[0], b[1]), pk2(b[2], b[3])};
                *(u32x4*)(Y + (size_t)row * 2048 + c) = w; unpack8(w, v[jj]); }
        } else {
#pragma unroll
            for (int jj = 0; jj < 4; ++jj) unpack8(*(const u32x4*)(Y + (size_t)row * 2048 + 8 * (lane + 64 * jj)), v[jj]);
        }
#pragma unroll
        for (int jj = 0; jj < 4; ++jj)
#pragma unroll
            for (int i = 0; i < 8; ++i) ss += v[jj][i] * v[jj][i];
        const float rstd = 1.0f / sqrtf(wave_sum(ss) * (1.f / 2048.f) + EPS);
#pragma unroll
        for (int jj = 0; jj < 4; ++jj) { const int c = 8 * (lane + 64 * jj);
            float o[8];
#pragma unroll
            for (int hf = 0; hf < 2; ++hf) { const f32x4 gg = *(const f32x4*)(g + c + 4 * hf), sc = *(const f32x4*)(scale + c + 4 * hf), sh = *(const f32x4*)(shift + c + 4 * hf);
#pragma unroll
                for (int i = 0; i < 4; ++i) o[4 * hf + i] = v[jj][4 * hf + i] * rstd * gg[i] * (sc[i] + 1.0f) + sh[i]; }
            *(u32x4*)(H + (size_t)row * 2048 + c) = pack8(o); }
    }
}

constexpr float QSCALE = 0.125f * 1.4426950408889634f;

template <bool F32SRC>
__device__ __forceinline__ void vt_tile(const void* src, size_t src_ld, bf16_t* dst, int Lk, LAS bf16_t* scr  , int lane) {
#pragma unroll 4
    for (int i = 0; i < 16; ++i) { const int p = lane + 64 * i, row = p >> 4, pc = p & 15;
        u32x4 v;
        if (F32SRC) { const float* s = (const float*)src + (size_t)row * src_ld + pc * 8; const f32x4 a = *(const f32x4*)s, b = *(const f32x4*)(s + 4);
            v.x = pk2(a[0], a[1]); v.y = pk2(a[2], a[3]); v.z = pk2(b[0], b[1]); v.w = pk2(b[2], b[3]); }
        else v = *(const u32x4*)((const bf16_t*)src + (size_t)row * src_ld + pc * 8);
        *(LAS u32x4*)(scr + row * 128 + pc * 8) = v; }
    asm volatile("s_waitcnt lgkmcnt(0)" ::: "memory");
#pragma unroll 4
    for (int i = 0; i < 16; ++i) { const int p = lane + 64 * i, dv = p & 127, tg = p >> 7;
        unsigned short e[8];
#pragma unroll
        for (int k = 0; k < 8; ++k) e[k] = scr[(8 * tg + k) * 128 + dv];
        u32x4 v; v.x = e[0] | ((unsigned)e[1] << 16); v.y = e[2] | ((unsigned)e[3] << 16); v.z = e[4] | ((unsigned)e[5] << 16); v.w = e[6] | ((unsigned)e[7] << 16);
        *(u32x4*)(dst + (size_t)dv * Lk + 8 * tg) = v; }
    asm volatile("s_waitcnt lgkmcnt(0)" ::: "memory");
}

__device__ __forceinline__ void phase_qkv_prep(const Args& A, LAS unsigned char* lds, int j, int u_lo = 0, int u_hi = 352, int wg_first = 0, int wg_count = -1) {
    const int tid = otid(), lane = tid & 63, wave = tid >> 6;
    unsigned char* ws = A.ws;
    const bf16_t* U5 = (const bf16_t*)(ws + WS_U5);
    bf16_t* Qb = (bf16_t*)(ws + WS_Q); bf16_t* Kb = (bf16_t*)(ws + WS_K); bf16_t* KC = (bf16_t*)(ws + WS_KC);
    bf16_t* VTP = (bf16_t*)(ws + WS_VTP); bf16_t* VTS = (bf16_t*)(ws + WS_VTS);
    const float* rope = (const float*)(ws + WS_ROPE);
    LAS bf16_t* scr = (LAS bf16_t*)(lds + wave * 16384);
    const int mq = (lane >> 2) & 1, aq = lane & 3;
    float qn[16], kn[16];
#pragma unroll
    for (int i = 0; i < 16; ++i) { qn[i] = A.in[20][((size_t)j * 2 + mq) * 64 + aq * 16 + i]; kn[i] = A.in[21][((size_t)j * 2 + mq) * 64 + aq * 16 + i]; }
    if (wg_count < 0) wg_count = (int)gridDim.x;
    if ((int)blockIdx.x < wg_first || (int)blockIdx.x >= wg_first + wg_count) return;
    for (int u = u_lo + (int)blockIdx.x - wg_first; u < u_hi; u += wg_count) {
        if (u < 320) {
            const int t0 = u * 64;
            const int sample = t0 >= TP, b = sample ? (t0 - TP) >> 11 : t0 >> 8, l0 = sample ? (t0 - TP) & 2047 : t0 & 255;
            for (int tt = 0; tt < 8; ++tt) {
                const int tok = wave * 8 + tt, t = t0 + tok, l = l0 + tok;
                float cs[16], sn[16];
                if (sample) {
#pragma unroll
                    for (int i = 0; i < 16; i += 4) { const f32x4 c4 = *(const f32x4*)(rope + (size_t)l * 64 + aq * 16 + i), s4 = *(const f32x4*)(rope + 2048 * 64 + (size_t)l * 64 + aq * 16 + i);
                        cs[i] = c4[0]; cs[i + 1] = c4[1]; cs[i + 2] = c4[2]; cs[i + 3] = c4[3]; sn[i] = s4[0]; sn[i + 1] = s4[1]; sn[i + 2] = s4[2]; sn[i + 3] = s4[3]; }
                }
#pragma unroll
                for (int qk = 0; qk < 2; ++qk) {
                    const bf16_t* src = U5 + (size_t)t * 5120 + (qk == 0 ? 2048 : 3072) + 16 * lane;
                    float x[16]; { float a[8], c[8]; unpack8(*(const u32x4*)src, a); unpack8(*(const u32x4*)(src + 8), c);
#pragma unroll
                        for (int i = 0; i < 8; ++i) { x[i] = a[i]; x[8 + i] = c[i]; } }
                    float ss = 0.f;
#pragma unroll
                    for (int i = 0; i < 16; ++i) ss += x[i] * x[i];
                    ss += quad_xor1(ss); ss += quad_xor2(ss);
                    const float rstd = 1.0f / sqrtf(ss * (1.f / 64.f) + EPS);
#pragma unroll
                    for (int i = 0; i < 16; ++i) x[i] = x[i] * rstd * (qk == 0 ? qn[i] : kn[i]);
                    if (qk == 1 && !sample) {
                        float* o = A.out + OUT_K + (((size_t)b * 2 + j) * 256 + l) * 1024 + 16 * lane;
#pragma unroll
                        for (int i = 0; i < 16; i += 4) *(f32x4*)(o + i) = (f32x4){x[i], x[i + 1], x[i + 2], x[i + 3]};
                    }
                    if (sample) {
#pragma unroll
                        for (int i = 0; i < 16; ++i) { const float partner = quad_xor1(x[i]); x[i] = (aq & 1) ? (x[i] * cs[i] + partner * sn[i]) : (x[i] * cs[i] - partner * sn[i]); }
                    }
                    if (qk == 0) {
#pragma unroll
                        for (int i = 0; i < 16; ++i) x[i] *= QSCALE;
                    }
                    bf16_t* dst = (qk == 0 ? Qb : Kb) + (size_t)t * 1024 + 16 * lane;
                    u32x4 w0, w1; w0.x = pk2(x[0], x[1]); w0.y = pk2(x[2], x[3]); w0.z = pk2(x[4], x[5]); w0.w = pk2(x[6], x[7]);
                    w1.x = pk2(x[8], x[9]); w1.y = pk2(x[10], x[11]); w1.z = pk2(x[12], x[13]); w1.w = pk2(x[14], x[15]);
                    *(u32x4*)dst = w0; *(u32x4*)(dst + 8) = w1;
                }
                if (!sample) {
                    const bf16_t* src = U5 + (size_t)t * 5120 + 4096 + 16 * lane;
                    float a[8], c[8]; unpack8(*(const u32x4*)src, a); unpack8(*(const u32x4*)(src + 8), c);
                    float* o = A.out + OUT_V + (((size_t)b * 2 + j) * 256 + l) * 1024 + 16 * lane;
                    *(f32x4*)(o) = (f32x4){a[0], a[1], a[2], a[3]}; *(f32x4*)(o + 4) = (f32x4){a[4], a[5], a[6], a[7]};
                    *(f32x4*)(o + 8) = (f32x4){c[0], c[1], c[2], c[3]}; *(f32x4*)(o + 12) = (f32x4){c[4], c[5], c[6], c[7]};
                }
            }
            {
                const int h = wave;
                bf16_t* dst = sample ? VTS + (((size_t)b * 8 + h) * 128) * 2304 + l0 : VTP + (((size_t)b * 8 + h) * 128) * 256 + l0;
                vt_tile<false>(U5 + (size_t)t0 * 5120 + 4096 + h * 128, 5120, dst, sample ? 2304 : 256, scr, lane);
            }
        } else {
            const int uu = u - 320, b = uu >> 2, k0 = (uu & 3) * 64;
            const float* ck = A.in[3] + (((size_t)b * 2 + j) * 256 + k0) * 1024;
            for (int idx = tid; idx < 64 * 1024 / 8; idx += 512) { const float* s = ck + (size_t)idx * 8; const f32x4 a = *(const f32x4*)s, c = *(const f32x4*)(s + 4);
                u32x4 v; v.x = pk2(a[0], a[1]); v.y = pk2(a[2], a[3]); v.z = pk2(c[0], c[1]); v.w = pk2(c[2], c[3]);
                *(u32x4*)(KC + ((size_t)b * 256 + k0) * 1024 + (size_t)idx * 8) = v; }
            const int h = wave;
            const float* cv = A.in[4] + (((size_t)b * 2 + j) * 256 + k0) * 1024 + h * 128;
            vt_tile<true>(cv, 1024, VTS + (((size_t)b * 8 + h) * 128) * 2304 + 2048 + k0, 2304, scr, lane);
        }
    }
}

__device__ __forceinline__ void lru_load_rows(const Args& A, int ci, int kblk, u32x4 (&rows)[7]) {
    const int tid = otid(), oct = tid & 15, tq = tid >> 4;
    const bf16_t* U5 = (const bf16_t*)(A.ws + WS_U5);
    const int t0 = ci * 128, sample = t0 >= TP, l0 = sample ? (t0 - TP) & 2047 : t0 & 255, L = sample ? 2048 : 256;
#pragma unroll
    for (int k = 0; k < 7; ++k) { const int ll = l0 + 4 * tq - 2 + k;
        rows[k] = (ll >= 0 && ll < L) ? *(const u32x4*)(U5 + (size_t)(t0 + 4 * tq - 2 + k) * 5120 + 1024 + kblk * 128 + oct * 8) : (u32x4){0u, 0u, 0u, 0u}; }
}
template <int PASS>
__device__ __forceinline__ void lru_unit(const Args& A, LAS unsigned char* lds, int j, int ci, int kblk, u32x4 (&rows)[7], int ci_next  ) {
    const int tid = otid(), lane = tid & 63, wave = tid >> 6, r = lane & 15, kq = lane >> 4;
    unsigned char* ws = A.ws;
    const bf16_t* U5 = (const bf16_t*)(ws + WS_U5);
    const bf16_t* LRUW = (const bf16_t*)(ws + WS_LRUW);
    f32x2* CHS = (f32x2*)(ws + WS_CHS);
    const int t0 = ci * 128;
    const int sample = t0 >= TP, b = sample ? (t0 - TP) >> 11 : t0 >> 8, l0 = sample ? (t0 - TP) & 2047 : t0 & 255, L = sample ? 2048 : 256;
    const int cis = l0 >> 7, nch = L >> 7, cbase = ci - cis;
    PROF_DECL
    PROF_START(0); PROF_START(1);
    LAS bf16_t* X = (LAS bf16_t*)lds;
    u32x4 wfr[4], wfi[4];
    {
        const bf16_t* Wr0 = LRUW + ((((size_t)j * 2 + 0) * 2 + 0) * 8 + kblk) * 16384 + (size_t)(wave * 16 + r) * 128 + 8 * kq;
        const bf16_t* Wi0 = LRUW + ((((size_t)j * 2 + 0) * 2 + 1) * 8 + kblk) * 16384 + (size_t)(wave * 16 + r) * 128 + 8 * kq;
#pragma unroll
        for (int ks = 0; ks < 4; ++ks) { wfr[ks] = *(const u32x4*)(Wr0 + 32 * ks); wfi[ks] = *(const u32x4*)(Wi0 + 32 * ks); }
    }
    f32x4 pbr[2], pbi[2], plam[2];
    { const int C0_ = kblk * 128 + wave * 16 + 4 * kq;
#pragma unroll
      for (int d = 0; d < 2; ++d) { pbr[d] = *(const f32x4*)(A.in[14] + ((size_t)j * 2 + d) * 1024 + C0_); pbi[d] = *(const f32x4*)(A.in[16] + ((size_t)j * 2 + d) * 1024 + C0_); plam[d] = *(const f32x4*)(A.in[17] + ((size_t)j * 2 + d) * 1024 + C0_); } }
    WG_SYNC();
    PROF_STOP(1, 46); PROF_START(1);
    {
        const int oct = tid & 15, tq = tid >> 4, ch0 = kblk * 128 + oct * 8;
        float cw[4][8], o[4][8];
#pragma unroll
        for (int tp = 0; tp < 4; ++tp) { const f32x4 a = *(const f32x4*)(A.in[11] + ((size_t)j * 4 + tp) * 1024 + ch0), c = *(const f32x4*)(A.in[11] + ((size_t)j * 4 + tp) * 1024 + ch0 + 4);
            cw[tp][0] = a[0]; cw[tp][1] = a[1]; cw[tp][2] = a[2]; cw[tp][3] = a[3]; cw[tp][4] = c[0]; cw[tp][5] = c[1]; cw[tp][6] = c[2]; cw[tp][7] = c[3]; }
        { const f32x4 a = *(const f32x4*)(A.in[12] + (size_t)j * 1024 + ch0), c = *(const f32x4*)(A.in[12] + (size_t)j * 1024 + ch0 + 4);
#pragma unroll
            for (int i = 0; i < 4; ++i) { o[i][0] = a[0]; o[i][1] = a[1]; o[i][2] = a[2]; o[i][3] = a[3]; o[i][4] = c[0]; o[i][5] = c[1]; o[i][6] = c[2]; o[i][7] = c[3]; } }
#pragma unroll
        for (int k = 0; k < 7; ++k) { float x[8]; unpack8(rows[k], x);
#pragma unroll
            for (int i = 0; i < 4; ++i) { const int tp = k - i;
                if (tp >= 0 && tp < 4) {
#pragma unroll
                    for (int c = 0; c < 8; ++c) o[i][c] = fmaf(x[c], cw[tp][c], o[i][c]); } } }
#pragma unroll
        for (int i = 0; i < 4; ++i) *(LAS u32x4*)(X + (4 * tq + i) * 136 + oct * 8) = pack8(o[i]);
        if (ci_next >= 0) lru_load_rows(A, ci_next, kblk, rows);
    }
    PROF_STOP(1, 47); PROF_START(1);
    WG_SYNC();
    PROF_STOP(1, 41);
    const int chl = wave * 16 + 4 * kq, C0 = kblk * 128 + chl;
    float hsum[8][4];
#pragma unroll
    for (int nt = 0; nt < 8; ++nt)
#pragma unroll
        for (int e = 0; e < 4; ++e) hsum[nt][e] = 0.f;
#pragma unroll
    for (int d = 0; d < 2; ++d) {
        f32x4 ar[8], ai[8];
#pragma unroll
        for (int nt = 0; nt < 8; ++nt) { ar[nt] = (f32x4){0.f, 0.f, 0.f, 0.f}; ai[nt] = (f32x4){0.f, 0.f, 0.f, 0.f}; }
        PROF_START(1);
#pragma unroll
        for (int ks = 0; ks < 4; ++ks) {
            const bf16x8 fr_ = as_bf16x8(wfr[ks]), fi_ = as_bf16x8(wfi[ks]);
#pragma unroll
            for (int nt = 0; nt < 8; ++nt) { const bf16x8 fb = *(const LAS bf16x8*)(X + (16 * nt + r) * 136 + 32 * ks + 8 * kq);
                ar[nt] = MFMA16(fr_, fb, ar[nt]); ai[nt] = MFMA16(fi_, fb, ai[nt]); }
        }
        if (d == 0) {
            const bf16_t* Wr1 = LRUW + ((((size_t)j * 2 + 1) * 2 + 0) * 8 + kblk) * 16384 + (size_t)(wave * 16 + r) * 128 + 8 * kq;
            const bf16_t* Wi1 = LRUW + ((((size_t)j * 2 + 1) * 2 + 1) * 8 + kblk) * 16384 + (size_t)(wave * 16 + r) * 128 + 8 * kq;
#pragma unroll
            for (int ks = 0; ks < 4; ++ks) { wfr[ks] = *(const u32x4*)(Wr1 + 32 * ks); wfi[ks] = *(const u32x4*)(Wi1 + 32 * ks); }
        }
        f32x4 csum[2];
        if (PASS == 2) {
            if (r < nch) { const f32x4* cp = (const f32x4*)(CHS + ((size_t)(cbase + r) * 2 + d) * 1024 + C0); csum[0] = cp[0]; csum[1] = cp[1]; }
            else { csum[0] = (f32x4){1.f, 0.f, 1.f, 0.f}; csum[1] = (f32x4){1.f, 0.f, 1.f, 0.f}; } }
        PROF_STOP(1, 42); PROF_START(1);
        float br[4], bi[4], sp[4];
#pragma unroll
        for (int e = 0; e < 4; ++e) { br[e] = -1.4426950408889634f * pbr[d][e]; bi[e] = -1.4426950408889634f * pbi[d][e]; sp[e] = -8.0f * fsoftplus(-plam[d][e]); }
#pragma unroll
        for (int nt = 0; nt < 8; ++nt) {
            const u32x2 xv = *(const LAS u32x2*)(X + (16 * nt + r) * 136 + chl);
            const float xc[4] = {bflo(xv.x), bfhi(xv.x), bflo(xv.y), bfhi(xv.y)};
#pragma unroll
            for (int e = 0; e < 4; ++e) {
                const float rr = __builtin_amdgcn_rcpf(1.0f + __builtin_amdgcn_exp2f(fmaf(ar[nt][e], -1.4426950408889634f, br[e])));
                const float gi = __builtin_amdgcn_rcpf(1.0f + __builtin_amdgcn_exp2f(fmaf(ai[nt][e], -1.4426950408889634f, bi[e])));
                const float la = rr * sp[e];
                const float av = __builtin_amdgcn_exp2f(1.4426950408889634f * la);
                const float t2 = 2.0f * la; const float om_s = -t2 * (1.0f + t2 * (0.5f + t2 * (0.16666667f + t2 * 0.041666668f))), om_d = 1.0f - av * av; const float wsel = t2 > -0.03f ? 1.0f : 0.0f; const float om = fmaf(wsel, om_s - om_d, om_d);
                const float bt = __builtin_amdgcn_sqrtf(om) * gi * xc[e];
                ar[nt][e] = av; ai[nt][e] = bt;
            }
            __builtin_amdgcn_sched_barrier(0);
        }
        PROF_STOP(1, 43); PROF_START(1);
#define LRU_SCAN4(SH) asm volatile("s_nop 4\n\t" \
            "v_fmac_f32_dpp %0, %0, %4 " SH ":1 row_mask:0xf bank_mask:0xf\n\tv_fmac_f32_dpp %1, %1, %5 " SH ":1 row_mask:0xf bank_mask:0xf\n\tv_fmac_f32_dpp %2, %2, %6 " SH ":1 row_mask:0xf bank_mask:0xf\n\tv_fmac_f32_dpp %3, %3, %7 " SH ":1 row_mask:0xf bank_mask:0xf\n\t" \
            "v_mul_f32_dpp %4, %4, %4 " SH ":1 row_mask:0xf bank_mask:0xf\n\tv_mul_f32_dpp %5, %5, %5 " SH ":1 row_mask:0xf bank_mask:0xf\n\tv_mul_f32_dpp %6, %6, %6 " SH ":1 row_mask:0xf bank_mask:0xf\n\tv_mul_f32_dpp %7, %7, %7 " SH ":1 row_mask:0xf bank_mask:0xf\n\t" \
            "v_fmac_f32_dpp %0, %0, %4 " SH ":2 row_mask:0xf bank_mask:0xf\n\tv_fmac_f32_dpp %1, %1, %5 " SH ":2 row_mask:0xf bank_mask:0xf\n\tv_fmac_f32_dpp %2, %2, %6 " SH ":2 row_mask:0xf bank_mask:0xf\n\tv_fmac_f32_dpp %3, %3, %7 " SH ":2 row_mask:0xf bank_mask:0xf\n\t" \
            "v_mul_f32_dpp %4, %4, %4 " SH ":2 row_mask:0xf bank_mask:0xf\n\tv_mul_f32_dpp %5, %5, %5 " SH ":2 row_mask:0xf bank_mask:0xf\n\tv_mul_f32_dpp %6, %6, %6 " SH ":2 row_mask:0xf bank_mask:0xf\n\tv_mul_f32_dpp %7, %7, %7 " SH ":2 row_mask:0xf bank_mask:0xf\n\t" \
            "v_fmac_f32_dpp %0, %0, %4 " SH ":4 row_mask:0xf bank_mask:0xf\n\tv_fmac_f32_dpp %1, %1, %5 " SH ":4 row_mask:0xf bank_mask:0xf\n\tv_fmac_f32_dpp %2, %2, %6 " SH ":4 row_mask:0xf bank_mask:0xf\n\tv_fmac_f32_dpp %3, %3, %7 " SH ":4 row_mask:0xf bank_mask:0xf\n\t" \
            "v_mul_f32_dpp %4, %4, %4 " SH ":4 row_mask:0xf bank_mask:0xf\n\tv_mul_f32_dpp %5, %5, %5 " SH ":4 row_mask:0xf bank_mask:0xf\n\tv_mul_f32_dpp %6, %6, %6 " SH ":4 row_mask:0xf bank_mask:0xf\n\tv_mul_f32_dpp %7, %7, %7 " SH ":4 row_mask:0xf bank_mask:0xf\n\t" \
            "v_fmac_f32_dpp %0, %0, %4 " SH ":8 row_mask:0xf bank_mask:0xf\n\tv_fmac_f32_dpp %1, %1, %5 " SH ":8 row_mask:0xf bank_mask:0xf\n\tv_fmac_f32_dpp %2, %2, %6 " SH ":8 row_mask:0xf bank_mask:0xf\n\tv_fmac_f32_dpp %3, %3, %7 " SH ":8 row_mask:0xf bank_mask:0xf\n\t" \
            "v_mul_f32_dpp %4, %4, %4 " SH ":8 row_mask:0xf bank_mask:0xf\n\tv_mul_f32_dpp %5, %5, %5 " SH ":8 row_mask:0xf bank_mask:0xf\n\tv_mul_f32_dpp %6, %6, %6 " SH ":8 row_mask:0xf bank_mask:0xf\n\tv_mul_f32_dpp %7, %7, %7 " SH ":8 row_mask:0xf bank_mask:0xf\n\ts_nop 1" \
            : "+v"(B0_), "+v"(B1_), "+v"(B2_), "+v"(B3_), "+v"(A0_), "+v"(A1_), "+v"(A2_), "+v"(A3_))
#pragma unroll
        for (int nt = 0; nt < 8; ++nt) {
            float A0_ = ar[nt][0], A1_ = ar[nt][1], A2_ = ar[nt][2], A3_ = ar[nt][3], B0_ = ai[nt][0], B1_ = ai[nt][1], B2_ = ai[nt][2], B3_ = ai[nt][3];
            if (d == 0) LRU_SCAN4("row_shr"); else LRU_SCAN4("row_shl");
            ar[nt] = (f32x4){A0_, A1_, A2_, A3_}; ai[nt] = (f32x4){B0_, B1_, B2_, B3_};
        }
        PROF_STOP(1, 44); PROF_START(1);
        if (PASS == 1) {
            unsigned pkv[8][4];
#pragma unroll
            for (int e = 0; e < 4; ++e) {
                float P = 1.f, E = 0.f;
#pragma unroll
                for (int q = 0; q < 8; ++q) { const int nt = d == 0 ? q : 7 - q; const int sl = d == 0 ? 15 : 0;
                    pkv[nt][e] = pk2(ar[nt][e] * P, ar[nt][e] * E + ai[nt][e]);
                    const float At = d == 0 ? row_bcast_hi(ar[nt][e]) : row_bcast_lo(ar[nt][e]), Bt = d == 0 ? row_bcast_hi(ai[nt][e]) : row_bcast_lo(ai[nt][e]);
                    E = At * E + Bt; P = P * At; }
                if (r == 0) CHS[((size_t)ci * 2 + d) * 1024 + C0 + e] = (f32x2){P, E};
            }
            unsigned* LR = (unsigned*)(ws + WS_LR);
#pragma unroll
            for (int nt = 0; nt < 8; ++nt) *(u32x4*)(LR + ((size_t)(t0 + 16 * nt + r) * 2 + d) * 1024 + C0) = (u32x4){pkv[nt][0], pkv[nt][1], pkv[nt][2], pkv[nt][3]};
            PROF_STOP(1, 45);
        } else {
            float cA[4], cB[4];
            {
                float A0_ = csum[0][0], B0_ = csum[0][1], A1_ = csum[0][2], B1_ = csum[0][3], A2_ = csum[1][0], B2_ = csum[1][1], A3_ = csum[1][2], B3_ = csum[1][3];
                if (d == 0) LRU_SCAN4("row_shr"); else LRU_SCAN4("row_shl");
                cA[0] = A0_; cA[1] = A1_; cA[2] = A2_; cA[3] = A3_; cB[0] = B0_; cB[1] = B1_; cB[2] = B2_; cB[3] = B3_;
            }
#pragma unroll
            for (int e = 0; e < 4; ++e) {
                float h = sample ? A.in[5][(((size_t)b * 2 + j) * 2 + d) * 1024 + C0 + e] : 0.f;
                {
                    const int src = d == 0 ? cis - 1 : cis + 1;
                    const float Ac = __shfl(cA[e], src & 15, 16), Bc = __shfl(cB[e], src & 15, 16);
                    if (d == 0 ? (cis > 0) : (cis + 1 < nch)) h = Ac * h + Bc;
                }
#pragma unroll
                for (int q = 0; q < 8; ++q) { const int nt = d == 0 ? q : 7 - q; const int sl = d == 0 ? 15 : 0;
                    const float hv = ar[nt][e] * h + ai[nt][e];
                    hsum[nt][e] += hv;
                    h = d == 0 ? row_bcast_hi(hv) : row_bcast_lo(hv); }
                if (!sample && r == 0) {
                    if (d == 0 && cis == nch - 1) A.out[OUT_LRU + (((size_t)b * 2 + j) * 2 + 0) * 1024 + C0 + e] = h;
                    if (d == 1 && cis == 0)       A.out[OUT_LRU + (((size_t)b * 2 + j) * 2 + 1) * 1024 + C0 + e] = h;
                }
            }
        }
    }
    PROF_STOP(0, 40);
    if (PASS == 2) {
        bf16_t* MIX = (bf16_t*)(ws + WS_MIXE);
#pragma unroll
        for (int nt = 0; nt < 8; ++nt) { const int t = t0 + 16 * nt + r;
            const u32x2 gv = *(const u32x2*)(U5 + (size_t)t * 5120 + C0);
            const float g[4] = {bflo(gv.x), bfhi(gv.x), bflo(gv.y), bfhi(gv.y)};
            u32x2 o; o.x = pk2(hsum[nt][0] * fgelu_tanh(g[0]), hsum[nt][1] * fgelu_tanh(g[1])); o.y = pk2(hsum[nt][2] * fgelu_tanh(g[2]), hsum[nt][3] * fgelu_tanh(g[3]));
            *(u32x2*)(MIX + (size_t)t * 2048 + C0) = o; }
    }
}

__device__ __forceinline__ void lru_finish(const Args& A, int j, int ci, int cg) {
    const int tid = otid(), lane = tid & 63, r = lane & 15, kq = lane >> 4;
    unsigned char* ws = A.ws;
    const bf16_t* U5 = (const bf16_t*)(ws + WS_U5);
    const f32x2* CHS = (const f32x2*)(ws + WS_CHS);
    const unsigned* LR = (const unsigned*)(ws + WS_LR);
    bf16_t* MIX = (bf16_t*)(ws + WS_MIXE);
    const int t0 = ci * 128;
    const int sample = t0 >= TP, b = sample ? (t0 - TP) >> 11 : t0 >> 8, l0 = sample ? (t0 - TP) & 2047 : t0 & 255, L = sample ? 2048 : 256;
    const int cis = l0 >> 7, nch = L >> 7, cbase = ci - cis;
    const int C0 = cg * 16 + 4 * kq;
    float carry[2][4];
#pragma unroll
    for (int d = 0; d < 2; ++d) {
        f32x4 c0, c1;
        if (r < nch) { const f32x4* cp = (const f32x4*)(CHS + ((size_t)(cbase + r) * 2 + d) * 1024 + C0); c0 = cp[0]; c1 = cp[1]; }
        else { c0 = (f32x4){1.f, 0.f, 1.f, 0.f}; c1 = c0; }
        float A0_ = c0[0], B0_ = c0[1], A1_ = c0[2], B1_ = c0[3], A2_ = c1[0], B2_ = c1[1], A3_ = c1[2], B3_ = c1[3];
        if (d == 0) LRU_SCAN4("row_shr"); else LRU_SCAN4("row_shl");
        const float cA[4] = {A0_, A1_, A2_, A3_}, cB[4] = {B0_, B1_, B2_, B3_};
        const int src = d == 0 ? cis - 1 : cis + 1;
        f32x4 h0 = (f32x4){0.f, 0.f, 0.f, 0.f};
        if (sample) h0 = *(const f32x4*)(A.in[5] + (((size_t)b * 2 + j) * 2 + d) * 1024 + C0);
#pragma unroll
        for (int e = 0; e < 4; ++e) { const float Ac = __shfl(cA[e], src & 15, 16), Bc = __shfl(cB[e], src & 15, 16);
            carry[d][e] = (d == 0 ? (cis > 0) : (cis + 1 < nch)) ? Ac * h0[e] + Bc : h0[e]; }
    }
#pragma unroll
    for (int nt = 0; nt < 8; ++nt) { const size_t t = (size_t)t0 + 16 * nt + r;
        const u32x4 pf_ = *(const u32x4*)(LR + (t * 2 + 0) * 1024 + C0), pb_ = *(const u32x4*)(LR + (t * 2 + 1) * 1024 + C0);
        const u32x2 gv = *(const u32x2*)(U5 + t * 5120 + C0);
        const unsigned pfw[4] = {pf_.x, pf_.y, pf_.z, pf_.w}, pbw[4] = {pb_.x, pb_.y, pb_.z, pb_.w};
        const float g[4] = {bflo(gv.x), bfhi(gv.x), bflo(gv.y), bfhi(gv.y)};
        float hf[4], hb[4], o[4];
#pragma unroll
        for (int e = 0; e < 4; ++e) { hf[e] = bflo(pfw[e]) * carry[0][e] + bfhi(pfw[e]); hb[e] = bflo(pbw[e]) * carry[1][e] + bfhi(pbw[e]); o[e] = (hf[e] + hb[e]) * fgelu_tanh(g[e]); }
        u32x2 w; w.x = pk2(o[0], o[1]); w.y = pk2(o[2], o[3]);
        *(u32x2*)(MIX + t * 2048 + C0) = w;
        if (!sample) {
            if (nt == 7 && r == 15 && cis == nch - 1) *(f32x4*)(A.out + OUT_LRU + (((size_t)b * 2 + j) * 2 + 0) * 1024 + C0) = (f32x4){hf[0], hf[1], hf[2], hf[3]};
            if (nt == 0 && r == 0 && cis == 0)        *(f32x4*)(A.out + OUT_LRU + (((size_t)b * 2 + j) * 2 + 1) * 1024 + C0) = (f32x4){hb[0], hb[1], hb[2], hb[3]};
        }
    }
}

__device__ __forceinline__ void attn_prefetch(const Args& A, int sample, int b, int h, int qb, bf16x8 (&qf)[2][2], u32x4 (&pk_)[2], u32x4 (&pv_)[2]) {
    const int tid = otid(), lane = tid & 63, wave = tid >> 6, r = lane & 15, kq = lane >> 4;
    unsigned char* ws = A.ws;
    const bf16_t* Qb = (const bf16_t*)(ws + WS_Q); const bf16_t* Kb = (const bf16_t*)(ws + WS_K);
    const int Lk = sample ? 2304 : 256;
    const int tbase = sample ? TP + b * 2048 : b * 256;
    const bf16_t* VT = sample ? (const bf16_t*)(ws + WS_VTS) + (((size_t)b * 8 + h) * 128) * 2304 : (const bf16_t*)(ws + WS_VTP) + (((size_t)b * 8 + h) * 128) * 256;
    const int m = wave >> 2, qs = (wave & 3) * 32, q0 = tbase + qb * 128 + qs;
#pragma unroll
    for (int i_ = 0; i_ < 2; ++i_) { const int p_ = tid + 512 * i_;
        pk_[i_] = *(const u32x4*)(Kb + (size_t)(tbase + (p_ >> 4)) * 1024 + h * 128 + (p_ & 15) * 8);
        pv_[i_] = *(const u32x4*)(VT + (size_t)(p_ >> 3) * Lk + (p_ & 7) * 8); }
#pragma unroll
    for (int qt = 0; qt < 2; ++qt)
#pragma unroll
        for (int ks = 0; ks < 2; ++ks) qf[qt][ks] = as_bf16x8(*(const u32x4*)(Qb + (size_t)(q0 + 16 * qt + r) * 1024 + h * 128 + m * 64 + 32 * ks + 8 * kq));
}
__device__ __forceinline__ void attn_unit(const Args& A, LAS unsigned char* lds, int j, int sample, int b, int h, int qb, float lam, float lam_init,
                                          int nsample, int nb, int nh, int nqb, bf16x8 (&qf)[2][2], u32x4 (&pk_)[2], u32x4 (&pv_)[2]) {
    const int tid = otid(), lane = tid & 63, wave = tid >> 6, r = lane & 15, kq = lane >> 4;
    unsigned char* ws = A.ws;
    const bf16_t* Qb = (const bf16_t*)(ws + WS_Q); const bf16_t* Kb = (const bf16_t*)(ws + WS_K); const bf16_t* KC = (const bf16_t*)(ws + WS_KC);
    PROF_DECL
    PROF_START(0);
    const int L = sample ? 2048 : 256, Lk = sample ? 2304 : 256;
    const int tbase = sample ? TP + b * 2048 : b * 256;
    const bf16_t* VT = sample ? (const bf16_t*)(ws + WS_VTS) + (((size_t)b * 8 + h) * 128) * 2304 : (const bf16_t*)(ws + WS_VTP) + (((size_t)b * 8 + h) * 128) * 256;
    const int m = wave >> 2, qs = (wave & 3) * 32, q0 = tbase + qb * 128 + qs;
    constexpr int KT_BYTES = 64 * 136 * 2, VT_BYTES = 128 * 72 * 2;
    f32x4 o[8][2];
#pragma unroll
    for (int dt = 0; dt < 8; ++dt) { o[dt][0] = (f32x4){0.f, 0.f, 0.f, 0.f}; o[dt][1] = (f32x4){0.f, 0.f, 0.f, 0.f}; }
    float mrun[2] = {-1e30f, -1e30f}, lrun[2] = {0.f, 0.f};
    const int nkt = Lk >> 6;
#define ATT_LOAD(kt_) do { const int key0_ = (kt_) * 64; \
        _Pragma("unroll") for (int i_ = 0; i_ < 2; ++i_) { const int p_ = tid + 512 * i_; \
            { const int row_ = p_ >> 4, pc_ = p_ & 15, key_ = key0_ + row_; \
              const bf16_t* s_ = key_ < L ? Kb + (size_t)(tbase + key_) * 1024 + h * 128 + pc_ * 8 : KC + ((size_t)b * 256 + (key_ - 2048)) * 1024 + h * 128 + pc_ * 8; \
              pk_[i_] = *(const u32x4*)s_; } \
            { const int row_ = p_ >> 3, pc_ = p_ & 7; pv_[i_] = *(const u32x4*)(VT + (size_t)row_ * Lk + key0_ + pc_ * 8); } } } while (0)
#define ATT_STORE(buf_) do { LAS unsigned char* kb_ = lds + (buf_) * KT_BYTES; LAS unsigned char* vb_ = lds + 2 * KT_BYTES + (buf_) * VT_BYTES; \
        _Pragma("unroll") for (int i_ = 0; i_ < 2; ++i_) { const int p_ = tid + 512 * i_; \
            *(LAS u32x4*)(kb_ + ((p_ >> 4) * 136 + (p_ & 15) * 8) * 2) = pk_[i_]; \
            *(LAS u32x4*)(vb_ + ((p_ >> 3) * 72 + (p_ & 7) * 8) * 2) = pv_[i_]; } } while (0)
    WG_SYNC();
    ATT_STORE(0);
    WG_SYNC();
    for (int kt = 0; kt < nkt; ++kt) {
        PROF_START(1);
        if (kt + 1 < nkt) ATT_LOAD(kt + 1);
        const LAS bf16_t* Kl = (const LAS bf16_t*)(lds + (kt & 1) * KT_BYTES);
        const LAS bf16_t* Vl = (const LAS bf16_t*)(lds + 2 * KT_BYTES + (kt & 1) * VT_BYTES);
        f32x4 s[4][2];
        {
            bf16x8 kf[4][2];
#pragma unroll
            for (int ks = 0; ks < 2; ++ks)
#pragma unroll
                for (int t = 0; t < 4; ++t) kf[t][ks] = *(const LAS bf16x8*)(Kl + (16 * t + r) * 136 + m * 64 + 32 * ks + 8 * kq);
            __builtin_amdgcn_sched_barrier(0);
            __builtin_amdgcn_s_setprio(1);
#pragma unroll
            for (int t = 0; t < 4; ++t) { s[t][0] = MFMA16(kf[t][0], qf[0][0], ((f32x4){0.f, 0.f, 0.f, 0.f})); s[t][1] = MFMA16(kf[t][0], qf[1][0], ((f32x4){0.f, 0.f, 0.f, 0.f})); }
#pragma unroll
            for (int t = 0; t < 4; ++t) { s[t][0] = MFMA16(kf[t][1], qf[0][1], s[t][0]); s[t][1] = MFMA16(kf[t][1], qf[1][1], s[t][1]); }
            __builtin_amdgcn_s_setprio(0);
        }
        u32x2 vlo[2][4], vhi[2][4];
#define ATT_VLOAD(buf_, b_) do { _Pragma("unroll") for (int i_ = 0; i_ < 4; ++i_) { const int dt_ = ((b_) & 1) * 4 + i_, blk_ = (b_) >> 1; \
            vlo[buf_][i_] = *(const LAS u32x2*)(Vl + (16 * dt_ + r) * 72 + 32 * blk_ + 4 * kq); vhi[buf_][i_] = *(const LAS u32x2*)(Vl + (16 * dt_ + r) * 72 + 32 * blk_ + 16 + 4 * kq); } } while (0)
        ATT_VLOAD(0, 0);
        __builtin_amdgcn_sched_barrier(0);
        PROF_STOP(1, 32); PROF_START(1);
        bf16x8 pf[2][2];
#pragma unroll
        for (int qt = 0; qt < 2; ++qt) {
            float mx = s[0][qt][0];
#pragma unroll
            for (int t = 0; t < 4; ++t)
#pragma unroll
                for (int e = 0; e < 4; ++e) mx = fmaxf(mx, s[t][qt][e]);
            mx = xor16_max(mx); mx = xor32_max(mx);
            const float mnew = fmaxf(mrun[qt], mx), alpha = __builtin_amdgcn_exp2f(mrun[qt] - mnew);
            mrun[qt] = mnew;
            float ps = 0.f;
#pragma unroll
            for (int t = 0; t < 4; ++t)
#pragma unroll
                for (int e = 0; e < 4; ++e) { const float p = __builtin_amdgcn_exp2f(s[t][qt][e] - mnew); s[t][qt][e] = p; ps += p; }
            lrun[qt] = lrun[qt] * alpha + ps;
#pragma unroll
            for (int dt = 0; dt < 8; ++dt) o[dt][qt] = o[dt][qt] * alpha;
#pragma unroll
            for (int blk = 0; blk < 2; ++blk) { u32x4 w; w.x = pk2(s[2 * blk][qt][0], s[2 * blk][qt][1]); w.y = pk2(s[2 * blk][qt][2], s[2 * blk][qt][3]);
                w.z = pk2(s[2 * blk + 1][qt][0], s[2 * blk + 1][qt][1]); w.w = pk2(s[2 * blk + 1][qt][2], s[2 * blk + 1][qt][3]); pf[blk][qt] = as_bf16x8(w); }
        }
        __builtin_amdgcn_sched_barrier(0);
        PROF_STOP(1, 33); PROF_START(1);
#pragma unroll
        for (int b = 0; b < 4; ++b) {
            if (b < 3) ATT_VLOAD((b + 1) & 1, b + 1);
            __builtin_amdgcn_s_setprio(1);
#pragma unroll
            for (int i = 0; i < 4; ++i) { const int dt = (b & 1) * 4 + i, blk = b >> 1;
                const bf16x8 va = as_bf16x8((u32x4){vlo[b & 1][i].x, vlo[b & 1][i].y, vhi[b & 1][i].x, vhi[b & 1][i].y});
                o[dt][0] = MFMA16(va, pf[blk][0], o[dt][0]); o[dt][1] = MFMA16(va, pf[blk][1], o[dt][1]); }
            __builtin_amdgcn_s_setprio(0);
            __builtin_amdgcn_sched_barrier(0);
        }
#undef ATT_VLOAD
        PROF_STOP(1, 34); PROF_START(1);
        if (kt + 1 < nkt) ATT_STORE((kt + 1) & 1);
        WG_SYNC();
        PROF_STOP(1, 35);
    }
#undef ATT_LOAD
#undef ATT_STORE
    if (nsample >= 0) attn_prefetch(A, nsample, nb, nh, nqb, qf, pk_, pv_);
    __builtin_amdgcn_sched_barrier(0);
    PROF_START(1);
#pragma unroll
    for (int qt = 0; qt < 2; ++qt) { float l = lrun[qt]; l = xor16_sum(l); l = xor32_sum(l); const float inv = 1.0f / l;
#pragma unroll
        for (int dt = 0; dt < 8; ++dt) o[dt][qt] = o[dt][qt] * inv; }
    LAS f32x4* ex = (LAS f32x4*)lds;
    f32x4 gsub[8];
    { const float* subln_ = A.in[23] + (size_t)j * 128;
#pragma unroll
      for (int dt = 0; dt < 8; ++dt) gsub[dt] = *(const f32x4*)(subln_ + 16 * dt + 4 * kq); }
    if (m == 1) {
#pragma unroll
        for (int dt = 0; dt < 8; ++dt) { ex[((wave & 3) * 16 + dt * 2 + 0) * 64 + lane] = o[dt][0]; ex[((wave & 3) * 16 + dt * 2 + 1) * 64 + lane] = o[dt][1]; }
    }
    WG_SYNC();
    if (m == 0) {
        bf16_t* MIX = (bf16_t*)(ws + WS_MIXE);
        float ss[2] = {0.f, 0.f};
#pragma unroll
        for (int dt = 0; dt < 8; ++dt)
#pragma unroll
            for (int qt = 0; qt < 2; ++qt) { const f32x4 o1 = ex[((wave & 3) * 16 + dt * 2 + qt) * 64 + lane]; o[dt][qt] = o[dt][qt] - o1 * lam;
                ss[qt] += (o[dt][qt][0] * o[dt][qt][0] + o[dt][qt][1] * o[dt][qt][1]) + (o[dt][qt][2] * o[dt][qt][2] + o[dt][qt][3] * o[dt][qt][3]); }
#pragma unroll
        for (int qt = 0; qt < 2; ++qt) { float v = ss[qt]; v = xor16_sum(v); v = xor32_sum(v); const float rstd = (1.0f - lam_init) / sqrtf(v * (1.f / 128.f) + EPS);
#pragma unroll
            for (int dt = 0; dt < 8; ++dt) { const f32x4 g = gsub[dt]; const f32x4 v4 = o[dt][qt] * rstd * g;
                u32x2 w; w.x = pk2(v4[0], v4[1]); w.y = pk2(v4[2], v4[3]);
                *(u32x2*)(MIX + (size_t)(q0 + 16 * qt + r) * 2048 + 1024 + h * 128 + 16 * dt + 4 * kq) = w; } }
    }
    PROF_STOP(1, 36); PROF_STOP(0, 30);
}

__device__ __forceinline__ void phase_even_mix1(const Args& A, LAS unsigned char* lds, int j, int qkv_lo) {
    phase_qkv_prep(A, lds, j, qkv_lo, 352);
    for (int rep_ = 0; rep_ < ((DBG_TWICE & 4096) ? 2 : 1); ++rep_)
    { u32x4 rows[7]; const int u0 = blockIdx.x; if (u0 < 1280) lru_load_rows(A, u0 >> 3, u0 & 7, rows);
      for (int u = u0; u < 1280; u += gridDim.x) { const int un = u + (int)gridDim.x; lru_unit<1>(A, lds, j, u >> 3, u & 7, rows, (un < 1280 && (un & 7) == (u & 7)) ? (un >> 3) : -1);
          if (un < 1280 && (un & 7) != (u & 7)) lru_load_rows(A, un >> 3, un & 7, rows); } }
}
__device__ __forceinline__ void phase_even_mix2(const Args& A, LAS unsigned char* lds, int j, int layer) {
    float lam;
    { const float* dl = A.in[22] + (size_t)j * 256; float s0 = 0.f, s1 = 0.f;
      for (int i = 0; i < 64; ++i) { s0 += dl[i] * dl[64 + i]; s1 += dl[128 + i] * dl[192 + i]; }
      float lam_init = layer == 0 ? 0.2f : 0.47071302f;
      lam = expf(s0) - expf(s1) + lam_init;
      lam_init = __builtin_bit_cast(float, __builtin_amdgcn_readfirstlane(__builtin_bit_cast(int, lam_init))); lam = __builtin_bit_cast(float, __builtin_amdgcn_readfirstlane(__builtin_bit_cast(int, lam)));
      const int G_ = (int)gridDim.x, vcu_ = (G_ % 8 == 0) ? ((int)blockIdx.x % 8) * (G_ / 8) + (int)blockIdx.x / 8 : (int)blockIdx.x;
      for (int rep_ = 0; rep_ < ((DBG_TWICE & 8192) ? 2 : 1); ++rep_)
      { bf16x8 qf[2][2]; u32x4 pk_[2], pv_[2];
#define ATT_DECODE(u_, s_, b_, h_, q_) do { if ((u_) < 1024) { s_ = 1; b_ = (u_) >> 7; h_ = ((u_) >> 4) & 7; q_ = (u_) & 15; } else { const int v_ = (u_) - 1024; s_ = 0; b_ = v_ >> 4; h_ = (v_ >> 1) & 7; q_ = v_ & 1; } } while (0)
        if (vcu_ < 1280) { int s0_, b0_, h0_, q0_; ATT_DECODE(vcu_, s0_, b0_, h0_, q0_); attn_prefetch(A, s0_, b0_, h0_, q0_, qf, pk_, pv_); }
        for (int u = vcu_; u < 1024 + 256; u += gridDim.x) {
            const int un = u + (int)gridDim.x;
            int sc, bc, hc, qc, sn = -1, bn = 0, hn = 0, qn = 0;
            ATT_DECODE(u, sc, bc, hc, qc);
            if (un < 1280) ATT_DECODE(un, sn, bn, hn, qn);
            attn_unit(A, lds, j, sc, bc, hc, qc, lam, lam_init, sn, bn, hn, qn, qf, pk_, pv_);
        }
#undef ATT_DECODE
      }
    }
    { const int gw = blockIdx.x * 8 + (otid() >> 6), NGW = gridDim.x * 8;
      for (int task = gw; task < 160 * 64; task += NGW) lru_finish(A, j, task >> 6, task & 63); }
}

__device__ __forceinline__ void phase_ssd_prep(const Args& A, LAS unsigned char* lds, int j) {
    const int tid = otid(), lane = tid & 63, wave = tid >> 6;
    unsigned char* ws = A.ws;
    const bf16_t* XBC = (const bf16_t*)(ws + WS_XBC);
    bf16_t* XT = (bf16_t*)(ws + WS_XT); bf16_t* BN = (bf16_t*)(ws + WS_BN); bf16_t* BT = (bf16_t*)(ws + WS_BT); bf16_t* CN = (bf16_t*)(ws + WS_CN);
    const int gw = blockIdx.x * 8 + wave, NGW = gridDim.x * 8;
    const int oct = lane & 7, tg = lane >> 3;
    for (int task = gw; task < 320 * 96; task += NGW) {
        const int slab = task / 96, cgp = task - slab * 96, t0 = slab * 64;
        const int sample = t0 >= TP, l0 = sample ? (t0 - TP) & 2047 : t0 & 255, L = sample ? 2048 : 256;
        const int ch = cgp * 64 + oct * 8;
        float cw[4][8], o[8][8];
#pragma unroll
        for (int tp = 0; tp < 4; ++tp) { const f32x4 a = *(const f32x4*)(A.in[25] + ((size_t)j * 4 + tp) * 6144 + ch), c = *(const f32x4*)(A.in[25] + ((size_t)j * 4 + tp) * 6144 + ch + 4);
            cw[tp][0] = a[0]; cw[tp][1] = a[1]; cw[tp][2] = a[2]; cw[tp][3] = a[3]; cw[tp][4] = c[0]; cw[tp][5] = c[1]; cw[tp][6] = c[2]; cw[tp][7] = c[3]; }
        { const f32x4 a = *(const f32x4*)(A.in[26] + (size_t)j * 6144 + ch), c = *(const f32x4*)(A.in[26] + (size_t)j * 6144 + ch + 4);
#pragma unroll
            for (int i = 0; i < 8; ++i) { o[i][0] = a[0]; o[i][1] = a[1]; o[i][2] = a[2]; o[i][3] = a[3]; o[i][4] = c[0]; o[i][5] = c[1]; o[i][6] = c[2]; o[i][7] = c[3]; } }
        u32x4 rows[11];
#pragma unroll
        for (int k = 0; k < 11; ++k) { const int ll = l0 + tg * 8 - 2 + k;
            rows[k] = (ll >= 0 && ll < L) ? *(const u32x4*)(XBC + (size_t)(t0 + tg * 8 - 2 + k) * 6144 + ch) : (u32x4){0u, 0u, 0u, 0u}; }
#pragma unroll
        for (int k = 0; k < 11; ++k) { float xr[8]; unpack8(rows[k], xr);
#pragma unroll
            for (int i = 0; i < 8; ++i) { const int tp = k - i;
                if (tp >= 0 && tp < 4) {
#pragma unroll
                    for (int c = 0; c < 8; ++c) o[i][c] = fmaf(cw[tp][c], xr[c], o[i][c]); } } }
#pragma unroll
        for (int i = 0; i < 8; ++i)
#pragma unroll
            for (int c = 0; c < 8; ++c) o[i][c] = fsilu(o[i][c]);
        const int tile = t0 >> 8, so = (t0 & 255) + tg * 8;
        if (ch >= 4096) {
            bf16_t* base = ch < 5120 ? BN + (ch - 4096) : CN + (ch - 5120);
#pragma unroll
            for (int i = 0; i < 8; ++i) *(u32x4*)(base + (size_t)(t0 + tg * 8 + i) * 1024) = pack8(o[i]);
        }
        if (ch < 5120) {
#pragma unroll
            for (int c = 0; c < 8; ++c) {
                u32x4 v; v.x = pk2(o[0][c], o[1][c]); v.y = pk2(o[2][c], o[3][c]); v.z = pk2(o[4][c], o[5][c]); v.w = pk2(o[6][c], o[7][c]);
                bf16_t* dst;
                if (ch < 4096) { const int cg = ch + c; dst = XT + (((size_t)tile * 64 + (cg >> 6)) * 64 + (cg & 63)) * 256 + so; }
                else { const int cg = ch - 4096 + c; dst = BT + (((size_t)tile * 8 + (cg >> 7)) * 128 + (cg & 127)) * 256 + so; }
                *(u32x4*)dst = v; }
        }
    }
}

template <int NV>
__device__ __forceinline__ void scan256(float (&v)[NV], LAS float* wtot, int lane, int wave_in_grp, float (&tot)[NV]) {
#pragma unroll
    for (int k = 0; k < NV; ++k) v[k] = wave_scan_incl(v[k]);
    if (lane == 63) {
#pragma unroll
        for (int k = 0; k < NV; ++k) wtot[wave_in_grp * NV + k] = v[k];
    }
    WG_SYNC();
#pragma unroll
    for (int k = 0; k < NV; ++k) { float pre = 0.f, all = 0.f;
#pragma unroll
        for (int w = 0; w < 4; ++w) { const float x = wtot[w * NV + k]; all += x; if (w < wave_in_grp) pre += x; }
        v[k] += pre; tot[k] = all; }
}

__device__ __forceinline__ void phase_ssd_state(const Args& A, LAS unsigned char* lds, int j) {
    const int tid = otid(), lane = tid & 63, wave = tid >> 6, r = lane & 15, kq = lane >> 4;
    unsigned char* ws = A.ws;
    const bf16_t* XT = (const bf16_t*)(ws + WS_XT); const bf16_t* BT = (const bf16_t*)(ws + WS_BT);
    const float* DTRAW = (const float*)(ws + WS_DTRAW);
    bf16_t* SIN = (bf16_t*)(ws + WS_SIN);
    LAS bf16_t* Bl = (LAS bf16_t*)lds;
    LAS bf16_t* Xl = (LAS bf16_t*)(lds + 67584);
    LAS float* Wl = (LAS float*)(lds + 67584 + 33792);
    LAS float* TOT = Wl + 1024;
    LAS float* WT_ = TOT + 16;
    const int pt = wave & 3, nh = wave >> 2;
    const int G_ = (int)gridDim.x, vcu_ = (G_ % 8 == 0) ? ((int)blockIdx.x % 8) * (G_ / 8) + (int)blockIdx.x / 8 : (int)blockIdx.x;
    PROF_DECL
    for (int u = vcu_; u < 256 + 512; u += gridDim.x) {
        PROF_START(0);
        const int sample = u < 256, v = sample ? u : u - 256;
        const int b = v >> 5, g = (v >> 2) & 7, dir = (v >> 1) & 1, half = v & 1;
        const int tile0 = sample ? 16 + b * 8 : b, ntile = sample ? 8 : 1;
        const int h0 = g * 8 + half * 4;
        f32x4 acc[4][4];
#pragma unroll
        for (int hh = 0; hh < 4; ++hh)
#pragma unroll
            for (int nt = 0; nt < 4; ++nt) {
                if (sample) {
#pragma unroll
                    for (int e = 0; e < 4; ++e) acc[hh][nt][e] = A.in[6][((((size_t)b * 2 + j) * 2 + dir) * 64 + h0 + hh) * 8192 + (size_t)(16 * pt + 4 * kq + e) * 128 + 16 * (nh * 4 + nt) + r];
                } else acc[hh][nt] = (f32x4){0.f, 0.f, 0.f, 0.f};
            }
        float adec[4], dtb[4];
#pragma unroll
        for (int hh = 0; hh < 4; ++hh) { adec[hh] = -expf(A.in[28][((size_t)j * 2 + dir) * 64 + h0 + hh]); dtb[hh] = A.in[27][((size_t)j * 2 + dir) * 64 + h0 + hh]; }
        u32x4 pbt[8];
        { const int tf = tile0 + (dir == 0 ? 0 : ntile - 1);
#pragma unroll
          for (int i = 0; i < 8; ++i) { const int p = tid + 512 * i, row = p >> 5, pc = p & 31; pbt[i] = *(const u32x4*)(BT + (((size_t)tf * 8 + g) * 128 + row) * 256 + pc * 8); } }
        for (int st = 0; st < ntile; ++st) {
            const int c = dir == 0 ? st : ntile - 1 - st, tile = tile0 + c;
            WG_SYNC();
            PROF_START(1);
            if (sample) {
                LAS bf16_t* St = (LAS bf16_t*)lds;
#pragma unroll
                for (int hh = 0; hh < 4; ++hh)
#pragma unroll
                    for (int nt = 0; nt < 4; ++nt)
#pragma unroll
                        for (int e = 0; e < 4; ++e)
                            St[(hh * 64 + 16 * pt + 4 * kq + e) * 136 + 16 * (nh * 4 + nt) + r] = (bf16_t)(pk2(acc[hh][nt][e], 0.f) & 0xffffu);
                WG_SYNC();
#pragma unroll
                for (int i = 0; i < 8; ++i) { const int p = tid + 512 * i, hh = p >> 10, row = (p >> 4) & 63, pc = p & 15;
                    *(u32x4*)(SIN + ((((size_t)(tile - 16) * 2 + dir) * 64 + h0 + hh) * 64 + row) * 128 + pc * 8) = *(const LAS u32x4*)(St + (hh * 64 + row) * 136 + pc * 8); }
                if (st == ntile - 1) break;
                WG_SYNC();
            }
            PROF_STOP(1, 21); PROF_START(1);
            {
                float val[4], dtv[4], tot[4];
                if (tid < 256) {
#pragma unroll
                    for (int hh = 0; hh < 4; ++hh) { dtv[hh] = fsoftplus(DTRAW[(size_t)(tile * 256 + tid) * 128 + dir * 64 + h0 + hh] + dtb[hh]); val[hh] = adec[hh] * dtv[hh]; }
                } else {
#pragma unroll
                    for (int hh = 0; hh < 4; ++hh) { dtv[hh] = 0.f; val[hh] = 0.f; }
                }
                float adt[4];
#pragma unroll
                for (int hh = 0; hh < 4; ++hh) adt[hh] = val[hh];
                scan256<4>(val, WT_ + (tid < 256 ? 0 : 16), lane, wave & 3, tot);
                if (tid < 256) {
#pragma unroll
                    for (int hh = 0; hh < 4; ++hh) { const float w = dir == 0 ? fexp(tot[hh] - val[hh]) * dtv[hh] : fexp(val[hh] - adt[hh]) * dtv[hh]; Wl[hh * 256 + tid] = w; }
                    if (tid == 0) {
#pragma unroll
                        for (int hh = 0; hh < 4; ++hh) TOT[hh] = tot[hh];
                    }
                }
            }
            PROF_STOP(1, 22); PROF_START(1);
#pragma unroll
            for (int i = 0; i < 8; ++i) { const int p = tid + 512 * i, row = p >> 5, pc = p & 31; *(LAS u32x4*)(Bl + row * 264 + pc * 8) = pbt[i]; }
            { const int stn = st + 1, lastupd = sample ? ntile - 1 : ntile;
              if (stn < lastupd) { const int tn = tile0 + (dir == 0 ? stn : ntile - 1 - stn);
#pragma unroll
                  for (int i = 0; i < 8; ++i) { const int p = tid + 512 * i, row = p >> 5, pc = p & 31; pbt[i] = *(const u32x4*)(BT + (((size_t)tn * 8 + g) * 128 + row) * 256 + pc * 8); } } }
            PROF_STOP(1, 23);
            u32x4 px[4];
#pragma unroll
            for (int i = 0; i < 4; ++i) { const int p = tid + 512 * i, row = p >> 5, pc = p & 31; px[i] = *(const u32x4*)(XT + (((size_t)tile * 64 + h0) * 64 + row) * 256 + pc * 8); }
#pragma unroll
            for (int hh = 0; hh < 4; ++hh) {
                PROF_START(1);
                WG_SYNC();
#pragma unroll
                for (int i = 0; i < 4; ++i) { const int p = tid + 512 * i, row = p >> 5, pc = p & 31;
                    float x[8]; unpack8(px[i], x);
                    if (hh < 3) px[i] = *(const u32x4*)(XT + (((size_t)tile * 64 + h0 + hh + 1) * 64 + row) * 256 + pc * 8);
                    const f32x4 w0 = *(const LAS f32x4*)(Wl + hh * 256 + pc * 8), w1 = *(const LAS f32x4*)(Wl + hh * 256 + pc * 8 + 4);
                    x[0] *= w0[0]; x[1] *= w0[1]; x[2] *= w0[2]; x[3] *= w0[3]; x[4] *= w1[0]; x[5] *= w1[1]; x[6] *= w1[2]; x[7] *= w1[3];
                    *(LAS u32x4*)(Xl + row * 264 + pc * 8) = pack8(x); }
                WG_SYNC();
                PROF_STOP(1, 24); PROF_START(1);
                const float dec = fexp(TOT[hh]);
#pragma unroll
                for (int nt = 0; nt < 4; ++nt) acc[hh][nt] = acc[hh][nt] * dec;
#pragma unroll
                for (int ks = 0; ks < 8; ++ks) { const bf16x8 fa = *(const LAS bf16x8*)(Xl + (16 * pt + r) * 264 + 32 * ks + 8 * kq);
#pragma unroll
                    for (int nt = 0; nt < 4; ++nt) { const bf16x8 fb = *(const LAS bf16x8*)(Bl + (16 * (nh * 4 + nt) + r) * 264 + 32 * ks + 8 * kq);
                        acc[hh][nt] = MFMA16(fa, fb, acc[hh][nt]); } }
                PROF_STOP(1, 25);
            }
        }
        PROF_STOP(0, 20);
        if (!sample) {
#pragma unroll
            for (int hh = 0; hh < 4; ++hh)
#pragma unroll
                for (int nt = 0; nt < 4; ++nt)
#pragma unroll
                    for (int e = 0; e < 4; ++e)
                        A.out[OUT_SSD + ((((size_t)b * 2 + j) * 2 + dir) * 64 + h0 + hh) * 8192 + (size_t)(16 * pt + 4 * kq + e) * 128 + 16 * (nh * 4 + nt) + r] = acc[hh][nt][e];
        }
    }
}

__device__ __forceinline__ void phase_ssd_out(const Args& A, LAS unsigned char* lds, int j) {
    const int tid = otid(), lane = tid & 63, wave = tid >> 6, r = lane & 15, kq = lane >> 4;
    unsigned char* ws = A.ws;
    const bf16_t* XT = (const bf16_t*)(ws + WS_XT); const bf16_t* BN = (const bf16_t*)(ws + WS_BN); const bf16_t* CN = (const bf16_t*)(ws + WS_CN);
    const bf16_t* Z = (const bf16_t*)(ws + WS_Z); const float* DTRAW = (const float*)(ws + WS_DTRAW); const bf16_t* SIN = (const bf16_t*)(ws + WS_SIN);
    bf16_t* MIX = (bf16_t*)(ws + WS_MIXO);
    LAS float* PF = (LAS float*)lds;
    LAS float* DTF = PF + 2048;
    LAS float* EB = DTF + 2048;
    LAS float* DTB = EB + 2048;
    LAS float* COLF = DTB + 2048;
    LAS float* COLB = COLF + 2048;
    LAS float* TOTB = (LAS float*)(lds + LDS_MISC + 256);
    LAS float* WT_ = (LAS float*)(lds + LDS_MISC + 320);
    LAS bf16_t* Bl = (LAS bf16_t*)(lds + 49152);
    LAS bf16_t* Xl = (LAS bf16_t*)(lds + 49152);
    LAS bf16_t* Sl = (LAS bf16_t*)(lds + 49152 + 33792);
    PROF_DECL
    for (int u = blockIdx.x; u < 160 * 8; u += gridDim.x) {
        PROF_START(0);
        const int rt = u >> 3, g = u & 7, tile = rt >> 1, half = rt & 1;
        const int sample = tile >= 16;
        const int l_loc = half * 128 + wave * 16 + r;
        const size_t tk = (size_t)tile * 256 + l_loc;
        WG_SYNC();
        PROF_START(1);
        {
            const int dir = tid >> 8, s = tid & 255;
            float val[8], dtv[8], tot[8], adt[8];
#pragma unroll
            for (int h8 = 0; h8 < 8; ++h8) { const int h = g * 8 + h8;
                dtv[h8] = fsoftplus(DTRAW[((size_t)tile * 256 + s) * 128 + dir * 64 + h] + A.in[27][((size_t)j * 2 + dir) * 64 + h]);
                val[h8] = -expf(A.in[28][((size_t)j * 2 + dir) * 64 + h]) * dtv[h8]; adt[h8] = val[h8]; }
            scan256<8>(val, WT_ + dir * 32, lane, wave & 3, tot);
            if (dir == 0) {
#pragma unroll
                for (int h8 = 0; h8 < 8; ++h8) { PF[h8 * 256 + s] = val[h8]; DTF[h8 * 256 + s] = dtv[h8];
                    const float pend = __shfl(val[h8], 15, 16); COLF[h8 * 256 + s] = fexp(pend - val[h8]) * dtv[h8]; }
            } else {
#pragma unroll
                for (int h8 = 0; h8 < 8; ++h8) { const float eb = val[h8] - adt[h8]; EB[h8 * 256 + s] = eb; DTB[h8 * 256 + s] = dtv[h8];
                    const float eb0 = __shfl(eb, 0, 16); COLB[h8 * 256 + s] = fexp(eb - eb0) * dtv[h8]; }
                if (s == 0) {
#pragma unroll
                    for (int h8 = 0; h8 < 8; ++h8) TOTB[h8] = tot[h8];
                }
            }
        }
        PROF_STOP(1, 1); PROF_START(1);
#pragma unroll
        for (int i = 0; i < 8; ++i) { const int p = tid + 512 * i, row = p >> 4, pc = p & 15;
            *(LAS u32x4*)(Bl + row * 136 + pc * 8) = *(const u32x4*)(BN + ((size_t)tile * 256 + row) * 1024 + g * 128 + pc * 8); }
        bf16x8 cf[4];
#pragma unroll
        for (int ks = 0; ks < 4; ++ks) cf[ks] = as_bf16x8(*(const u32x4*)(CN + tk * 1024 + g * 128 + 32 * ks + 8 * kq));
        WG_SYNC();
        f32x4 gt[16];
#pragma unroll
        for (int t = 0; t < 16; ++t) gt[t] = (f32x4){0.f, 0.f, 0.f, 0.f};
#pragma unroll
        for (int ks = 0; ks < 4; ++ks)
#pragma unroll
            for (int t = 0; t < 16; ++t) { const bf16x8 fa = *(const LAS bf16x8*)(Bl + (16 * t + r) * 136 + 32 * ks + 8 * kq); gt[t] = MFMA16(fa, cf[ks], gt[t]); }
        PROF_STOP(1, 2); PROF_START(1);
        float ssq = 0.f;
        u32x4 pfx[4], pfs[4];
#define SSDO_PREFETCH(HH) do { const int tidp = otid(); \
            _Pragma("unroll") for (int i = 0; i < 4; ++i) { const int p = tidp + 512 * i; \
                pfx[i] = *(const u32x4*)(XT + (((size_t)tile * 64 + g * 8 + (HH)) * 64 + (p >> 5)) * 256 + (p & 31) * 8); \
                if (sample) pfs[i] = *(const u32x4*)(SIN + ((((size_t)(tile - 16) * 2 + (p >> 10)) * 64 + g * 8 + (HH)) * 64 + ((p >> 4) & 63)) * 128 + (p & 15) * 8); } } while (0)
        SSDO_PREFETCH(0);
#pragma unroll 1
        for (int h8 = 0; h8 < 8; ++h8) {
            const int h = g * 8 + h8;
            const int tid = otid(), lane = tid & 63, wave = __builtin_amdgcn_readfirstlane(tid >> 6), r = lane & 15, kq = lane >> 4;
            const int l_loc = half * 128 + wave * 16 + r; const size_t tk = (size_t)tile * 256 + l_loc; const int tdiag = half * 8 + wave;
            PROF_START(2);
            WG_SYNC();
#pragma unroll
            for (int i = 0; i < 4; ++i) { const int p = tid + 512 * i, row = p >> 5, pc = p & 31;
                *(LAS u32x4*)(Xl + row * 264 + pc * 8) = pfx[i]; }
            if (sample) {
#pragma unroll
                for (int i = 0; i < 4; ++i) { const int p = tid + 512 * i, dirn = p >> 10, row = (p >> 4) & 63, pc = p & 15;
                    *(LAS u32x4*)(Sl + (dirn * 64 + row) * 136 + pc * 8) = pfs[i]; }
            }
            if (h8 < 7) SSDO_PREFETCH(h8 + 1);
            WG_SYNC();
            PROF_STOP(2, 4); PROF_START(2);
            const float pf_l = PF[h8 * 256 + l_loc], eb_l = EB[h8 * 256 + l_loc];
            u32x2 zpre[4];
#pragma unroll
            for (int p4 = 0; p4 < 4; ++p4) zpre[p4] = *(const u32x2*)(Z + tk * 4096 + h * 64 + 16 * p4 + 4 * kq);
            const float dsk = A.in[29][(size_t)j * 64 + h];
            f32x4 y[4];
#pragma unroll
            for (int p4 = 0; p4 < 4; ++p4) y[p4] = (f32x4){0.f, 0.f, 0.f, 0.f};
#pragma unroll
            for (int blk = 0; blk < 8; ++blk) {
                f32x4 cv[2]; float rs[2];
#pragma unroll
                for (int hf_ = 0; hf_ < 2; ++hf_) { const int t_ = 2 * blk + hf_; const bool fw_ = t_ < tdiag;
                    cv[hf_] = *(const LAS f32x4*)((fw_ ? COLF : COLB) + h8 * 256 + 16 * t_ + 4 * kq); rs[hf_] = fw_ ? PF[h8 * 256 + 16 * t_ + 15] : EB[h8 * 256 + 16 * t_]; }
                u32x2 xlo[4], xhi[4];
                __builtin_amdgcn_sched_barrier(0);
                float mv[8];
#pragma unroll
                for (int hf = 0; hf < 2; ++hf) {
                    const int t = 2 * blk + hf, sb = 16 * t + 4 * kq;
                    if (t != tdiag) {
                        const float row = fexp(t < tdiag ? pf_l - rs[hf] : rs[hf] - eb_l);
#pragma unroll
                        for (int e = 0; e < 4; ++e) mv[hf * 4 + e] = gt[t][e] * (row * cv[hf][e]);
                    } else {
                        const f32x4 ps = *(const LAS f32x4*)(PF + h8 * 256 + sb), df = *(const LAS f32x4*)(DTF + h8 * 256 + sb);
                        const f32x4 es = *(const LAS f32x4*)(EB + h8 * 256 + sb), db = *(const LAS f32x4*)(DTB + h8 * 256 + sb);
#pragma unroll
                        for (int e = 0; e < 4; ++e) { const int s = sb + e; float w = 0.f;
                            if (s <= l_loc) w += fexp(fminf(pf_l - ps[e], 0.f)) * df[e];
                            if (s >= l_loc) w += fexp(fminf(es[e] - eb_l, 0.f)) * db[e];
                            mv[hf * 4 + e] = gt[t][e] * w;
                            if (s == l_loc) mv[hf * 4 + e] += dsk; }
                    }
                }
                const bf16x8 mf = as_bf16x8(pack8(mv));
#pragma unroll
                for (int p4 = 0; p4 < 4; ++p4) { xlo[p4] = *(const LAS u32x2*)(Xl + (16 * p4 + r) * 264 + 32 * blk + 4 * kq); xhi[p4] = *(const LAS u32x2*)(Xl + (16 * p4 + r) * 264 + 32 * blk + 16 + 4 * kq); }
#pragma unroll
                for (int p4 = 0; p4 < 4; ++p4)
                    y[p4] = MFMA16(as_bf16x8((u32x4){xlo[p4].x, xlo[p4].y, xhi[p4].x, xhi[p4].y}), mf, y[p4]);
                __builtin_amdgcn_sched_barrier(0);
            }

            PROF_STOP(2, 5); PROF_START(2);
            if (sample) {
#pragma unroll
                for (int dirn = 0; dirn < 2; ++dirn) {
                    f32x4 tmp[4];
#pragma unroll
                    for (int p4 = 0; p4 < 4; ++p4) tmp[p4] = (f32x4){0.f, 0.f, 0.f, 0.f};
#pragma unroll
                    for (int ks = 0; ks < 4; ++ks)
#pragma unroll
                        for (int p4 = 0; p4 < 4; ++p4) { const bf16x8 sa = *(const LAS bf16x8*)(Sl + (dirn * 64 + 16 * p4 + r) * 136 + 32 * ks + 8 * kq); tmp[p4] = MFMA16(sa, cf[ks], tmp[p4]); }
                    const float ev = dirn == 0 ? fexp(pf_l) : fexp(TOTB[h8] - eb_l);
#pragma unroll
                    for (int p4 = 0; p4 < 4; ++p4) y[p4] = y[p4] + tmp[p4] * ev;
                }
            }
            PROF_STOP(2, 6); PROF_START(2);
#pragma unroll
            for (int p4 = 0; p4 < 4; ++p4) { const int p0 = 16 * p4 + 4 * kq;
                const u32x2 zv = zpre[p4];
                const float zz[4] = {bflo(zv.x), bfhi(zv.x), bflo(zv.y), bfhi(zv.y)};
                float yv[4];
#pragma unroll
                for (int e = 0; e < 4; ++e) { yv[e] = y[p4][e] * zz[e]; ssq += yv[e] * yv[e]; }
                u32x2 w; w.x = pk2(yv[0], yv[1]); w.y = pk2(yv[2], yv[3]);
                *(u32x2*)(MIX + tk * 4096 + h * 64 + p0) = w; }
            PROF_STOP(2, 7);
        }
        PROF_STOP(1, 3); PROF_START(1);
        ssq = xor16_sum(ssq); ssq = xor32_sum(ssq);
        const float rstd = 1.0f / sqrtf(ssq * (1.f / 512.f) + EPS);
        asm volatile("s_waitcnt vmcnt(0)" ::: "memory");
        {
            const int tid2 = otid(), kq2 = (tid2 & 63) >> 4; const size_t tk2 = (size_t)tile * 256 + half * 128 + (tid2 >> 6) * 16 + (tid2 & 15);
#pragma unroll 1
            for (int qb = 0; qb < 32; qb += 32) {
            unsigned long long raw[32];
#pragma unroll
            for (int q = 0; q < 32; ++q) raw[q] = __hip_atomic_load((unsigned long long*)(MIX + tk2 * 4096 + (g * 8 + ((qb + q) >> 2)) * 64 + 16 * (q & 3) + 4 * kq2), __ATOMIC_RELAXED, __HIP_MEMORY_SCOPE_AGENT);
#pragma unroll
            for (int q = 0; q < 32; ++q) { const int cix = (g * 8 + ((qb + q) >> 2)) * 64 + 16 * (q & 3) + 4 * kq2;
                const unsigned lo = (unsigned)raw[q], hi = (unsigned)(raw[q] >> 32);
                const f32x4 nw = *(const f32x4*)(A.in[30] + (size_t)j * 4096 + cix);
                u32x2 w; w.x = pk2(bflo(lo) * rstd * nw[0], bfhi(lo) * rstd * nw[1]); w.y = pk2(bflo(hi) * rstd * nw[2], bfhi(hi) * rstd * nw[3]);
                *(u32x2*)(MIX + tk2 * 4096 + cix) = w; }
            }
        }
        PROF_STOP(1, 8); PROF_STOP(0, 0);
    }
#undef SSDO_PREFETCH
}

constexpr int N_PHASE_IDS = 2 + 9 * 4;
#ifndef DBG_TWICE
#define DBG_TWICE 0
#endif
#ifndef MK_ONE_LAUNCH
#define MK_ONE_LAUNCH 1
#endif

__device__ __forceinline__ void sub_barrier(unsigned* bar, unsigned* cnt, unsigned n) {
    asm volatile("s_waitcnt vmcnt(0)" ::: "memory");
    __syncthreads();
    if (threadIdx.x == 0) {
        __builtin_amdgcn_fence(__ATOMIC_RELEASE, "agent");
        asm volatile("s_waitcnt vmcnt(0)" ::: "memory");
        (void)xb_add(cnt, 1u);
        XB_SPIN(xb_ld(cnt) < n, bar);
        __builtin_amdgcn_fence(__ATOMIC_ACQUIRE, "agent");
        asm volatile("s_waitcnt vmcnt(0)" ::: "memory");
    }
    __syncthreads();
}

__global__ void __launch_bounds__(512, 2) fwd_kernel(Args args) {
    extern __shared__ __attribute__((aligned(16))) unsigned char shm[];
    LAS unsigned char* lds = (LAS unsigned char*)shm;
    const int tid = threadIdx.x;
    unsigned char* ws = args.ws;
    if (tid < 4) ((LAS unsigned*)(lds + LDS_MISC))[tid] = 0u;
#if DBG_PROF
    if (tid < 96) ((LAS unsigned*)(lds + LDS_MISC + 640))[tid] = 0u;
#endif
    __syncthreads();
    XcdBarrier bar = xcd_barrier_post((unsigned*)(ws + WS_CTL), (volatile LAS unsigned*)(lds + LDS_MISC));
    const int lo = args.ph_lo, hi = args.ph_hi;
    bool need_bar = false;
#define PHASE(id) if (lo <= (id) && (id) < hi && ((need_bar ? (xcd_barrier(bar), ((DBG_TWICE & 131072) ? (xcd_barrier(bar), 0) : 0), 0) : 0), need_bar = true, true))
#define REP(bit) for (int rep_ = 0; rep_ < ((DBG_TWICE & (bit)) ? 2 : 1); ++rep_) if (((rep_ ? (xcd_barrier(bar), 0) : 0), true))
    const float* ADA = (const float*)(ws + WS_ADA);
    bf16_t* H = (bf16_t*)(ws + WS_H);
    const int G = (int)gridDim.x, bx = (int)blockIdx.x;

    PHASE(0) { REP(1) phase_prologue(args, lds); }
    PHASE(1) { REP(2) phase_modulate(args, 0, 0, true); }
    for (int layer = 0; layer < 4; ++layer) {
        const int pb = 2 + 9 * layer, j = layer >> 1, even = (layer & 1) == 0;
        if (even) {
            PHASE(pb + 0) { pg8::Gemm g{H, (const bf16_t*)(ws + WS_WEIN) + (size_t)j * 5120 * 2048, T, 5120, 2048};
                pg8::EpiStore E{(bf16_t*)(ws + WS_U5), 5120};
                if (G == 256) {
                    { const int c0 = layer > 0 ? 4 : 0;
                      pg8::Gemm g1{H, g.Bt + (size_t)c0 * 256 * 2048, T, 5120 - c0 * 256, 2048}; pg8::EpiStore E1{(bf16_t*)(ws + WS_U5) + c0 * 256, 5120};
                      pg8::StaticOrder S; S.init(16384, 5120 - c0 * 256, G, bx); pg8::gemm_phase<pg8::EpiStore, pg8::StaticOrder, true, true>(lds, g1, S, E1); }
                    xcd_barrier(bar);
                    { pg8::TailOrderE S{G, bx}; pg8::gemm_phase<pg8::EpiStore, pg8::TailOrderE, true, true>(lds, g, S, E); }
                    phase_qkv_prep(args, lds, j, 0, 192, 64, 192);
                } else { pg8::StaticOrder S; S.init(T, 5120, G, bx); pg8::gemm_phase<pg8::EpiStore, pg8::StaticOrder, true, true>(lds, g, S, E); } }
            PHASE(pb + 1) { REP(8) phase_even_mix1(args, lds, j, G == 256 ? 192 : 0); }
            PHASE(pb + 2) { REP(16) phase_even_mix2(args, lds, j, layer); }
        } else {
            PHASE(pb + 0) REP(32) { pg8::Gemm g{H, (const bf16_t*)(ws + WS_WSIN) + (size_t)j * 10496 * 2048, T, 10496, 2048};
                pg8::EpiOdd1 E{(bf16_t*)(ws + WS_Z), (bf16_t*)(ws + WS_XBC), (float*)(ws + WS_DTRAW)};
                if (G == 256) { pg8::O1RestOrder S{G, bx}; pg8::gemm_phase<pg8::EpiOdd1, pg8::O1RestOrder, true, true>(lds, g, S, E); }
                else { pg8::StaticOrder S; S.init(T, 10496, G, bx); pg8::gemm_phase<pg8::EpiOdd1, pg8::StaticOrder, true, true>(lds, g, S, E); } }
            PHASE(pb + 1) { REP(64) phase_ssd_prep(args, lds, j); }
            PHASE(pb + 2) { REP(128) phase_ssd_state(args, lds, j); }
            PHASE(pb + 3) { REP(256) phase_ssd_out(args, lds, j); }
        }
        PHASE(pb + 4) {
            const bf16_t* Am = even ? (const bf16_t*)(ws + WS_MIXE) : (const bf16_t*)(ws + WS_MIXO);
            const bf16_t* Bm = even ? (const bf16_t*)(ws + WS_WEOUT) + (size_t)j * 2048 * 2048 : (const bf16_t*)(ws + WS_WSOUT) + (size_t)j * 2048 * 4096;
            pg8::Gemm g{Am, Bm, T, 2048, even ? 2048 : 4096};
            pg8::EpiResid E{(bf16_t*)(ws + WS_Y), ADA + (size_t)layer * 9 * 12288 + 2 * 2048, nullptr};
            if (G == 256) {
                { pg8::StaticOrder S; S.init(16384, 2048, G, bx); pg8::gemm_phase<pg8::EpiResid, pg8::StaticOrder, true, true>(lds, g, S, E); }
                xcd_barrier(bar);
                if (bx < 128) { pg8::TailOrder S{bx}; pg8::gemm_phase<pg8::EpiResid, pg8::TailOrder, true, true>(lds, g, S, E); }
                else phase_modulate(args, layer, 1, false, 0, 16384, 128, 128);
                xcd_barrier(bar);
                phase_modulate(args, layer, 1, false, 16384, T);
            } else { pg8::StaticOrder S; S.init(T, 2048, G, bx); pg8::gemm_phase<pg8::EpiResid, pg8::StaticOrder, true, true>(lds, g, S, E);
                xcd_barrier(bar); phase_modulate(args, layer, 1, false); } }
#if (DBG_TWICE & 32768)
        PHASE(pb + 4) {
            const bf16_t* Am = even ? (const bf16_t*)(ws + WS_MIXE) : (const bf16_t*)(ws + WS_MIXO);
            const bf16_t* Bm = even ? (const bf16_t*)(ws + WS_WEOUT) + (size_t)j * 2048 * 2048 : (const bf16_t*)(ws + WS_WSOUT) + (size_t)j * 2048 * 4096;
            pg8::Gemm g{Am, Bm, T, 2048, even ? 2048 : 4096}; pg8::StaticOrder S; S.init(T, 2048, G, bx);
            pg8::EpiDummy E{(float*)(ws + 1242 * MiB)};
            pg8::gemm_phase<pg8::EpiDummy, pg8::StaticOrder, true, true>(lds, g, S, E); }
#endif
        PHASE(pb + 6) REP(1024) { pg8::Gemm g{H, (const bf16_t*)(ws + WS_WFIN) + (size_t)layer * 11264 * 2048, T, 11264, 2048}; pg8::StaticOrder S; S.init(T, 11264, G, bx);
            pg8::EpiSwiGLU E{(bf16_t*)(ws + WS_HID), 5632};
            pg8::gemm_phase<pg8::EpiSwiGLU, pg8::StaticOrder, true, true>(lds, g, S, E); }
        PHASE(pb + 7) { pg8::Gemm g{(const bf16_t*)(ws + WS_HID), (const bf16_t*)(ws + WS_WFOUT) + (size_t)layer * 2048 * 5632, T, 2048, 5632};
            pg8::EpiResid E{(bf16_t*)(ws + WS_Y), ADA + (size_t)layer * 9 * 12288 + 5 * 2048, layer == 3 ? args.out : nullptr};
            if (G == 256 && layer < 3) {
                { pg8::StaticOrder S; S.init(16384, 2048, G, bx); pg8::gemm_phase<pg8::EpiResid, pg8::StaticOrder, true, true>(lds, g, S, E); }
                xcd_barrier(bar);
                if (bx < 128) { pg8::TailOrder S{bx}; pg8::gemm_phase<pg8::EpiResid, pg8::TailOrder, true, true>(lds, g, S, E); }
                else { phase_modulate(args, layer + 1, 0, false, 0, 16384, 128, 128);
                    if (even) {
                        sub_barrier((unsigned*)(ws + WS_CTL), (unsigned*)(ws + WS_CTL) + 8192 + 64 * layer, 128u);
                        pg8::Gemm g2{H, (const bf16_t*)(ws + WS_WSIN) + (size_t)j * 10496 * 2048, T, 10496, 2048};
                        pg8::EpiOdd1 E2{(bf16_t*)(ws + WS_Z), (bf16_t*)(ws + WS_XBC), (float*)(ws + WS_DTRAW)};
                        pg8::EarlyO1Order S2{bx}; pg8::gemm_phase<pg8::EpiOdd1, pg8::EarlyO1Order, true, true>(lds, g2, S2, E2); }
                    else {
                        sub_barrier((unsigned*)(ws + WS_CTL), (unsigned*)(ws + WS_CTL) + 8192 + 64 * layer, 128u);
                        pg8::Gemm g2{H, (const bf16_t*)(ws + WS_WEIN) + (size_t)(j + 1) * 5120 * 2048, T, 5120, 2048};
                        pg8::EpiStore E2{(bf16_t*)(ws + WS_U5), 5120};
                        pg8::EarlyO1Order S2{bx}; pg8::gemm_phase<pg8::EpiStore, pg8::EarlyO1Order, true, true>(lds, g2, S2, E2); } }
                xcd_barrier(bar);
                phase_modulate(args, layer + 1, 0, false, 16384, T);
            } else if (G == 256) {
                { pg8::StaticOrder S; S.init(16384, 2048, G, bx); pg8::gemm_phase<pg8::EpiResid, pg8::StaticOrder, true, true>(lds, g, S, E); }
                float* Ppart = (float*)(ws + WS_R2); unsigned* pflags = (unsigned*)(ws + WS_CTL) + 8192 + 1024;
                pg8::TailOrder S{bx & 127};
                if (bx >= 128) { pg8::Gemm gh{g.A + 2816, g.Bt + 2816, T, 2048, 5632, 2816}; pg8::EpiPartW Ew{Ppart, pflags}; pg8::gemm_phase<pg8::EpiPartW, pg8::TailOrder, true, true>(lds, gh, S, Ew); }
                else { pg8::Gemm gh{g.A, g.Bt, T, 2048, 5632, 2816}; pg8::EpiResidP Er{E.Y, E.gate, E.OUTF, Ppart, pflags}; pg8::gemm_phase<pg8::EpiResidP, pg8::TailOrder, true, true>(lds, gh, S, Er); }
            } else { pg8::StaticOrder S; S.init(T, 2048, G, bx); pg8::gemm_phase<pg8::EpiResid, pg8::StaticOrder, true, true>(lds, g, S, E);
                if (layer < 3) { xcd_barrier(bar); phase_modulate(args, layer + 1, 0, false); } } }
#if (DBG_TWICE & 16384)
        PHASE(pb + 7) {
            pg8::Gemm g{(const bf16_t*)(ws + WS_HID), (const bf16_t*)(ws + WS_WFOUT) + (size_t)layer * 2048 * 5632, T, 2048, 5632}; pg8::StaticOrder S; S.init((DBG_TWICE & 65536) ? 16384 : T, 2048, G, bx);
            pg8::EpiDummy E{(float*)(ws + 1242 * MiB)};
            pg8::gemm_phase<pg8::EpiDummy, pg8::StaticOrder, true, true>(lds, g, S, E); }
#endif
    }
#if DBG_PROF
    {
        if (bx == 0 && tid == 0) { LAS long long* pa_ = (LAS long long*)(lds + LDS_MISC + 640); const float ratio = (float)pa_[DBG_PROF / 100] / (float)pa_[DBG_PROF % 100];
            __hip_atomic_store((float*)(ws + WS_CTL + 60000), ratio, __ATOMIC_RELAXED, __HIP_MEMORY_SCOPE_AGENT); }
        xcd_barrier(bar);
        const float ratio = __hip_atomic_load((float*)(ws + WS_CTL + 60000), __ATOMIC_RELAXED, __HIP_MEMORY_SCOPE_AGENT);
        for (int i = bx * 512 + tid; i < 65536; i += G * 512) args.out[OUT_LRU + i] *= (1.0f + ratio);
    }
#endif
#undef PHASE
}

extern "C" void kernel_launch(void* const* d_in, const int* in_sizes, int n_in, void* d_out, int out_size, void* d_ws, size_t ws_size, hipStream_t stream) {
    static int grid = 0;
    if (grid == 0) {
        if (n_in != 34 || out_size != 92340224 || ws_size < WS_END) { fprintf(stderr, "kernel_launch: unexpected shapes (n_in %d, out %d, ws %zu); nothing launched\n", n_in, out_size, ws_size); grid = -1; return; }
        int dev = 0, cus = 0, per_cu = 0;
        if (hipGetDevice(&dev) != hipSuccess || hipDeviceGetAttribute(&cus, hipDeviceAttributeMultiprocessorCount, dev) != hipSuccess) { grid = -1; return; }
        if (hipFuncSetAttribute((const void*)fwd_kernel, hipFuncAttributeMaxDynamicSharedMemorySize, LDS_BYTES) != hipSuccess) { fprintf(stderr, "kernel_launch: hipFuncSetAttribute failed\n"); grid = -1; return; }
        if (hipOccupancyMaxActiveBlocksPerMultiprocessor(&per_cu, (const void*)fwd_kernel, 512, LDS_BYTES) != hipSuccess || per_cu < 1)
            fprintf(stderr, "kernel_launch: occupancy query reports %d workgroups per CU\n", per_cu);
        (void)hipGetLastError();
        grid = cus;
    }
    if (grid < 0) return;
    (void)hipMemsetAsync(d_ws, 0, 65536, stream);
    Args a{};
    for (int i = 0; i < 34; ++i) a.in[i] = (const float*)d_in[i];
    a.out = (float*)d_out; a.ws = (unsigned char*)d_ws;
#if MK_ONE_LAUNCH
    a.ph_lo = 0; a.ph_hi = N_PHASE_IDS;
    hipLaunchKernelGGL(fwd_kernel, dim3(grid), dim3(512), LDS_BYTES, stream, a);
#else
    for (int p = 0; p < N_PHASE_IDS; ++p) {
        if (p >= 2) { const int L = (p - 2) / 9, k = (p - 2) % 9; const bool even = (L & 1) == 0; if ((even && k == 3) || (L == 3 && k == 8)) continue; }
        a.ph_lo = p; a.ph_hi = p + 1;
        hipLaunchKernelGGL(fwd_kernel, dim3(grid), dim3(512), LDS_BYTES, stream, a);
    }
#endif
}
```
